# Optimizing an MI355X kernel written in HIP

```python
import math, functools
import jax, jax.numpy as jnp
from jax import lax
import numpy as np

D_MODEL = 2048
BATCH = 2
SEQ = 16384
DEPTH = 2

GRID_W = 64
CTX_LEN = 256

HY_WIDTH = D_MODEL // 2
HY_ORDER = 2
HY_SHORT = 3
HY_BANDS = 16
HY_EMB = 1 + 2 * HY_BANDS
HY_FILTER_HIDDEN = 64
HY_FILTER_GAIN = 0.03
HY_MIN_DECAY = math.log(1e-2) / 1.5
HY_MAX_DECAY = math.log(1e-2) / 0.3
GLA_HEADS = 4
GLA_DK = D_MODEL // 4
GLA_DV = D_MODEL // 2
GLA_HEAD_K = GLA_DK // GLA_HEADS
GLA_HEAD_V = GLA_DV // GLA_HEADS
GLA_RANK = 16
GLA_TAU = 16.0
GLA_CHUNK = 64
AB_SIZES = ((HY_ORDER + 1) * HY_WIDTH, GLA_DK, GLA_DK, GLA_DV, GLA_DV, GLA_RANK, GLA_RANK)
AB_IN = sum(AB_SIZES)
AB_MIX = HY_WIDTH + GLA_DV
SSD_D_INNER = 2 * D_MODEL
SSD_HEADDIM = 64
SSD_HEADS = SSD_D_INNER // SSD_HEADDIM
SSD_GROUPS = 8
SSD_HPG = SSD_HEADS // SSD_GROUPS
SSD_STATE = 128
SSD_CONV = 3
SSD_CHUNK = 128
SSD_CONV_DIM = SSD_D_INNER + 2 * SSD_GROUPS * SSD_STATE
SSD_SIZES = (SSD_D_INNER, SSD_CONV_DIM, SSD_HEADS, SSD_HEADS)
SSD_IN = sum(SSD_SIZES)
N_EXPERTS = 16
N_EXPERT_GROUPS = 4
EXPERTS_PER_GROUP = N_EXPERTS // N_EXPERT_GROUPS
TOP_K = 2
D_EXPERT = D_MODEL // 2
MOE_BLOCK = 256
ALPHA = (2 * DEPTH) ** 0.25
BETA = (8 * DEPTH) ** -0.25
EPS = 1e-6

kernel_name = 'hybrid_diffusion_hyena_gla_ssd_moe'


def _split(t, sizes):
    return jnp.split(t, np.cumsum(sizes)[:-1].tolist(), axis=-1)


def _layer_norm(x, g, b):
    xf = x.astype(jnp.float32)
    xc = xf - jnp.mean(xf, -1, keepdims=True)
    var = jnp.mean(xc * xc, -1, keepdims=True)
    return (xc * lax.rsqrt(var + EPS) * g.astype(jnp.float32) + b.astype(jnp.float32)).astype(x.dtype)


def _rms_norm(x, g):
    xf = x.astype(jnp.float32)
    return xf * lax.rsqrt(jnp.mean(xf * xf, -1, keepdims=True) + EPS) * g.astype(jnp.float32)


def _dwconv1d(x, w, b):
    k, L = w.shape[0], x.shape[1]
    xp = jnp.pad(x, ((0, 0), (k // 2, k // 2), (0, 0)))
    return sum(xp[:, j:j + L] * w[j] for j in range(k)) + b


def _dwconv_grid(x, w, b):
    bsz, L, C = x.shape
    rows = L // GRID_W
    k = w.shape[0]
    p = k // 2
    xg = jnp.pad(x.reshape(bsz, rows, GRID_W, C), ((0, 0), (p, p), (p, p), (0, 0)))
    out = sum(xg[:, i:i + rows, j:j + GRID_W] * w[i, j] for i in range(k) for j in range(k))
    return (out + b).reshape(bsz, L, C)


def _hyena_spectra(L, w1, b1, fr1, w2, b2, fr2, w3):
    f32 = jnp.float32
    pos = jnp.arange(L, dtype=f32)[:, None]
    t = pos / max(L - 1, 1)
    bands = jnp.linspace(1e-4, HY_BANDS - 1, HY_BANDS, dtype=f32)
    ang = 2.0 * math.pi * bands * pos / L
    z = jnp.concatenate([t, jnp.cos(ang), -jnp.sin(ang)], axis=-1)
    hid = jnp.sin(fr1.astype(f32) * (z @ w1.astype(f32) + b1.astype(f32)))
    hid = jnp.sin(fr2.astype(f32) * (hid @ w2.astype(f32) + b2.astype(f32)))
    h = (hid @ w3.astype(f32)).reshape(L, HY_ORDER, 2, HY_WIDTH)
    deltas = jnp.abs(jnp.linspace(HY_MIN_DECAY, HY_MAX_DECAY, HY_WIDTH, dtype=f32))
    h = h * jnp.exp(-t * deltas)[:, None, None, :]
    causal, anti = h[:, :, 0], h[:, :, 1]
    full = jnp.concatenate([causal, jnp.zeros_like(causal[:1]), jnp.flip(anti[1:], axis=0)], axis=0)
    return jnp.fft.rfft(full, axis=0)


def _long_conv(u, spec, d):
    L = u.shape[1]
    uf = u.astype(jnp.float32)
    y = jnp.fft.irfft(jnp.fft.rfft(uf, n=2 * L, axis=1) * spec, n=2 * L, axis=1)[:, :L]
    return y + uf * d.astype(jnp.float32)


def _hyena_branch(u, conv_w, conv_b, f_w1, f_b1, f_fr1, f_w2, f_b2, f_fr2, f_w3, long_bias):
    L = u.shape[1]
    parts = jnp.split(_dwconv1d(u, conv_w, conv_b), HY_ORDER + 1, axis=-1)
    spec = _hyena_spectra(L, f_w1, f_b1, f_fr1, f_w2, f_b2, f_fr2, f_w3)
    y = parts[0].astype(jnp.float32)
    for o in range(HY_ORDER):
        y = parts[o + 1].astype(jnp.float32) * _long_conv(y, spec[:, o], long_bias[o])
    return y.astype(u.dtype)


def _gla_scan(q, k, v, g, s0):
    f32 = jnp.float32
    bsz, L = q.shape[:2]
    n = L // GLA_CHUNK

    def chunks(t):
        return jnp.moveaxis(t.astype(f32).reshape((bsz, n, GLA_CHUNK) + t.shape[2:]), 1, 0)

    causal = jnp.tril(jnp.ones((GLA_CHUNK, GLA_CHUNK), bool))[None, :, :, None, None]

    def step(state, inp):
        qc, kc, vc, gc = inp
        b = jnp.cumsum(gc, axis=1)
        decay = jnp.exp(jnp.where(causal, b[:, :, None] - b[:, None, :], -jnp.inf))
        att = jnp.einsum('bihk,bjhk,bijhk->bhij', qc, kc, decay)
        o = jnp.einsum('bhij,bjhv->bihv', att, vc) + jnp.einsum('bihk,bhkv->bihv', qc * jnp.exp(b), state)
        tail = jnp.exp(b[:, -1:] - b)
        state = jnp.exp(b[:, -1])[..., None] * state + jnp.einsum('bjhk,bjhv->bhkv', kc * tail, vc)
        return state, o

    state, o = lax.scan(step, s0, (chunks(q), chunks(k), chunks(v), chunks(g)))
    return jnp.moveaxis(o, 0, 1).reshape(bsz, L, GLA_HEADS, GLA_HEAD_V), state


def _ssd_scan(x, dt, bmat, cmat, s0, a_neg, d_skip):
    f32 = jnp.float32
    bsz, L = x.shape[:2]
    n = L // SSD_CHUNK
    x = x.astype(f32)
    a = dt * a_neg
    xdt = x * dt[..., None]

    def chunks(t):
        return jnp.moveaxis(t.astype(f32).reshape((bsz, n, SSD_CHUNK) + t.shape[2:]), 1, 0)

    causal = jnp.tril(jnp.ones((SSD_CHUNK, SSD_CHUNK), bool))[None, :, :, None, None]

    def step(state, inp):
        xc, ac, bc, cc = inp
        acs = jnp.cumsum(ac, axis=1)
        decay = jnp.exp(jnp.where(causal, acs[:, :, None] - acs[:, None, :], -jnp.inf))
        cb = jnp.einsum('bign,bjgn->bijg', cc, bc)
        y = jnp.einsum('bijg,bijgr,bjgrp->bigrp', cb, decay, xc)
        y = y + jnp.einsum('bign,bgrpn->bigrp', cc, state) * jnp.exp(acs)[..., None]
        tail = jnp.exp(acs[:, -1:] - acs)
        state = jnp.exp(acs[:, -1])[..., None, None] * state + jnp.einsum('bjgn,bjgr,bjgrp->bgrpn', bc, tail, xc)
        return state, y

    state, y = lax.scan(step, s0, (chunks(xdt), chunks(a), chunks(bmat), chunks(cmat)))
    y = jnp.moveaxis(y, 0, 1).reshape(x.shape) + d_skip[..., None] * x
    return y, state


def _two_way(scan_f, scan_b, ctx_f, ctx_b, lat_f, lat_b, s0):
    def flip(args):
        return tuple(jnp.flip(a, axis=1) for a in args)
    yc_f, st_f = scan_f(*ctx_f, s0)
    yc_b, st_b = scan_b(*flip(ctx_b), s0)
    yl_f, _ = scan_f(*lat_f, st_f)
    yl_b, _ = scan_b(*flip(lat_b), st_b)
    return yc_f + jnp.flip(yc_b, axis=1), yl_f + jnp.flip(yl_b, axis=1)


def _hyena_gla_mixer(h_ctx, h_lat, w_in, w_out, hy_p, gate_w2, gate_b, norm_g, need_ctx):
    f32 = jnp.float32

    def project(h):
        bsz, L = h.shape[:2]
        u, q, k, v, r, g1f, g1b = _split(h @ w_in, AB_SIZES)

        def log_gate(g1, d):
            z = (g1 @ gate_w2[d] + gate_b[d]).astype(f32)
            return (jax.nn.log_sigmoid(z) / GLA_TAU).reshape(bsz, L, GLA_HEADS, GLA_HEAD_K)

        q = q.reshape(bsz, L, GLA_HEADS, GLA_HEAD_K) * GLA_HEAD_K ** -0.5
        k = k.reshape(bsz, L, GLA_HEADS, GLA_HEAD_K)
        v = v.reshape(bsz, L, GLA_HEADS, GLA_HEAD_V)
        return u, (q, k, v), r, log_gate(g1f, 0), log_gate(g1b, 1)

    u_c, qkv_c, r_c, gf_c, gb_c = project(h_ctx)
    u_l, qkv_l, r_l, gf_l, gb_l = project(h_lat)
    s0 = jnp.zeros((h_lat.shape[0], GLA_HEADS, GLA_HEAD_K, GLA_HEAD_V), f32)
    o_c, o_l = _two_way(_gla_scan, _gla_scan, (*qkv_c, gf_c), (*qkv_c, gb_c), (*qkv_l, gf_l), (*qkv_l, gb_l), s0)

    def finish(u, o, r):
        bsz, L = u.shape[:2]
        o = _rms_norm(o, norm_g.reshape(GLA_HEADS, GLA_HEAD_V)).reshape(bsz, L, GLA_DV)
        o = (o * jax.nn.silu(r.astype(f32))).astype(u.dtype)
        return jnp.concatenate([_hyena_branch(u, *hy_p), o], axis=-1) @ w_out

    y_lat = finish(u_l, o_l, r_l)
    y_ctx = finish(u_c, o_c, r_c) if need_ctx else None
    return y_ctx, y_lat


def _mamba_mixer(h_ctx, h_lat, w_in, conv_w, conv_b, dt_bias, a_log, d_skip, norm_g, w_out, need_ctx):
    f32 = jnp.float32

    def project(h, conv):
        bsz, L = h.shape[:2]
        z, xbc, dt_f, dt_b = _split(h @ w_in, SSD_SIZES)
        xbc = jax.nn.silu(conv(xbc))
        xs, bm, cm = _split(xbc, (SSD_D_INNER, SSD_GROUPS * SSD_STATE, SSD_GROUPS * SSD_STATE))
        xs = xs.reshape(bsz, L, SSD_GROUPS, SSD_HPG, SSD_HEADDIM)
        bm = bm.reshape(bsz, L, SSD_GROUPS, SSD_STATE)
        cm = cm.reshape(bsz, L, SSD_GROUPS, SSD_STATE)
        dts = [jax.nn.softplus(t.astype(f32) + dt_bias[d].astype(f32)).reshape(bsz, L, SSD_GROUPS, SSD_HPG)
               for d, t in enumerate((dt_f, dt_b))]
        return z, (xs, dts[0], bm, cm), (xs, dts[1], bm, cm)

    z_c, ctx_f, ctx_b = project(h_ctx, lambda t: _dwconv1d(t, conv_w[SSD_CONV // 2], conv_b))
    z_l, lat_f, lat_b = project(h_lat, lambda t: _dwconv_grid(t, conv_w, conv_b))
    a_neg = -jnp.exp(a_log.astype(f32)).reshape(2, SSD_GROUPS, SSD_HPG)
    dsk = d_skip.astype(f32).reshape(2, SSD_GROUPS, SSD_HPG)
    scan_f = functools.partial(_ssd_scan, a_neg=a_neg[0], d_skip=dsk[0])
    scan_b = functools.partial(_ssd_scan, a_neg=a_neg[1], d_skip=dsk[1])
    s0 = jnp.zeros((h_lat.shape[0], SSD_GROUPS, SSD_HPG, SSD_HEADDIM, SSD_STATE), f32)
    y_c, y_l = _two_way(scan_f, scan_b, ctx_f, ctx_b, lat_f, lat_b, s0)

    def finish(y, z):
        bsz, L = z.shape[:2]
        y = y.reshape(bsz, L, SSD_D_INNER) * jax.nn.silu(z.astype(f32))
        y = _rms_norm(y.reshape(bsz, L, SSD_GROUPS, SSD_D_INNER // SSD_GROUPS), norm_g.reshape(SSD_GROUPS, -1))
        return y.reshape(bsz, L, SSD_D_INNER).astype(z.dtype) @ w_out

    y_lat = finish(y_l, z_l)
    y_ctx = finish(y_c, z_c) if need_ctx else None
    return y_ctx, y_lat


def _moe(h, router_w, router_b, w_gate, w_up, w_down):
    f32 = jnp.float32
    t = h.shape[0]
    scores = jax.nn.sigmoid(h.astype(f32) @ router_w.astype(f32))
    sel = (scores + router_b.astype(f32)).reshape(t, N_EXPERT_GROUPS, EXPERTS_PER_GROUP)
    group = jnp.argmax(lax.top_k(sel, 2)[0].sum(-1), axis=-1)
    in_group = jnp.take_along_axis(sel, group[:, None, None], axis=1)[:, 0]
    experts = group[:, None] * EXPERTS_PER_GROUP + lax.top_k(in_group, TOP_K)[1]
    gates = jnp.take_along_axis(scores, experts, axis=1)
    gates = gates / jnp.sum(gates, -1, keepdims=True)
    e_flat = experts.reshape(-1)
    tk = e_flat.shape[0]
    order = jnp.argsort(e_flat)
    e_s = e_flat[order]
    tok_s = order // TOP_K
    g_s = gates.reshape(-1)[order]
    counts = jnp.bincount(e_flat, length=N_EXPERTS)
    padded = (counts + MOE_BLOCK - 1) // MOE_BLOCK * MOE_BLOCK
    starts = jnp.cumsum(counts) - counts
    pstarts = jnp.cumsum(padded) - padded
    dest = pstarts[e_s] + jnp.arange(tk) - starts[e_s]
    n_blocks = -(-tk // MOE_BLOCK) + N_EXPERTS
    buf = jnp.zeros((n_blocks * MOE_BLOCK, h.shape[1]), h.dtype).at[dest].set(h[tok_s])
    block_expert = jnp.minimum(
        jnp.searchsorted(pstarts + padded, jnp.arange(n_blocks) * MOE_BLOCK, side='right'), N_EXPERTS - 1)

    def expert_block(args):
        xb, e = args
        return (jax.nn.silu(xb @ w_gate[e]) * (xb @ w_up[e])) @ w_down[e]

    out_blocks = lax.map(expert_block, (buf.reshape(n_blocks, MOE_BLOCK, -1), block_expert))
    rows = (out_blocks.reshape(n_blocks * MOE_BLOCK, -1)[dest] * g_s[:, None]).astype(h.dtype)
    return jnp.zeros_like(h).at[tok_s].add(rows)


def setup_inputs(seed: int = 0) -> dict:
    key = jax.random.key(seed)
    keys = iter(jax.random.split(key, 48))

    def nrm(shape, scale):
        return scale * jax.random.normal(next(keys), shape, jnp.float32)

    ne, no = (DEPTH + 1) // 2, DEPTH // 2
    fh = HY_FILTER_HIDDEN
    dt0 = jnp.exp(jax.random.uniform(next(keys), (no, 2, SSD_HEADS), jnp.float32, math.log(1e-3), math.log(1e-1)))
    a0 = jax.random.uniform(next(keys), (no, 2, SSD_HEADS), jnp.float32, 1.0, 16.0)
    return {
        'x': nrm((BATCH, SEQ, D_MODEL), 1.0),
        'c': nrm((BATCH, D_MODEL), 1.0),
        'ctx': nrm((BATCH, CTX_LEN, D_MODEL), 1.0),
        'c_ctx': nrm((D_MODEL,), 1.0),
        'router_w': nrm((D_MODEL, N_EXPERTS), D_MODEL ** -0.5),
        'router_b': nrm((N_EXPERTS,), 0.01),
        'mod_w': nrm((DEPTH, D_MODEL, 6 * D_MODEL), 0.5 * D_MODEL ** -0.5),
        'mod_b': nrm((DEPTH, 6 * D_MODEL), 0.02),
        'ln_g': 1.0 + nrm((DEPTH, 2, D_MODEL), 0.02),
        'ln_b': nrm((DEPTH, 2, D_MODEL), 0.02),
        'exp_w_gate': nrm((DEPTH, N_EXPERTS, D_MODEL, D_EXPERT), D_MODEL ** -0.5),
        'exp_w_up': nrm((DEPTH, N_EXPERTS, D_MODEL, D_EXPERT), D_MODEL ** -0.5),
        'exp_w_down': nrm((DEPTH, N_EXPERTS, D_EXPERT, D_MODEL), BETA * D_EXPERT ** -0.5),
        'ab_w_in': nrm((ne, D_MODEL, AB_IN), D_MODEL ** -0.5),
        'ab_w_out': nrm((ne, AB_MIX, D_MODEL), BETA * AB_MIX ** -0.5),
        'hy_conv_w': nrm((ne, HY_SHORT, (HY_ORDER + 1) * HY_WIDTH), HY_SHORT ** -0.5),
        'hy_conv_b': nrm((ne, (HY_ORDER + 1) * HY_WIDTH), 0.02),
        'hy_f_w1': nrm((ne, HY_EMB, fh), HY_EMB ** -0.5),
        'hy_f_b1': nrm((ne, fh), 0.02),
        'hy_f_fr1': 1.0 + nrm((ne, fh), 0.1),
        'hy_f_w2': nrm((ne, fh, fh), fh ** -0.5),
        'hy_f_b2': nrm((ne, fh), 0.02),
        'hy_f_fr2': 1.0 + nrm((ne, fh), 0.1),
        'hy_f_w3': nrm((ne, fh, HY_ORDER * 2 * HY_WIDTH), HY_FILTER_GAIN * fh ** -0.5),
        'hy_long_bias': nrm((ne, HY_ORDER, HY_WIDTH), 1.0),
        'gla_gate_w2': nrm((ne, 2, GLA_RANK, GLA_DK), GLA_RANK ** -0.5),
        'gla_gate_b': nrm((ne, 2, GLA_DK), 0.5),
        'gla_norm_g': 1.0 + nrm((ne, GLA_DV), 0.02),
        'ssd_w_in': nrm((no, D_MODEL, SSD_IN), D_MODEL ** -0.5),
        'ssd_conv_w': nrm((no, SSD_CONV, SSD_CONV, SSD_CONV_DIM), 1.0 / SSD_CONV),
        'ssd_conv_b': nrm((no, SSD_CONV_DIM), 0.02),
        'ssd_dt_bias': dt0 + jnp.log(-jnp.expm1(-dt0)),
        'ssd_a_log': jnp.log(a0),
        'ssd_d': 1.0 + nrm((no, 2, SSD_HEADS), 0.1),
        'ssd_norm_g': 1.0 + nrm((no, SSD_D_INNER), 0.02),
        'ssd_w_out': nrm((no, SSD_D_INNER, D_MODEL), BETA * SSD_D_INNER ** -0.5),
    }


def reference(x, c, ctx, c_ctx, router_w, router_b, mod_w, mod_b, ln_g, ln_b,
              exp_w_gate, exp_w_up, exp_w_down, ab_w_in, ab_w_out,
              hy_conv_w, hy_conv_b, hy_f_w1, hy_f_b1, hy_f_fr1, hy_f_w2, hy_f_b2, hy_f_fr2, hy_f_w3, hy_long_bias,
              gla_gate_w2, gla_gate_b, gla_norm_g,
              ssd_w_in, ssd_conv_w, ssd_conv_b, ssd_dt_bias, ssd_a_log, ssd_d, ssd_norm_g, ssd_w_out):
    n_lat = x.shape[0] * x.shape[1]
    for i in range(DEPTH):
        last = i == DEPTH - 1
        j = i // 2
        mod_l = jnp.split((jax.nn.silu(c) @ mod_w[i] + mod_b[i])[:, None, :], 6, axis=-1)
        mod_c = jnp.split(jax.nn.silu(c_ctx) @ mod_w[i] + mod_b[i], 6, axis=-1)
        h_l = x * (1 + mod_l[1]) + mod_l[0]
        h_c = ctx * (1 + mod_c[1]) + mod_c[0]
        if i % 2 == 0:
            hy_p = (hy_conv_w[j], hy_conv_b[j], hy_f_w1[j], hy_f_b1[j], hy_f_fr1[j], hy_f_w2[j], hy_f_b2[j],
                    hy_f_fr2[j], hy_f_w3[j], hy_long_bias[j])
            y_c, y_l = _hyena_gla_mixer(h_c, h_l, ab_w_in[j], ab_w_out[j], hy_p, gla_gate_w2[j], gla_gate_b[j],
                                        gla_norm_g[j], not last)
        else:
            y_c, y_l = _mamba_mixer(h_c, h_l, ssd_w_in[j], ssd_conv_w[j], ssd_conv_b[j], ssd_dt_bias[j],
                                    ssd_a_log[j], ssd_d[j], ssd_norm_g[j], ssd_w_out[j], not last)
        x = _layer_norm(ALPHA * x + mod_l[2] * y_l, ln_g[i, 0], ln_b[i, 0])
        tokens = (x * (1 + mod_l[4]) + mod_l[3]).reshape(n_lat, D_MODEL)
        if not last:
            ctx = _layer_norm(ALPHA * ctx + mod_c[2] * y_c, ln_g[i, 0], ln_b[i, 0])
            h_c = ctx * (1 + mod_c[4]) + mod_c[3]
            tokens = jnp.concatenate([tokens, h_c.reshape(-1, D_MODEL)], axis=0)
        y = _moe(tokens, router_w, router_b, exp_w_gate[i], exp_w_up[i], exp_w_down[i])
        x = _layer_norm(ALPHA * x + mod_l[5] * y[:n_lat].reshape(x.shape), ln_g[i, 1], ln_b[i, 1])
        if not last:
            ctx = _layer_norm(ALPHA * ctx + mod_c[5] * y[n_lat:].reshape(ctx.shape), ln_g[i, 1], ln_b[i, 1])
    return x
```

```cpp
#include <hip/hip_runtime.h>
#include <cstdio>
#include <cstdint>
#define ONE_LAUNCH 0
namespace pg8 {
#define PG8_LAS __attribute__((address_space(3)))
typedef unsigned short bf16_t;
typedef short bf16x8 __attribute__((ext_vector_type(8)));
typedef float f32x4 __attribute__((ext_vector_type(4)));
typedef unsigned u32x4 __attribute__((ext_vector_type(4)));
constexpr int BM = 256, BK = 64, HALF = 128, HTB = HALF * BK * 2  , STAGE_BYTES = 8 * HTB, NXCD = 8, WGM = 8;

__host__ __device__ __forceinline__ int lds_byte(int r, int c) { const int st = (r >> 4) * 2 + (c >> 5), rr = r & 15, cc = c & 31, ob = rr * 64 + cc * 2; return st * 1024 + (ob ^ (((ob >> 9) & 1) << 5)); }
__host__ __device__ __forceinline__ void stage_rc(int b, int& R, int& C) { const int st = b / 1024, sb = b % 1024, swz = sb ^ (((sb >> 9) & 1) << 5); R = (st >> 1) * 16 + swz / 64; C = (st & 1) * 32 + (swz % 64) / 2; }
__host__ __device__ __forceinline__ int perm32(int rho) { const int n = rho >> 4, i = rho & 15; return 8 * (i >> 2) + 4 * n + (i & 3); }

struct Unit { int pm, pn; };
struct Gemm { const bf16_t* A; const bf16_t* Bt; int M, N, K; };

struct StaticOrder {
    int nM, nN, nwg, G, c;
    __host__ __device__ void init(int M, int N, int G_, int c_) { nM = M / BM; nN = N / BM; nwg = nM * nN; G = G_; c = c_; }
    __host__ __device__ bool next(int i, Unit& u) const {
        const long L = (long)i * G + c; if (L >= nwg) return false;
        int wgid = (int)L; { const int q = nwg / NXCD, r = nwg % NXCD, xcd = wgid % NXCD, off = wgid / NXCD; wgid = (xcd < r ? xcd * (q + 1) : r * (q + 1) + (xcd - r) * q) + off; }
        const int nig = WGM * nN, gid = wgid / nig, fm = gid * WGM, gsz = (nM - fm) < WGM ? (nM - fm) : WGM;
        u.pm = fm + ((wgid % nig) % gsz); u.pn = (wgid % nig) / gsz; return true;
    }
    __device__ __forceinline__ void a_ready(const Unit&) const {}
    __device__ __forceinline__ void done(const Unit&) const {}
};
__device__ __forceinline__ unsigned cvt_pk_bf16(float lo, float hi) { unsigned r; asm volatile("v_cvt_pk_bf16_f32 %0, %1, %2" : "=v"(r) : "v"(lo), "v"(hi)); return r; }
typedef unsigned u32x4 __attribute__((ext_vector_type(4)));
struct EpiStore {
    static constexpr bool PERM = true, AFTER_DRAIN = false;
    bf16_t* O; int ld; int split; bf16_t* O2; int ld2; int pn_mod;
    __device__ __forceinline__ void operator()(const f32x4 (&acc)[2][2][4][2], const Unit& u, int wr, int wc, int fr, int fq) const {
        const int pn = pn_mod > 0 ? (u.pn % pn_mod) : u.pn;
        const int row0 = u.pm * BM + wr * 64 + fr;
        bf16_t* base = O; int ldc = ld, colt = pn * BM;
        if (pn >= split) { base = O2; ldc = ld2; colt = (pn - split) * BM; }
        const int col0 = colt + wc * 32 + 8 * fq;
#pragma unroll
        for (int ai = 0; ai < 2; ++ai)
#pragma unroll
            for (int m = 0; m < 4; ++m) { bf16_t* rowp = base + (size_t)(row0 + ai * HALF + m * 16) * ldc + col0;
#pragma unroll
                for (int bj = 0; bj < 2; ++bj) { const f32x4 v0 = acc[ai][bj][m][0], v1 = acc[ai][bj][m][1];
                    u32x4 w; w.x = cvt_pk_bf16(v0[0], v0[1]); w.y = cvt_pk_bf16(v0[2], v0[3]); w.z = cvt_pk_bf16(v1[0], v1[1]); w.w = cvt_pk_bf16(v1[2], v1[3]);
                    *(u32x4*)(rowp + bj * HALF) = w; } }
    }
};
struct EpiSwiGLU {
    static constexpr bool PERM = true, AFTER_DRAIN = false;
    bf16_t* O; int ld; int pn_mod;
    __device__ __forceinline__ void operator()(const f32x4 (&acc)[2][2][4][2], const Unit& u, int wr, int wc, int fr, int fq) const {
        const int pn = u.pn % pn_mod;
        const int row0 = u.pm * BM + wr * 64 + fr, col0 = pn * HALF + wc * 32 + 8 * fq;
#pragma unroll
        for (int ai = 0; ai < 2; ++ai)
#pragma unroll
            for (int m = 0; m < 4; ++m) { bf16_t* rowp = O + (size_t)(row0 + ai * HALF + m * 16) * ld + col0;
                float h[8];
#pragma unroll
                for (int n = 0; n < 2; ++n)
#pragma unroll
                    for (int j = 0; j < 4; ++j) { const float g = acc[ai][0][m][n][j], uu = acc[ai][1][m][n][j]; h[n * 4 + j] = g * __builtin_amdgcn_rcpf(1.0f + __expf(-g)) * uu; }
                u32x4 w; w.x = cvt_pk_bf16(h[0], h[1]); w.y = cvt_pk_bf16(h[2], h[3]); w.z = cvt_pk_bf16(h[4], h[5]); w.w = cvt_pk_bf16(h[6], h[7]);
                *(u32x4*)rowp = w; }
    }
};
struct GroupedOrder {
    const int* tile_e; int ntiles, ncol, G, c;
    __device__ __forceinline__ bool next(int i, Unit& u) const {
        const long L = (long)i * G + c; if (L >= (long)ntiles * ncol) return false;
        const int rt = (int)(L / ncol), pl = (int)(L % ncol);
        u.pm = rt; u.pn = tile_e[rt] * ncol + pl; return true;
    }
    __device__ __forceinline__ void a_ready(const Unit&) const {}
    __device__ __forceinline__ void done(const Unit&) const {}
};

template <class Epi, class Sched, bool STAMP = false>
__device__ __forceinline__ void gemm_phase(PG8_LAS unsigned char* lds, const Gemm g, const Sched& S, const Epi& E, unsigned long long* stamps) {
    const int tid = threadIdx.x, wid = __builtin_amdgcn_readfirstlane(tid >> 6), lane = tid & 63, wr = wid >> 2, wc = wid & 3, fr = lane & 15, fq = lane >> 4;
    const int K = g.K, nt = K / BK;
    int ts_lo = 0, ts_hi = 0, nts = 0; const unsigned long long rt_entry = STAMP ? (unsigned long long)wall_clock64() : 0ull;
#define PG8_STAMP() do { if (STAMP && wid == 0 && nts < 64) { const unsigned long long _c = (unsigned long long)clock64(); \
        ts_lo = (lane == nts) ? (int)(unsigned)_c : ts_lo; ts_hi = (lane == nts) ? (int)(unsigned)(_c >> 32) : ts_hi; ++nts; } } while (0)
    PG8_STAMP();
    unsigned voffA[2], voffB[2];
#pragma unroll
    for (int i = 0; i < 2; ++i) { int R, C; stage_rc(tid * 16 + i * 8192, R, C); const int Rb = Epi::PERM ? ((R & ~31) + perm32(R & 31)) : R;
        voffA[i] = (unsigned)(R * K + C) * 2u; voffB[i] = (unsigned)(Rb * K + C) * 2u; }
    const size_t kstep = (size_t)(BK * 2);
    const size_t hstep = (size_t)HALF * K * 2;
    const size_t tstep = 2 * hstep;
    const unsigned ldsw = (unsigned)wid * 1024u;
    const int aoff = lds_byte(wr * 64 + fr, fq * 8), boff = lds_byte(wc * 32 + fr, fq * 8);
#define PG8_SA(b, h) (((b) * 2 + (h)) * HTB)
#define PG8_SB(b, h) ((4 + (b) * 2 + (h)) * HTB)
#define PG8_STAGE(bufoff, gbase, voff) do { _Pragma("unroll") for (int _i = 0; _i < 2; ++_i) \
        __builtin_amdgcn_global_load_lds((const unsigned*)((const char*)(gbase) + (voff)[_i]), (PG8_LAS unsigned*)(lds + (bufoff) + ldsw + _i * 8192), 16, 0, 0); } while (0)
#define PG8_LDA(dst, b, h) do { _Pragma("unroll") for (int m = 0; m < 4; ++m) _Pragma("unroll") for (int k = 0; k < 2; ++k) dst[m][k] = *(const PG8_LAS bf16x8*)(lds + PG8_SA(b, h) + aoff + m * 2048 + k * 1024); } while (0)
#define PG8_LDB(dst, b, h) do { _Pragma("unroll") for (int n = 0; n < 2; ++n) _Pragma("unroll") for (int k = 0; k < 2; ++k) dst[n][k] = *(const PG8_LAS bf16x8*)(lds + PG8_SB(b, h) + boff + n * 2048 + k * 1024); } while (0)
#define PG8_MMA(ai, bj, At, Bt) do { __builtin_amdgcn_s_setprio(1); _Pragma("unroll") for (int m = 0; m < 4; ++m) _Pragma("unroll") for (int n = 0; n < 2; ++n) _Pragma("unroll") for (int k = 0; k < 2; ++k) \
        acc[ai][bj][m][n] = __builtin_amdgcn_mfma_f32_16x16x32_bf16(Bt[n][k], At[m][k], acc[ai][bj][m][n], 0, 0, 0); __builtin_amdgcn_s_setprio(0); } while (0)
#define PG8_WAIT_V(n) asm volatile("s_waitcnt vmcnt(" #n ")" ::: "memory")
#define PG8_WAIT_L(n) asm volatile("s_waitcnt lgkmcnt(" #n ")" ::: "memory")
#define PG8_BAR __builtin_amdgcn_s_barrier()
#define PG8_SCHED __builtin_amdgcn_sched_barrier(0)
    Unit cur, nxt; int ui = 0;
    if (!S.next(0, cur)) return;
    f32x4 acc[2][2][4][2];
#pragma unroll
    for (int a = 0; a < 2; ++a)
#pragma unroll
        for (int b = 0; b < 2; ++b)
#pragma unroll
            for (int m = 0; m < 4; ++m)
#pragma unroll
                for (int n = 0; n < 2; ++n) acc[a][b][m][n] = (f32x4){0.f, 0.f, 0.f, 0.f};
    bf16x8 At[4][2], B0[2][2], B1[2][2];
    const char* cA = (const char*)g.A + (size_t)cur.pm * tstep; const char* cB = (const char*)g.Bt + (size_t)cur.pn * tstep;
    S.a_ready(cur);
    PG8_STAGE(PG8_SB(0, 0), cB, voffB); PG8_STAGE(PG8_SA(0, 0), cA, voffA); PG8_STAGE(PG8_SB(0, 1), cB + hstep, voffB); PG8_STAGE(PG8_SA(0, 1), cA + hstep, voffA);
    if (wr == 1) PG8_BAR;
    PG8_WAIT_V(4); PG8_BAR;
    PG8_STAGE(PG8_SB(1, 0), cB + kstep, voffB); PG8_STAGE(PG8_SA(1, 0), cA + kstep, voffA); PG8_STAGE(PG8_SB(1, 1), cB + hstep + kstep, voffB);
    PG8_WAIT_V(6); PG8_BAR;
    PG8_STAMP();
    for (;;) {
        const bool has_next = S.next(ui + 1, nxt);
        const char* nA = has_next ? (const char*)g.A + (size_t)nxt.pm * tstep : cA; const char* nB = has_next ? (const char*)g.Bt + (size_t)nxt.pn * tstep : cB;
        for (int t = 0; t < nt; t += 2) {
            const bool last = (t == nt - 2);
            const char* a1 = cA + (size_t)(t + 1) * kstep;
            const char* a2 = last ? nA : cA + (size_t)(t + 2) * kstep; const char* b2 = last ? nB : cB + (size_t)(t + 2) * kstep;
            const char* a3 = a2 + kstep; const char* b3 = b2 + kstep;
            if (last && has_next) S.a_ready(nxt);
            PG8_LDB(B0, 0, 0); PG8_SCHED; PG8_LDA(At, 0, 0); PG8_STAGE(PG8_SA(1, 1), a1 + hstep, voffA);
            PG8_WAIT_L(8); PG8_BAR; PG8_WAIT_L(0); PG8_MMA(0, 0, At, B0); PG8_BAR; PG8_SCHED;
            PG8_LDB(B1, 0, 1); PG8_STAGE(PG8_SB(0, 0), b2, voffB);
            PG8_BAR; PG8_WAIT_L(0); PG8_MMA(0, 1, At, B1); PG8_BAR;
            PG8_LDA(At, 0, 1); PG8_STAGE(PG8_SA(0, 0), a2, voffA);
            PG8_BAR; PG8_WAIT_L(0); PG8_MMA(1, 0, At, B0); PG8_BAR; PG8_SCHED;
            PG8_STAGE(PG8_SB(0, 1), b2 + hstep, voffB);
            PG8_WAIT_V(6); PG8_BAR; PG8_MMA(1, 1, At, B1); PG8_BAR;
            PG8_LDB(B0, 1, 0); PG8_SCHED; PG8_LDA(At, 1, 0); PG8_STAGE(PG8_SA(0, 1), a2 + hstep, voffA);
            PG8_WAIT_L(8); PG8_BAR; PG8_WAIT_L(0); PG8_MMA(0, 0, At, B0); PG8_BAR; PG8_SCHED;
            PG8_LDB(B1, 1, 1); PG8_STAGE(PG8_SB(1, 0), b3, voffB);
            PG8_BAR; PG8_WAIT_L(0); PG8_MMA(0, 1, At, B1); PG8_BAR;
            PG8_LDA(At, 1, 1); PG8_STAGE(PG8_SA(1, 0), a3, voffA);
            PG8_BAR; PG8_WAIT_L(0); PG8_MMA(1, 0, At, B0); PG8_BAR; PG8_SCHED;
            PG8_STAGE(PG8_SB(1, 1), b3 + hstep, voffB);
            PG8_WAIT_V(6); PG8_BAR; PG8_MMA(1, 1, At, B1); PG8_BAR;
        }
        PG8_STAMP();
        if constexpr (!Epi::AFTER_DRAIN) { E(acc, cur, wr, wc, fr, fq); S.done(cur); }
        PG8_STAMP();
        if (!has_next) break;
#pragma unroll
        for (int a = 0; a < 2; ++a)
#pragma unroll
            for (int b = 0; b < 2; ++b)
#pragma unroll
                for (int m = 0; m < 4; ++m)
#pragma unroll
                    for (int n = 0; n < 2; ++n) acc[a][b][m][n] = (f32x4){0.f, 0.f, 0.f, 0.f};
        cur = nxt; cA = nA; cB = nB; ++ui;
    }
    PG8_WAIT_V(0);
    if (wr == 0) PG8_BAR;
    PG8_BAR;
    if constexpr (Epi::AFTER_DRAIN) { E.fused(acc, cur, wr, wc, fr, fq, lds, wid, lane); S.done(cur); }
    PG8_STAMP();
    if (STAMP && wid == 0) { stamps[lane] = lane < nts ? (((unsigned long long)(unsigned)ts_hi << 32) | (unsigned)ts_lo) : 0ull;
        if (lane == 62) stamps[62] = rt_entry; if (lane == 63) stamps[63] = (unsigned long long)wall_clock64(); }
#undef PG8_STAMP
#undef PG8_SA
#undef PG8_SB
#undef PG8_STAGE
#undef PG8_LDA
#undef PG8_LDB
#undef PG8_MMA
#undef PG8_WAIT_V
#undef PG8_WAIT_L
#undef PG8_BAR
#undef PG8_SCHED
}
}

#define XB_TMO      128
#define XB_XCNT(j)  (256  + 64 * (j))
#define XB_XSUB(j)  (1280 + 64 * (j))
#define XB_XGEN(j)  (2304 + 64 * (j))
#define XB_TOP      3328
#define XB_TOPGEN   3392
#define XCD_BAR_WORDS 3456
#define XB_SPIN_CAP (1u << 18)
#define LAS __attribute__((address_space(3)))

__device__ __forceinline__ unsigned xb_ld(unsigned* p)              { return __hip_atomic_load(p, __ATOMIC_RELAXED, __HIP_MEMORY_SCOPE_AGENT); }
__device__ __forceinline__ unsigned xb_add(unsigned* p, unsigned v) { return __hip_atomic_fetch_add(p, v, __ATOMIC_RELAXED, __HIP_MEMORY_SCOPE_AGENT); }
__device__ __forceinline__ unsigned xb_xcc_id() { return (unsigned)__builtin_amdgcn_s_getreg((3 << 11) | 20) & 0xFu; }
#define XB_SPIN(cond, bar) do { unsigned _sp = 0; while (cond) { __builtin_amdgcn_s_sleep(1); \
    if ((++_sp & 255u) == 0u) { if (xb_ld(&(bar)[XB_TMO])) break; if (_sp > XB_SPIN_CAP) { atomicAdd(&(bar)[XB_TMO], 1u); break; } } } } while (0)

struct XcdBarrier {
    unsigned* bar; unsigned x;
    volatile LAS unsigned* st;
};

__device__ __forceinline__ XcdBarrier xcd_barrier_post(unsigned* bar, volatile LAS unsigned* st) {
    XcdBarrier b; b.bar = bar; b.x = xb_xcc_id(); b.st = st;
    if (threadIdx.x == 0) (void)xb_add(&bar[XB_XCNT(b.x)], 1u);
    return b;
}
__device__ __forceinline__ void xcd_barrier_complete(unsigned* bar, unsigned x, unsigned& nloc, unsigned& nx) {
    const unsigned G = gridDim.x * gridDim.y * gridDim.z;
    unsigned sum, cnt, mine, sp = 0u;
    for (;;) {
        sum = 0u; cnt = 0u; mine = 0u;
#pragma unroll
        for (unsigned j = 0; j < 16; ++j) { const unsigned c = xb_ld(&bar[XB_XCNT(j)]); sum += c; cnt += (c > 0u) ? 1u : 0u; mine = (j == x) ? c : mine; }
        if (sum == G) break;
        __builtin_amdgcn_s_sleep(1);
        if ((++sp & 255u) == 0u) { if (xb_ld(&bar[XB_TMO])) break; if (sp > XB_SPIN_CAP) { atomicAdd(&bar[XB_TMO], 1u); break; } }
    }
    nloc = mine > 0u ? mine : 1u; nx = cnt > 0u ? cnt : 1u;
}

__device__ __forceinline__ void xcd_barrier(const XcdBarrier& b) {
    asm volatile("s_waitcnt vmcnt(0)" ::: "memory");
    __syncthreads();
    if (threadIdx.x == 0) {
        unsigned* bar = b.bar;
        __builtin_amdgcn_s_waitcnt(0);
        unsigned nloc = b.st[0], nx = b.st[1];
        if (nloc == 0u) { xcd_barrier_complete(bar, b.x, nloc, nx); b.st[0] = nloc; b.st[1] = nx; }
        const unsigned old = xb_add(&bar[XB_XSUB(b.x)], 1u);
        const unsigned gen = old / nloc;
        if (old + 1u == (gen + 1u) * nloc) {
            __builtin_amdgcn_fence(__ATOMIC_RELEASE, "agent");
            asm volatile("s_waitcnt vmcnt(0)" ::: "memory");
            const unsigned og = xb_add(&bar[XB_TOP], 1u);
            const unsigned tg = og / nx;
            if (og + 1u == (tg + 1u) * nx) xb_add(&bar[XB_TOPGEN], 1u);
            else XB_SPIN(xb_ld(&bar[XB_TOPGEN]) == tg, bar);
            __builtin_amdgcn_fence(__ATOMIC_ACQUIRE, "agent");
            xb_add(&bar[XB_XGEN(b.x)], 1u);
            asm volatile("s_waitcnt vmcnt(0)" ::: "memory");
        } else {
            XB_SPIN(xb_ld(&bar[XB_XGEN(b.x)]) == gen, bar);
            __builtin_amdgcn_fence(__ATOMIC_ACQUIRE, "agent");
            asm volatile("s_waitcnt vmcnt(0)" ::: "memory");
        }
    }
    __syncthreads();
}
typedef unsigned short bf16_t;
typedef float f32x4 __attribute__((ext_vector_type(4)));
typedef unsigned u32x4 __attribute__((ext_vector_type(4)));
typedef unsigned u32x2 __attribute__((ext_vector_type(2)));
namespace hk {
constexpr int D = 2048, SEQ = 16384, CTXL = 256, TL = 32768, TC = 512, TA = 33280;
constexpr float ALPHA = 1.41421356237309515f;
constexpr float LN_EPS = 1e-6f;
constexpr int NTHREADS = 512;
constexpr int LDS_BYTES = 156 * 1024;
enum { I_X = 0, I_C, I_CTX, I_CCTX, I_RW, I_RB, I_MODW, I_MODB, I_LNG, I_LNB, I_EG, I_EU, I_ED, I_ABIN, I_ABOUT, I_HCW, I_HCB, I_FW1, I_FB1, I_FFR1, I_FW2, I_FB2, I_FFR2, I_FW3, I_HLB,
       I_GW2, I_GB, I_GNG, I_SWIN, I_SCW, I_SCB, I_SDTB, I_SALOG, I_SD, I_SNG, I_SWOUT, N_IN };
constexpr size_t MiB = 1024 * 1024;
constexpr size_t WS_CTL = 0;
constexpr int CW_BAR = 0;
constexpr int CW_CNT = 4096;
constexpr int CW_NT = 4096 + 256;
constexpr int CW_TILEE = 4096 + 512;
constexpr size_t WS_MOD = 64 * 1024;
constexpr size_t WS_CTXS = 384 * 1024;
constexpr size_t WS_MISC = 4608 * 1024;
constexpr size_t MISC_EXP = 0, MISC_GATE = 272 * 1024, MISC_SLOT = 544 * 1024, MISC_DEST = 816 * 1024;
constexpr size_t WS_WOUT1 = 6 * MiB;
constexpr size_t WS_WE = 22 * MiB;
constexpr size_t WS_WE_DN = WS_WE + 128 * MiB;
constexpr size_t WS_R0 = 214 * MiB;
constexpr size_t WS_WU = WS_R0;
constexpr size_t WS_WGLA = WS_R0 + 12 * MiB;
constexpr size_t WS_WOUT0 = WS_R0 + 25 * MiB;
constexpr size_t WS_W3T = WS_R0 + 33 * MiB;
constexpr size_t WS_HID2 = WS_R0 + 35 * MiB;
constexpr size_t WS_HID2C = WS_R0 + 43 * MiB;
constexpr size_t WS_WSSDIN = WS_R0 + 44 * MiB;
constexpr size_t WS_ACT = 299 * MiB;
constexpr size_t A_HA = 0;
constexpr size_t A_UT = 130 * MiB;
constexpr size_t A_GL = 325 * MiB;
constexpr size_t A_HF = 537 * MiB;
constexpr size_t A_HFC = 665 * MiB;
constexpr size_t A_YT = 667 * MiB;
constexpr size_t A_OF = 732 * MiB;
constexpr size_t A_OB = 862 * MiB;
constexpr size_t A_HYTMP = 1000 * MiB;
constexpr size_t A_YO = 130 * MiB;
constexpr size_t A_AG = 260 * MiB;
constexpr size_t A_HB = 536 * MiB;
constexpr size_t A_YR = 0;
constexpr size_t A_HA1 = 700 * MiB;
constexpr size_t A_Z = 0;
constexpr size_t A_XBC = 260 * MiB;
constexpr size_t A_XC = 667 * MiB;
constexpr size_t A_DT = 1057 * MiB;
constexpr size_t A_YF = 260 * MiB;
constexpr size_t WS_YB = WS_WE;
constexpr size_t A_YO1 = 260 * MiB;
constexpr size_t A_HA2 = 400 * MiB;
constexpr size_t A_AG1 = 530 * MiB;
constexpr size_t A_HB1 = 806 * MiB;
constexpr size_t A_YR1 = 0;
constexpr size_t WS_NEED = WS_ACT + 1074 * MiB;
constexpr int XBC_LD = 6400, GL_LD = 3328;
}

struct Params { const float* in[hk::N_IN]; float* out; unsigned char* ws; int ph_lo, ph_hi; };

__device__ __forceinline__ float bf2f(bf16_t v) { return __uint_as_float(((unsigned)v) << 16); }
__device__ __forceinline__ bf16_t f2bf(float f) { unsigned u = __float_as_uint(f); u += 0x7FFFu + ((u >> 16) & 1u); return (bf16_t)(u >> 16); }
__device__ __forceinline__ unsigned pk2(float lo, float hi) { return (unsigned)f2bf(lo) | ((unsigned)f2bf(hi) << 16); }
__device__ __forceinline__ float silu_f(float v) { return v / (1.0f + __expf(-v)); }
__device__ __forceinline__ float wave_sum(float v) {
#pragma unroll
    for (int o = 32; o > 0; o >>= 1) v += __shfl_xor(v, o);
    return v;
}
__device__ __forceinline__ void unpack8(const u32x4 w, float (&f)[8]) {
    f[0] = __uint_as_float(w.x << 16); f[1] = __uint_as_float(w.x & 0xFFFF0000u); f[2] = __uint_as_float(w.y << 16); f[3] = __uint_as_float(w.y & 0xFFFF0000u);
    f[4] = __uint_as_float(w.z << 16); f[5] = __uint_as_float(w.z & 0xFFFF0000u); f[6] = __uint_as_float(w.w << 16); f[7] = __uint_as_float(w.w & 0xFFFF0000u);
}
__device__ __forceinline__ int mod_vec(int r) { return r < hk::TL ? (r >> 14) : 2; }
#define MODP(ws, l, mv, k) ((const float*)((ws) + hk::WS_MOD) + ((size_t)((l) * 3 + (mv)) * 6 + (k)) * 2048)
__device__ __forceinline__ void ph_mod(const Params& p, unsigned char* ldsb) {
    float* svec = (float*)ldsb; float* red = svec + 3 * 2048;
    const int tid = threadIdx.x;
    const float* c = p.in[hk::I_C]; const float* cc = p.in[hk::I_CCTX];
    for (int i = tid; i < 3 * 2048; i += 512) { const float v = i < 4096 ? c[i] : cc[i - 4096]; svec[i] = v / (1.0f + expf(-v)); }
    __syncthreads();
    float* MOD = (float*)(p.ws + hk::WS_MOD);
    for (int slab = blockIdx.x; slab < 768; slab += gridDim.x) {
        const int l = slab / 384, j0 = (slab % 384) * 32;
        const float* W = p.in[hk::I_MODW] + (size_t)l * 2048 * 12288;
        const int cq = tid & 7, rg = tid >> 3;
        float acc[3][4];
#pragma unroll
        for (int v = 0; v < 3; ++v)
#pragma unroll
            for (int j = 0; j < 4; ++j) acc[v][j] = 0.f;
#pragma unroll 4
        for (int i = 0; i < 32; ++i) {
            const int r = rg + 64 * i;
            const f32x4 w = *(const f32x4*)(W + (size_t)r * 12288 + j0 + cq * 4);
#pragma unroll
            for (int v = 0; v < 3; ++v) { const float s = svec[v * 2048 + r];
#pragma unroll
                for (int j = 0; j < 4; ++j) acc[v][j] += s * w[j]; }
        }
#pragma unroll
        for (int v = 0; v < 3; ++v)
#pragma unroll
            for (int j = 0; j < 4; ++j) red[tid * 12 + v * 4 + j] = acc[v][j];
        __syncthreads();
        if (tid < 96) {
            const int v = tid >> 5, col = tid & 31, q = col >> 2, j = col & 3;
            float s = 0.f;
            for (int g = 0; g < 64; ++g) s += red[(g * 8 + q) * 12 + v * 4 + j];
            const int jj = j0 + col;
            MOD[(size_t)(l * 3 + v) * 12288 + jj] = s + p.in[hk::I_MODB][l * 12288 + jj];
        }
        __syncthreads();
    }
}

__device__ __forceinline__ void conv_mat(const float* src, int ld, int K, int ncol0, int nvalid, int npad, bf16_t* dst, int Kd, int mode, unsigned char* ldsb) {
    float* tile = (float*)ldsb;
    const int tid = threadIdx.x, nkt = K / 64, ntile = nkt * (npad / 64);
    for (int t = blockIdx.x; t < ntile; t += gridDim.x) {
        const int kt = t % nkt, nt = t / nkt, k0 = kt * 64, n0 = nt * 64;
#pragma unroll
        for (int it = 0; it < 2; ++it) {
            const int r = (tid >> 4) + 32 * it, c4 = (tid & 15) * 4;
            f32x4 v = (f32x4){0.f, 0.f, 0.f, 0.f};
            if (n0 + c4 < nvalid) v = *(const f32x4*)(src + (size_t)(k0 + r) * ld + ncol0 + n0 + c4);
            tile[r * 65 + c4 + 0] = v[0]; tile[r * 65 + c4 + 1] = v[1]; tile[r * 65 + c4 + 2] = v[2]; tile[r * 65 + c4 + 3] = v[3];
        }
        __syncthreads();
        {
            const int n = tid >> 3, kq = tid & 7;
            float f[8];
#pragma unroll
            for (int j = 0; j < 8; ++j) f[j] = tile[(kq * 8 + j) * 65 + n];
            int drow = n0 + n;
            if (mode != 0) drow = 256 * (n0 >> 7) + (n0 & 127) + n + (mode == 2 ? 128 : 0);
            u32x4 w; w.x = pk2(f[0], f[1]); w.y = pk2(f[2], f[3]); w.z = pk2(f[4], f[5]); w.w = pk2(f[6], f[7]);
            *(u32x4*)(dst + (size_t)drow * Kd + k0 + kq * 8) = w;
        }
        __syncthreads();
    }
}
__device__ __forceinline__ void ph_conv_experts(const Params& p, int layer, unsigned char* ldsb) {
    bf16_t* GU = (bf16_t*)(p.ws + hk::WS_WE); bf16_t* DN = (bf16_t*)(p.ws + hk::WS_WE_DN);
    for (int e = 0; e < 16; ++e) {
        const size_t eo = ((size_t)layer * 16 + e) * 2048 * 1024;
        conv_mat(p.in[hk::I_EG] + eo, 1024, 2048, 0, 1024, 1024, GU + (size_t)e * 2048 * 2048, 2048, 1, ldsb);
        conv_mat(p.in[hk::I_EU] + eo, 1024, 2048, 0, 1024, 1024, GU + (size_t)e * 2048 * 2048, 2048, 2, ldsb);
        conv_mat(p.in[hk::I_ED] + eo, 2048, 1024, 0, 2048, 2048, DN + (size_t)e * 2048 * 1024, 1024, 0, ldsb);
    }
}
__device__ __forceinline__ void ph_conv_weights(const Params& p, unsigned char* ldsb) {
    unsigned char* ws = p.ws;
    conv_mat(p.in[hk::I_ABIN], 6176, 2048, 0, 3072, 3072, (bf16_t*)(ws + hk::WS_WU), 2048, 0, ldsb);
    conv_mat(p.in[hk::I_ABIN], 6176, 2048, 3072, 3104, 3328, (bf16_t*)(ws + hk::WS_WGLA), 2048, 0, ldsb);
    conv_mat(p.in[hk::I_ABOUT], 2048, 2048, 0, 2048, 2048, (bf16_t*)(ws + hk::WS_WOUT0), 2048, 0, ldsb);
    conv_mat(p.in[hk::I_SWIN], 10368, 2048, 0, 10368, 10496, (bf16_t*)(ws + hk::WS_WSSDIN), 2048, 0, ldsb);
    conv_mat(p.in[hk::I_SWOUT], 2048, 4096, 0, 2048, 2048, (bf16_t*)(ws + hk::WS_WOUT1), 4096, 0, ldsb);
    bf16_t* W3T = (bf16_t*)(ws + hk::WS_W3T); const float* w3 = p.in[hk::I_FW3];
    for (int i = blockIdx.x * 512 + threadIdx.x; i < 4096 * 32; i += gridDim.x * 512) {
        const int col = i >> 5, k8 = (i & 31) * 8;
        u32x4 w = (u32x4){0u, 0u, 0u, 0u};
        if (k8 < 64) { float f[8];
#pragma unroll
            for (int j = 0; j < 8; ++j) f[j] = w3[(size_t)(k8 + j) * 4096 + col];
            w.x = pk2(f[0], f[1]); w.y = pk2(f[2], f[3]); w.z = pk2(f[4], f[5]); w.w = pk2(f[6], f[7]); }
        *(u32x4*)(W3T + (size_t)col * 256 + k8) = w;
    }
}
__device__ __forceinline__ void ph_hid(const Params& p, unsigned char* ldsb) {
    float* w1 = (float*)ldsb; float* b1 = w1 + 33 * 64; float* fr1 = b1 + 64; float* w2 = fr1 + 64; float* b2 = w2 + 64 * 64; float* fr2 = b2 + 64; float* h1 = fr2 + 64;
    const int tid = threadIdx.x;
    for (int i = tid; i < 33 * 64; i += 512) w1[i] = p.in[hk::I_FW1][i];
    for (int i = tid; i < 64 * 64; i += 512) w2[i] = p.in[hk::I_FW2][i];
    if (tid < 64) { b1[tid] = p.in[hk::I_FB1][tid]; fr1[tid] = p.in[hk::I_FFR1][tid]; b2[tid] = p.in[hk::I_FB2][tid]; fr2[tid] = p.in[hk::I_FFR2][tid]; }
    __syncthreads();
    const int j = tid & 63, pl = tid >> 6;
    bf16_t* HID2 = (bf16_t*)(p.ws + hk::WS_HID2); bf16_t* HID2C = (bf16_t*)(p.ws + hk::WS_HID2C);
    for (int pg = blockIdx.x; pg < (16384 + 256) / 8; pg += gridDim.x) {
        const int pid = pg * 8 + pl;
        const bool lat = pid < 16384; const int L = lat ? 16384 : 256, pos = lat ? pid : pid - 16384;
        const float t = (float)pos / (float)(L - 1);
        float s = b1[j] + t * w1[j];
        for (int b = 0; b < 16; ++b) {
            const float band = 1e-4f + (float)b * ((15.0f - 1e-4f) / 15.0f);
            float turns = band * (float)pos / (float)L; turns -= floorf(turns);
            const float ang = 6.283185307179586f * turns;
            s += cosf(ang) * w1[(1 + b) * 64 + j] - sinf(ang) * w1[(17 + b) * 64 + j];
        }
        h1[pl * 64 + j] = sinf(fr1[j] * s);
        __syncthreads();
        float s2 = b2[j];
        for (int i = 0; i < 64; ++i) s2 += h1[pl * 64 + i] * w2[i * 64 + j];
        const float v = sinf(fr2[j] * s2);
        bf16_t* row = (lat ? HID2 : HID2C) + (size_t)pos * 256;
        row[j] = f2bf(v); row[64 + j] = 0; row[128 + j] = 0; row[192 + j] = 0;
        __syncthreads();
    }
}
__device__ __forceinline__ void ph_modulate0(const Params& p) {
    const int lane = threadIdx.x & 63, wave = threadIdx.x >> 6;
    bf16_t* HA = (bf16_t*)(p.ws + hk::WS_ACT + hk::A_HA);
    for (int r = blockIdx.x * 8 + wave; r < hk::TA; r += gridDim.x * 8) {
        const int mv = mod_vec(r);
        const float* xin = r < hk::TL ? p.in[hk::I_X] + (size_t)r * 2048 : p.in[hk::I_CTX] + (size_t)(r - hk::TL) * 2048;
        const float* sh = MODP(p.ws, 0, mv, 0); const float* sc = MODP(p.ws, 0, mv, 1);
#pragma unroll
        for (int i = 0; i < 8; ++i) {
            const int j = 4 * (lane + 64 * i);
            const f32x4 x = *(const f32x4*)(xin + j), a = *(const f32x4*)(sc + j), b = *(const f32x4*)(sh + j);
            u32x2 w; w.x = pk2(x[0] * (1.f + a[0]) + b[0], x[1] * (1.f + a[1]) + b[1]); w.y = pk2(x[2] * (1.f + a[2]) + b[2], x[3] * (1.f + a[3]) + b[3]);
            *(u32x2*)(HA + (size_t)r * 2048 + j) = w;
        }
    }
}

__device__ __forceinline__ void ph_ln1_router(const Params& p, int layer, unsigned char* ldsb, const bf16_t* YO, bf16_t* TOK) {
    float* rwT = (float*)ldsb; int* lcnt = (int*)(ldsb + 131072); int* lbase = lcnt + 16;
    const int tid = threadIdx.x, lane = tid & 63, wave = tid >> 6;
    const int T = layer == 0 ? hk::TA : hk::TL;
    for (int i = tid; i < 2048 * 16; i += 512) { const int j = i >> 4, e = i & 15; rwT[e * 2048 + j] = p.in[hk::I_RW][i]; }
    if (tid < 16) lcnt[tid] = 0;
    __syncthreads();
    float* CTXS = (float*)(p.ws + hk::WS_CTXS);
    int* EXPERT = (int*)(p.ws + hk::WS_MISC + hk::MISC_EXP); float* GATE = (float*)(p.ws + hk::WS_MISC + hk::MISC_GATE); int* SLOT = (int*)(p.ws + hk::WS_MISC + hk::MISC_SLOT);
    const float* lng = p.in[hk::I_LNG] + (size_t)(layer * 2 + 0) * 2048; const float* lnb = p.in[hk::I_LNB] + (size_t)(layer * 2 + 0) * 2048;
    const float* rb = p.in[hk::I_RB];
    for (int r = blockIdx.x * 8 + wave; r < T; r += gridDim.x * 8) {
        const int mv = mod_vec(r);
        const float* xin; float* xout;
        if (r < hk::TL) { xin = (layer == 0 ? p.in[hk::I_X] : p.out) + (size_t)r * 2048; xout = p.out + (size_t)r * 2048; }
        else { xin = (layer == 0 ? p.in[hk::I_CTX] : CTXS) + (size_t)(r - hk::TL) * 2048; xout = CTXS + (size_t)(r - hk::TL) * 2048; }
        const float* g1 = MODP(p.ws, layer, mv, 2); const float* sh2 = MODP(p.ws, layer, mv, 3); const float* sc2 = MODP(p.ws, layer, mv, 4);
        float sum = 0.f, sq = 0.f;
#pragma unroll
        for (int i = 0; i < 8; ++i) {
            const int j = 4 * (lane + 64 * i);
            const f32x4 x = *(const f32x4*)(xin + j), g = *(const f32x4*)(g1 + j);
            const u32x2 yw = *(const u32x2*)(YO + (size_t)r * 2048 + j);
            const float y0 = __uint_as_float(yw.x << 16), y1 = __uint_as_float(yw.x & 0xFFFF0000u), y2 = __uint_as_float(yw.y << 16), y3 = __uint_as_float(yw.y & 0xFFFF0000u);
            const float v0 = hk::ALPHA * x[0] + g[0] * y0, v1 = hk::ALPHA * x[1] + g[1] * y1, v2 = hk::ALPHA * x[2] + g[2] * y2, v3 = hk::ALPHA * x[3] + g[3] * y3;
            sum += (v0 + v1) + (v2 + v3); sq += (v0 * v0 + v1 * v1) + (v2 * v2 + v3 * v3);
        }
        const float mean = wave_sum(sum) * (1.0f / 2048.0f);
        const float var = fmaxf(wave_sum(sq) * (1.0f / 2048.0f) - mean * mean, 0.f);
        const float rstd = rsqrtf(var + hk::LN_EPS);
        float lg[16];
#pragma unroll
        for (int e = 0; e < 16; ++e) lg[e] = 0.f;
#pragma unroll 1
        for (int i = 0; i < 8; ++i) {
            const int j = 4 * (lane + 64 * i);
            const f32x4 x = *(const f32x4*)(xin + j), gg = *(const f32x4*)(g1 + j);
            const u32x2 yw = *(const u32x2*)(YO + (size_t)r * 2048 + j);
            const float y0 = __uint_as_float(yw.x << 16), y1 = __uint_as_float(yw.x & 0xFFFF0000u), y2 = __uint_as_float(yw.y << 16), y3 = __uint_as_float(yw.y & 0xFFFF0000u);
            const f32x4 v = (f32x4){hk::ALPHA * x[0] + gg[0] * y0, hk::ALPHA * x[1] + gg[1] * y1, hk::ALPHA * x[2] + gg[2] * y2, hk::ALPHA * x[3] + gg[3] * y3};
            const f32x4 g = *(const f32x4*)(lng + j), b = *(const f32x4*)(lnb + j), a2 = *(const f32x4*)(sc2 + j), b2 = *(const f32x4*)(sh2 + j);
            f32x4 xn, tk;
#pragma unroll
            for (int q = 0; q < 4; ++q) { xn[q] = (v[q] - mean) * rstd * g[q] + b[q]; tk[q] = xn[q] * (1.f + a2[q]) + b2[q]; }
            *(f32x4*)(xout + j) = xn;
            u32x2 w; w.x = pk2(tk[0], tk[1]); w.y = pk2(tk[2], tk[3]);
            *(u32x2*)(TOK + (size_t)r * 2048 + j) = w;
#pragma unroll
            for (int e = 0; e < 16; ++e) { const f32x4 rw = *(const f32x4*)(rwT + e * 2048 + j); lg[e] += (tk[0] * rw[0] + tk[1] * rw[1]) + (tk[2] * rw[2] + tk[3] * rw[3]); }
        }
#pragma unroll
        for (int e = 0; e < 16; ++e) lg[e] = wave_sum(lg[e]);
        float sc[16], sel[16];
#pragma unroll
        for (int e = 0; e < 16; ++e) { sc[e] = 1.0f / (1.0f + expf(-lg[e])); sel[e] = sc[e] + rb[e]; }
        int grp = 0; float best = -1e30f;
#pragma unroll
        for (int g = 0; g < 4; ++g) {
            float m1 = -1e30f, m2 = -1e30f;
#pragma unroll
            for (int q = 0; q < 4; ++q) { const float s = sel[g * 4 + q]; if (s > m1) { m2 = m1; m1 = s; } else if (s > m2) m2 = s; }
            const float gs = m1 + m2; if (gs > best) { best = gs; grp = g; }
        }
        float s4[4], u4[4];
#pragma unroll
        for (int q = 0; q < 4; ++q) { s4[q] = grp == 0 ? sel[q] : grp == 1 ? sel[4 + q] : grp == 2 ? sel[8 + q] : sel[12 + q]; u4[q] = grp == 0 ? sc[q] : grp == 1 ? sc[4 + q] : grp == 2 ? sc[8 + q] : sc[12 + q]; }
        int i1 = 0; float b1 = s4[0];
#pragma unroll
        for (int q = 1; q < 4; ++q) if (s4[q] > b1) { b1 = s4[q]; i1 = q; }
        int i2 = -1; float b2v = -1e30f;
#pragma unroll
        for (int q = 0; q < 4; ++q) if (q != i1 && s4[q] > b2v) { b2v = s4[q]; i2 = q; }
        const float ga = i1 == 0 ? u4[0] : i1 == 1 ? u4[1] : i1 == 2 ? u4[2] : u4[3];
        const float gb = i2 == 0 ? u4[0] : i2 == 1 ? u4[1] : i2 == 2 ? u4[2] : u4[3];
        const float inv = 1.0f / (ga + gb);
        if (lane == 0) {
            const int e1 = grp * 4 + i1, e2 = grp * 4 + i2;
            const int s1 = atomicAdd(&lcnt[e1], 1), s2 = atomicAdd(&lcnt[e2], 1);
            EXPERT[2 * r] = e1; EXPERT[2 * r + 1] = e2; GATE[2 * r] = ga * inv; GATE[2 * r + 1] = gb * inv; SLOT[2 * r] = s1; SLOT[2 * r + 1] = s2;
        }
    }
    __syncthreads();
    unsigned* gcnt = (unsigned*)(p.ws + hk::WS_CTL) + hk::CW_CNT + layer * 64;
    if (tid < 16) lbase[tid] = (int)atomicAdd(&gcnt[tid], (unsigned)lcnt[tid]);
    __syncthreads();
    for (int r = blockIdx.x * 8 + wave; r < T; r += gridDim.x * 8) {
        if (lane == 0) { SLOT[2 * r] += lbase[EXPERT[2 * r]]; SLOT[2 * r + 1] += lbase[EXPERT[2 * r + 1]]; }
    }
}

__device__ __forceinline__ void expert_starts(const unsigned* gcnt, int (&pstart)[17]) {
    int acc = 0;
#pragma unroll
    for (int e = 0; e < 16; ++e) { pstart[e] = acc; acc += (int)((__hip_atomic_load(gcnt + e, __ATOMIC_RELAXED, __HIP_MEMORY_SCOPE_AGENT) + 255u) & ~255u); }
    pstart[16] = acc;
}
__device__ __forceinline__ void ph_dispatch(const Params& p, int layer, const bf16_t* TOK, bf16_t* AG) {
    const int tid = threadIdx.x, lane = tid & 63, wave = tid >> 6;
    const int T = layer == 0 ? hk::TA : hk::TL;
    unsigned* ctl = (unsigned*)(p.ws + hk::WS_CTL);
    int pstart[17]; expert_starts(ctl + hk::CW_CNT + layer * 64, pstart);
    if (blockIdx.x == 0) {
        const int nt = pstart[16] >> 8;
        if (tid == 0) ctl[hk::CW_NT + layer * 64] = (unsigned)nt;
        for (int rt = tid; rt < nt; rt += 512) { int e = 0;
#pragma unroll
            for (int q = 1; q < 16; ++q) if (rt * 256 >= pstart[q]) e = q;
            ctl[hk::CW_TILEE + layer * 320 + rt] = (unsigned)e; }
    }
    const int* EXPERT = (const int*)(p.ws + hk::WS_MISC + hk::MISC_EXP); const int* SLOT = (const int*)(p.ws + hk::WS_MISC + hk::MISC_SLOT); int* DEST = (int*)(p.ws + hk::WS_MISC + hk::MISC_DEST);
    for (int r = blockIdx.x * 8 + wave; r < T; r += gridDim.x * 8) {
#pragma unroll
        for (int k = 0; k < 2; ++k) {
            const int e = EXPERT[2 * r + k], s = SLOT[2 * r + k];
            int ps = 0;
#pragma unroll
            for (int q = 0; q < 16; ++q) ps = (e == q) ? pstart[q] : ps;
            const int d = ps + s;
            if (lane == 0) DEST[2 * r + k] = d;
#pragma unroll
            for (int i = 0; i < 4; ++i) *(u32x4*)(AG + (size_t)d * 2048 + 8 * (lane + 64 * i)) = *(const u32x4*)(TOK + (size_t)r * 2048 + 8 * (lane + 64 * i));
        }
    }
}

__device__ __forceinline__ void ph_ln2(const Params& p, int layer, const bf16_t* YR, bf16_t* HNEXT) {
    const int lane = threadIdx.x & 63, wave = threadIdx.x >> 6;
    const int T = layer == 0 ? hk::TA : hk::TL;
    float* CTXS = (float*)(p.ws + hk::WS_CTXS);
    const int* DEST = (const int*)(p.ws + hk::WS_MISC + hk::MISC_DEST); const float* GATE = (const float*)(p.ws + hk::WS_MISC + hk::MISC_GATE);
    const float* lng = p.in[hk::I_LNG] + (size_t)(layer * 2 + 1) * 2048; const float* lnb = p.in[hk::I_LNB] + (size_t)(layer * 2 + 1) * 2048;
    for (int r = blockIdx.x * 8 + wave; r < T; r += gridDim.x * 8) {
        const int mv = mod_vec(r);
        float* xio = r < hk::TL ? p.out + (size_t)r * 2048 : CTXS + (size_t)(r - hk::TL) * 2048;
        const float* g2 = MODP(p.ws, layer, mv, 5);
        const int d0 = DEST[2 * r], d1 = DEST[2 * r + 1]; const float w0 = GATE[2 * r], w1 = GATE[2 * r + 1];
        float v[32]; float sum = 0.f;
#pragma unroll
        for (int i = 0; i < 8; ++i) {
            const int j = 4 * (lane + 64 * i);
            const f32x4 x = *(const f32x4*)(xio + j), g = *(const f32x4*)(g2 + j);
            const u32x2 ya = *(const u32x2*)(YR + (size_t)d0 * 2048 + j), yb = *(const u32x2*)(YR + (size_t)d1 * 2048 + j);
            float y[4];
            y[0] = w0 * __uint_as_float(ya.x << 16) + w1 * __uint_as_float(yb.x << 16); y[1] = w0 * __uint_as_float(ya.x & 0xFFFF0000u) + w1 * __uint_as_float(yb.x & 0xFFFF0000u);
            y[2] = w0 * __uint_as_float(ya.y << 16) + w1 * __uint_as_float(yb.y << 16); y[3] = w0 * __uint_as_float(ya.y & 0xFFFF0000u) + w1 * __uint_as_float(yb.y & 0xFFFF0000u);
#pragma unroll
            for (int q = 0; q < 4; ++q) { v[4 * i + q] = hk::ALPHA * x[q] + g[q] * y[q]; sum += v[4 * i + q]; }
        }
        const float mean = wave_sum(sum) * (1.0f / 2048.0f);
        float sq = 0.f;
#pragma unroll
        for (int k = 0; k < 32; ++k) { const float d = v[k] - mean; sq += d * d; }
        const float rstd = rsqrtf(wave_sum(sq) * (1.0f / 2048.0f) + hk::LN_EPS);
        const float* sh = MODP(p.ws, 1, mv, 0); const float* sc = MODP(p.ws, 1, mv, 1);
#pragma unroll
        for (int i = 0; i < 8; ++i) {
            const int j = 4 * (lane + 64 * i);
            const f32x4 g = *(const f32x4*)(lng + j), b = *(const f32x4*)(lnb + j);
            f32x4 xn;
#pragma unroll
            for (int q = 0; q < 4; ++q) xn[q] = (v[4 * i + q] - mean) * rstd * g[q] + b[q];
            *(f32x4*)(xio + j) = xn;
            if (layer == 0) {
                const f32x4 a = *(const f32x4*)(sc + j), bb = *(const f32x4*)(sh + j);
                u32x2 w; w.x = pk2(xn[0] * (1.f + a[0]) + bb[0], xn[1] * (1.f + a[1]) + bb[1]); w.y = pk2(xn[2] * (1.f + a[2]) + bb[2], xn[3] * (1.f + a[3]) + bb[3]);
                *(u32x2*)(HNEXT + (size_t)r * 2048 + j) = w;
            }
        }
    }
}
__device__ __forceinline__ void ph_gla_scan_naive(const Params& p, unsigned char* ldsb) {
    float* w2s = (float*)ldsb;
    float* bs = w2s + 16 * 128;
    float* qs = bs + 128;
    float* ks = qs + 32 * 128; float* as = ks + 32 * 128;
    float* vv = as + 32 * 128;
    float* part = vv + 32 * 16;
    const int tid = threadIdx.x, lane = tid & 63, wave = tid >> 6;
    const bf16_t* GL = (const bf16_t*)(p.ws + hk::WS_ACT + hk::A_GL);
    for (int it = blockIdx.x; it < 256; it += gridDim.x) {
        const int b = it >> 7, dir = (it >> 6) & 1, h = (it >> 4) & 3, vs = it & 15;
        float* OUT = (float*)(p.ws + hk::WS_ACT + (dir == 0 ? hk::A_OF : hk::A_OB));
        __syncthreads();
        for (int i = tid; i < 16 * 128; i += 512) { const int r = i >> 7, kk = i & 127; w2s[i] = p.in[hk::I_GW2][(size_t)(dir * 16 + r) * 512 + h * 128 + kk]; }
        if (tid < 128) bs[tid] = p.in[hk::I_GB][dir * 512 + h * 128 + tid];
        __syncthreads();
        const int v = tid & 15, kg = tid >> 4;
        float S[4] = {0.f, 0.f, 0.f, 0.f};
        for (int seg = 0; seg < 2; ++seg) {
            const int n = seg == 0 ? hk::CTXL : hk::SEQ, rowbase = seg == 0 ? hk::TL + b * hk::CTXL : b * hk::SEQ;
            for (int t0 = 0; t0 < n; t0 += 32) {
                for (int idx = tid; idx < 32 * 128; idx += 512) {
                    const int s = idx >> 7, kk = idx & 127, tt = t0 + s, t = dir == 0 ? tt : n - 1 - tt;
                    const bf16_t* row = GL + (size_t)(rowbase + t) * hk::GL_LD;
                    qs[idx] = bf2f(row[h * 128 + kk]) * 0.08838834764831845f;
                    ks[idx] = bf2f(row[512 + h * 128 + kk]);
                    float z = bs[kk];
#pragma unroll
                    for (int r = 0; r < 16; ++r) z += bf2f(row[3072 + dir * 16 + r]) * w2s[r * 128 + kk];
                    const float ls = z >= 0.f ? -log1pf(expf(-z)) : z - log1pf(expf(z));
                    as[idx] = expf(ls * (1.0f / 16.0f));
                }
                { const int s = tid >> 4, tt = t0 + s, t = dir == 0 ? tt : n - 1 - tt;
                  vv[tid] = bf2f(GL[(size_t)(rowbase + t) * hk::GL_LD + 1024 + h * 256 + vs * 16 + v]); }
                __syncthreads();
#pragma unroll 4
                for (int s = 0; s < 32; ++s) {
                    const f32x4 a4 = *(const f32x4*)(as + s * 128 + kg * 4), k4 = *(const f32x4*)(ks + s * 128 + kg * 4), q4 = *(const f32x4*)(qs + s * 128 + kg * 4);
                    const float vval = vv[s * 16 + v];
                    float o = 0.f;
#pragma unroll
                    for (int i = 0; i < 4; ++i) { S[i] = a4[i] * S[i] + k4[i] * vval; o += q4[i] * S[i]; }
                    o += __shfl_xor(o, 16); o += __shfl_xor(o, 32);
                    if (lane < 16) part[(s * 8 + wave) * 16 + lane] = o;
                }
                __syncthreads();
                { const int s = tid >> 4, tt = t0 + s, t = dir == 0 ? tt : n - 1 - tt;
                  float o = 0.f;
#pragma unroll
                  for (int w = 0; w < 8; ++w) o += part[(s * 8 + w) * 16 + v];
                  OUT[(size_t)(rowbase + t) * 1024 + h * 256 + vs * 16 + v] = o; }
                __syncthreads();
            }
        }
    }
}
__device__ __forceinline__ void ph_mix_finish(const Params& p, unsigned char* ldsb) {
    const int tid = threadIdx.x, lane = tid & 63, wave = tid >> 6;
    const float* OF = (const float*)(p.ws + hk::WS_ACT + hk::A_OF); const float* OB = (const float*)(p.ws + hk::WS_ACT + hk::A_OB);
    const bf16_t* GL = (const bf16_t*)(p.ws + hk::WS_ACT + hk::A_GL);
    bf16_t* MIX = (bf16_t*)(p.ws + hk::WS_ACT + hk::A_HA);
    const float* ng = p.in[hk::I_GNG];
    for (int r = blockIdx.x * 8 + wave; r < hk::TA; r += gridDim.x * 8) {
        float o[16]; float ss = 0.f;
#pragma unroll
        for (int i = 0; i < 4; ++i) {
            const f32x4 a = *(const f32x4*)(OF + (size_t)r * 1024 + lane * 16 + 4 * i), bq = *(const f32x4*)(OB + (size_t)r * 1024 + lane * 16 + 4 * i);
#pragma unroll
            for (int q = 0; q < 4; ++q) { o[4 * i + q] = a[q] + bq[q]; ss += o[4 * i + q] * o[4 * i + q]; }
        }
        ss += __shfl_xor(ss, 1); ss += __shfl_xor(ss, 2); ss += __shfl_xor(ss, 4); ss += __shfl_xor(ss, 8);
        const float rs = rsqrtf(ss * (1.0f / 256.0f) + hk::LN_EPS);
        const u32x4 r0 = *(const u32x4*)(GL + (size_t)r * hk::GL_LD + 2048 + lane * 16), r1 = *(const u32x4*)(GL + (size_t)r * hk::GL_LD + 2048 + lane * 16 + 8);
        float rr[16]; { float t8[8]; unpack8(r0, t8);
#pragma unroll
            for (int q = 0; q < 8; ++q) rr[q] = t8[q]; unpack8(r1, t8);
#pragma unroll
            for (int q = 0; q < 8; ++q) rr[8 + q] = t8[q]; }
        float f[16];
#pragma unroll
        for (int q = 0; q < 16; ++q) f[q] = o[q] * rs * ng[lane * 16 + q] * silu_f(rr[q]);
        u32x4 w0, w1; w0.x = pk2(f[0], f[1]); w0.y = pk2(f[2], f[3]); w0.z = pk2(f[4], f[5]); w0.w = pk2(f[6], f[7]); w1.x = pk2(f[8], f[9]); w1.y = pk2(f[10], f[11]); w1.z = pk2(f[12], f[13]); w1.w = pk2(f[14], f[15]);
        *(u32x4*)(MIX + (size_t)r * 2048 + 1024 + lane * 16) = w0; *(u32x4*)(MIX + (size_t)r * 2048 + 1024 + lane * 16 + 8) = w1;
    }
    const bf16_t* YT = (const bf16_t*)(p.ws + hk::WS_ACT + hk::A_YT);
    bf16_t* tile = (bf16_t*)ldsb;
    __syncthreads();
    for (int t = blockIdx.x; t < 16 * (hk::TA / 64); t += gridDim.x) {
        const int ct = t & 15, tt = t >> 4, c0 = ct * 64, tok0 = tt * 64;
        { const int c = tid >> 3, q = tid & 7;
          const u32x4 w = *(const u32x4*)(YT + (size_t)(c0 + c) * hk::TA + tok0 + q * 8);
          unsigned* dstw = (unsigned*)(tile + c * 66 + q * 8);
          dstw[0] = w.x; dstw[1] = w.y; dstw[2] = w.z; dstw[3] = w.w; }
        __syncthreads();
        { const int tk = tid >> 3, q = tid & 7;
          bf16_t e[8];
#pragma unroll
          for (int j = 0; j < 8; ++j) e[j] = tile[(q * 8 + j) * 66 + tk];
          u32x4 w; w.x = e[0] | ((unsigned)e[1] << 16); w.y = e[2] | ((unsigned)e[3] << 16); w.z = e[4] | ((unsigned)e[5] << 16); w.w = e[6] | ((unsigned)e[7] << 16);
          *(u32x4*)(MIX + (size_t)(tok0 + tk) * 2048 + c0 + q * 8) = w; }
        __syncthreads();
    }
}
namespace hy {
constexpr int PADF = 1024, L = 16384;
__device__ __forceinline__ float sconv(const bf16_t* row, int t, int n, float w0, float w1, float w2, float bias) {
    const float a = t > 0 ? bf2f(row[t - 1]) : 0.f, b = bf2f(row[t]), c = t + 1 < n ? bf2f(row[t + 1]) : 0.f;
    return w0 * a + w1 * b + w2 * c + bias;
}
template <int SGN> __device__ __forceinline__ void lconv8(const float* u, const bf16_t* f, int t0, int trips, float (&acc)[8]) {
    float W[16];
    if (SGN > 0) {
#pragma unroll
        for (int x = 0; x < 8; ++x) W[8 + x] = u[PADF + t0 + x];
        for (int it = 0; it < trips; ++it) {
            const int d0 = it * 8;
            const f32x4 lo0 = *(const f32x4*)(u + PADF + t0 - d0 - 8), lo1 = *(const f32x4*)(u + PADF + t0 - d0 - 4);
            W[0] = lo0[0]; W[1] = lo0[1]; W[2] = lo0[2]; W[3] = lo0[3]; W[4] = lo1[0]; W[5] = lo1[1]; W[6] = lo1[2]; W[7] = lo1[3];
            float fe[8]; unpack8(*(const u32x4*)(f + d0), fe);
#pragma unroll
            for (int e = 0; e < 8; ++e)
#pragma unroll
                for (int i = 0; i < 8; ++i) acc[i] += fe[e] * W[8 + i - e];
#pragma unroll
            for (int x = 0; x < 8; ++x) W[8 + x] = W[x];
        }
    } else {
#pragma unroll
        for (int x = 0; x < 8; ++x) W[x] = u[PADF + t0 + x];
        for (int it = 0; it < trips; ++it) {
            const int d0 = it * 8;
            const f32x4 hi0 = *(const f32x4*)(u + PADF + t0 + d0 + 8), hi1 = *(const f32x4*)(u + PADF + t0 + d0 + 12);
            W[8] = hi0[0]; W[9] = hi0[1]; W[10] = hi0[2]; W[11] = hi0[3]; W[12] = hi1[0]; W[13] = hi1[1]; W[14] = hi1[2]; W[15] = hi1[3];
            float fe[8]; unpack8(*(const u32x4*)(f + d0), fe);
#pragma unroll
            for (int e = 0; e < 8; ++e)
#pragma unroll
                for (int i = 0; i < 8; ++i) acc[i] += fe[e] * W[i + e];
#pragma unroll
            for (int x = 0; x < 8; ++x) W[x] = W[8 + x];
        }
    }
}
}
__device__ __forceinline__ void ph_hyena_naive(const Params& p, unsigned char* ldsb) {
    using namespace hy;
    float* u = (float*)ldsb;
    bf16_t* f = (bf16_t*)(u + (PADF + L + PADF));
    float* tmp = (float*)(p.ws + hk::WS_ACT + hk::A_HYTMP) + (size_t)blockIdx.x * L;
    const int tid = threadIdx.x, wave = tid >> 6;
    const bf16_t* UT = (const bf16_t*)(p.ws + hk::WS_ACT + hk::A_UT);
    const bf16_t* HF = (const bf16_t*)(p.ws + hk::WS_ACT + hk::A_HF); const bf16_t* HFC = (const bf16_t*)(p.ws + hk::WS_ACT + hk::A_HFC);
    bf16_t* YT = (bf16_t*)(p.ws + hk::WS_ACT + hk::A_YT);
    const float* cw = p.in[hk::I_HCW]; const float* cb = p.in[hk::I_HCB]; const float* lb = p.in[hk::I_HLB];
    for (int c = blockIdx.x; c < 1024; c += gridDim.x) {
        const float delta = fabsf(-3.0701134573253945f + (-15.350567286626973f + 3.0701134573253945f) * ((float)c / 1023.0f));
        float wv[3][4];
#pragma unroll
        for (int q = 0; q < 3; ++q) { wv[q][0] = cw[0 * 3072 + q * 1024 + c]; wv[q][1] = cw[1 * 3072 + q * 1024 + c]; wv[q][2] = cw[2 * 3072 + q * 1024 + c]; wv[q][3] = cb[q * 1024 + c]; }
        const bf16_t* rv = UT + (size_t)c * hk::TA; const bf16_t* r1 = UT + (size_t)(1024 + c) * hk::TA; const bf16_t* r2 = UT + (size_t)(2048 + c) * hk::TA;
        for (int b = 0; b < 2; ++b) {
            const int base = b * L;
            __syncthreads();
            for (int i = tid; i < PADF; i += 512) { u[i] = 0.f; u[PADF + L + i] = 0.f; }
            for (int t = tid; t < L; t += 512) u[PADF + t] = sconv(rv + base, t, L, wv[0][0], wv[0][1], wv[0][2], wv[0][3]);
            for (int o = 0; o < 2; ++o) {
                __syncthreads();
                for (int dir = 0; dir < 2; ++dir) {
                    const bf16_t* hrow = HF + (size_t)((o * 2 + dir) * 1024 + c) * L;
                    for (int m = tid; m < L; m += 512) f[dir * L + m] = (dir == 1 && m == 0) ? (bf16_t)0 : f2bf(bf2f(hrow[m]) * expf(-((float)m / (float)(L - 1)) * delta));
                }
                __syncthreads();
                const float d = lb[o * 1024 + c];
#pragma unroll 1
                for (int jj = 0; jj < 4; ++jj) {
                    const int t0 = 8 * (tid + 512 * jj), tw0 = 8 * (wave * 64 + 512 * jj);
                    float acc[8];
#pragma unroll
                    for (int i = 0; i < 8; ++i) acc[i] = 0.f;
                    lconv8<1>(u, f, t0, (tw0 + 8 * 63 + 7) / 8 + 1, acc);
                    lconv8<-1>(u, f + L, t0, (L - tw0 + 7) / 8, acc);
                    float res[8];
#pragma unroll
                    for (int i = 0; i < 8; ++i) {
                        const int t = t0 + i;
                        const float g = o == 0 ? sconv(r1 + base, t, L, wv[1][0], wv[1][1], wv[1][2], wv[1][3]) : sconv(r2 + base, t, L, wv[2][0], wv[2][1], wv[2][2], wv[2][3]);
                        res[i] = g * (acc[i] + d * u[PADF + t]);
                    }
                    if (o == 0) {
                        *(f32x4*)(tmp + t0) = (f32x4){res[0], res[1], res[2], res[3]}; *(f32x4*)(tmp + t0 + 4) = (f32x4){res[4], res[5], res[6], res[7]};
                    } else {
                        u32x4 w; w.x = pk2(res[0], res[1]); w.y = pk2(res[2], res[3]); w.z = pk2(res[4], res[5]); w.w = pk2(res[6], res[7]);
                        *(u32x4*)(YT + (size_t)c * hk::TA + base + t0) = w;
                    }
                }
                if (o == 0) {
                    __syncthreads();
#pragma unroll 1
                    for (int jj = 0; jj < 4; ++jj) {
                        const int t0 = 8 * (tid + 512 * jj);
                        *(f32x4*)(u + PADF + t0) = *(const f32x4*)(tmp + t0); *(f32x4*)(u + PADF + t0 + 4) = *(const f32x4*)(tmp + t0 + 4);
                    }
                }
            }
        }
        {
            __syncthreads();
            float* uc = u;
            float* fc = u + 512;
            const int b = tid >> 8, t = tid & 255, cbase = hk::TL + b * 256;
            uc[tid] = sconv(rv + cbase, t, 256, wv[0][0], wv[0][1], wv[0][2], wv[0][3]);
            for (int i = tid; i < 1024; i += 512) { const int od = i >> 8, m = i & 255; fc[i] = bf2f(HFC[(size_t)(od * 1024 + c) * 256 + m]) * expf(-((float)m / 255.0f) * delta); }
            __syncthreads();
            float y = uc[tid];
            for (int o = 0; o < 2; ++o) {
                float a = 0.f;
                for (int s = 0; s <= t; ++s) a += fc[(o * 2 + 0) * 256 + (t - s)] * uc[b * 256 + s];
                for (int s = t + 1; s < 256; ++s) a += fc[(o * 2 + 1) * 256 + (s - t)] * uc[b * 256 + s];
                const float g = o == 0 ? sconv(r1 + cbase, t, 256, wv[1][0], wv[1][1], wv[1][2], wv[1][3]) : sconv(r2 + cbase, t, 256, wv[2][0], wv[2][1], wv[2][2], wv[2][3]);
                y = g * (a + lb[o * 1024 + c] * y);
                __syncthreads();
                uc[tid] = y;
                __syncthreads();
            }
            YT[(size_t)c * hk::TA + cbase + t] = f2bf(y);
        }
    }
}
__device__ __forceinline__ void ph_ssd_conv(const Params& p) {
    const bf16_t* XBC = (const bf16_t*)(p.ws + hk::WS_ACT + hk::A_XBC); bf16_t* XC = (bf16_t*)(p.ws + hk::WS_ACT + hk::A_XC); float* DT = (float*)(p.ws + hk::WS_ACT + hk::A_DT);
    const float* cw = p.in[hk::I_SCW]; const float* cb = p.in[hk::I_SCB];
    const long total = (long)hk::TA * 768;
    for (long idx = (long)blockIdx.x * 512 + threadIdx.x; idx < total; idx += (long)gridDim.x * 512) {
        const int r = (int)(idx / 768), c0 = (int)(idx % 768) * 8;
        float acc[8];
#pragma unroll
        for (int j = 0; j < 8; ++j) acc[j] = cb[c0 + j];
        if (r < hk::TL) {
            const int b = r >> 14, t = r & 16383, gy = t >> 6, gx = t & 63;
#pragma unroll
            for (int dy = 0; dy < 3; ++dy)
#pragma unroll
                for (int dx = 0; dx < 3; ++dx) {
                    const int yy = gy + dy - 1, xx = gx + dx - 1;
                    if (yy >= 0 && yy < 256 && xx >= 0 && xx < 64) {
                        float f[8]; unpack8(*(const u32x4*)(XBC + (size_t)((b << 14) + yy * 64 + xx) * hk::XBC_LD + c0), f);
                        const f32x4 w0 = *(const f32x4*)(cw + (size_t)(dy * 3 + dx) * 6144 + c0), w1 = *(const f32x4*)(cw + (size_t)(dy * 3 + dx) * 6144 + c0 + 4);
#pragma unroll
                        for (int j = 0; j < 4; ++j) { acc[j] += f[j] * w0[j]; acc[4 + j] += f[4 + j] * w1[j]; }
                    }
                }
        } else {
            const int q = r - hk::TL, s = q & 255;
#pragma unroll
            for (int dx = 0; dx < 3; ++dx) {
                const int ss = s + dx - 1;
                if (ss >= 0 && ss < 256) {
                    float f[8]; unpack8(*(const u32x4*)(XBC + (size_t)(r + dx - 1) * hk::XBC_LD + c0), f);
                    const f32x4 w0 = *(const f32x4*)(cw + (size_t)(3 + dx) * 6144 + c0), w1 = *(const f32x4*)(cw + (size_t)(3 + dx) * 6144 + c0 + 4);
#pragma unroll
                    for (int j = 0; j < 4; ++j) { acc[j] += f[j] * w0[j]; acc[4 + j] += f[4 + j] * w1[j]; }
                }
            }
        }
        u32x4 w; w.x = pk2(silu_f(acc[0]), silu_f(acc[1])); w.y = pk2(silu_f(acc[2]), silu_f(acc[3])); w.z = pk2(silu_f(acc[4]), silu_f(acc[5])); w.w = pk2(silu_f(acc[6]), silu_f(acc[7]));
        *(u32x4*)(XC + (size_t)r * 6144 + c0) = w;
    }
    for (long idx = (long)blockIdx.x * 512 + threadIdx.x; idx < (long)hk::TA * 128; idx += (long)gridDim.x * 512) {
        const int r = (int)(idx >> 7), q = (int)(idx & 127), dir = q >> 6, h = q & 63;
        const float z = bf2f(XBC[(size_t)r * hk::XBC_LD + 6144 + q]) + p.in[hk::I_SDTB][dir * 64 + h];
        DT[((size_t)dir * hk::TA + r) * 64 + h] = z > 20.f ? z : log1pf(expf(z));
    }
}
__device__ __forceinline__ void ph_ssd_scan_naive(const Params& p, unsigned char* ldsb) {
    float* Bs = (float*)ldsb;
    float* Cs = Bs + 32 * 128;
    float* xs = Cs + 32 * 128;
    float* dts = xs + 32 * 64;
    const int tid = threadIdx.x;
    const bf16_t* XC = (const bf16_t*)(p.ws + hk::WS_ACT + hk::A_XC); const float* DT = (const float*)(p.ws + hk::WS_ACT + hk::A_DT);
    for (int it = blockIdx.x; it < 256; it += gridDim.x) {
        const int b = it >> 7, dir = (it >> 6) & 1, h = it & 63, g = h >> 3;
        bf16_t* Y = (bf16_t*)(dir == 0 ? p.ws + hk::WS_ACT + hk::A_YF : p.ws + hk::WS_YB);
        const float aneg = -expf(p.in[hk::I_SALOG][dir * 64 + h]), dsk = p.in[hk::I_SD][dir * 64 + h];
        const int pp = tid >> 3, ns = tid & 7;
        float S[16];
#pragma unroll
        for (int i = 0; i < 16; ++i) S[i] = 0.f;
        for (int seg = 0; seg < 2; ++seg) {
            const int n = seg == 0 ? hk::CTXL : hk::SEQ, rowbase = seg == 0 ? hk::TL + b * hk::CTXL : b * hk::SEQ;
            for (int t0 = 0; t0 < n; t0 += 32) {
                __syncthreads();
                for (int idx = tid; idx < 32 * 128; idx += 512) {
                    const int s = idx >> 7, nn = idx & 127, tt = t0 + s, t = dir == 0 ? tt : n - 1 - tt;
                    const bf16_t* row = XC + (size_t)(rowbase + t) * 6144;
                    Bs[idx] = bf2f(row[4096 + g * 128 + nn]); Cs[idx] = bf2f(row[5120 + g * 128 + nn]);
                }
                for (int idx = tid; idx < 32 * 64; idx += 512) {
                    const int s = idx >> 6, q = idx & 63, tt = t0 + s, t = dir == 0 ? tt : n - 1 - tt;
                    xs[idx] = bf2f(XC[(size_t)(rowbase + t) * 6144 + h * 64 + q]);
                }
                if (tid < 32) { const int tt = t0 + tid, t = dir == 0 ? tt : n - 1 - tt; dts[tid] = DT[((size_t)dir * hk::TA + rowbase + t) * 64 + h]; }
                __syncthreads();
#pragma unroll 2
                for (int s = 0; s < 32; ++s) {
                    const float dt = dts[s], da = expf(dt * aneg), xv = xs[s * 64 + pp], xd = dt * xv;
                    float y = 0.f;
#pragma unroll
                    for (int q = 0; q < 4; ++q) {
                        const f32x4 b4 = *(const f32x4*)(Bs + s * 128 + ns * 16 + q * 4), c4 = *(const f32x4*)(Cs + s * 128 + ns * 16 + q * 4);
#pragma unroll
                        for (int j = 0; j < 4; ++j) { S[q * 4 + j] = da * S[q * 4 + j] + xd * b4[j]; y += S[q * 4 + j] * c4[j]; }
                    }
                    y += __shfl_xor(y, 1); y += __shfl_xor(y, 2); y += __shfl_xor(y, 4);
                    if (seg == 1 && ns == 0) { const int tt = t0 + s, t = dir == 0 ? tt : n - 1 - tt; Y[(size_t)(rowbase + t) * 4096 + h * 64 + pp] = f2bf(y + dsk * xv); }
                }
            }
        }
    }
}
__device__ __forceinline__ void ph_ssd_finish(const Params& p) {
    const int lane = threadIdx.x & 63, wave = threadIdx.x >> 6;
    bf16_t* Z = (bf16_t*)(p.ws + hk::WS_ACT + hk::A_Z);
    const bf16_t* YF = (const bf16_t*)(p.ws + hk::WS_ACT + hk::A_YF); const bf16_t* YB = (const bf16_t*)(p.ws + hk::WS_YB);
    const float* ng = p.in[hk::I_SNG];
    for (int r = blockIdx.x * 8 + wave; r < hk::TL; r += gridDim.x * 8) {
#pragma unroll 2
        for (int g = 0; g < 8; ++g) {
            const int col = g * 512 + lane * 8;
            float a[8], bq[8], z[8], uu[8];
            unpack8(*(const u32x4*)(YF + (size_t)r * 4096 + col), a); unpack8(*(const u32x4*)(YB + (size_t)r * 4096 + col), bq); unpack8(*(const u32x4*)(Z + (size_t)r * 4096 + col), z);
            float ss = 0.f;
#pragma unroll
            for (int j = 0; j < 8; ++j) { uu[j] = (a[j] + bq[j]) * silu_f(z[j]); ss += uu[j] * uu[j]; }
            const float rs = rsqrtf(wave_sum(ss) * (1.0f / 512.0f) + hk::LN_EPS);
            const f32x4 g0 = *(const f32x4*)(ng + col), g1 = *(const f32x4*)(ng + col + 4);
            u32x4 w; w.x = pk2(uu[0] * rs * g0[0], uu[1] * rs * g0[1]); w.y = pk2(uu[2] * rs * g0[2], uu[3] * rs * g0[3]); w.z = pk2(uu[4] * rs * g1[0], uu[5] * rs * g1[1]); w.w = pk2(uu[6] * rs * g1[2], uu[7] * rs * g1[3]);
            *(u32x4*)(Z + (size_t)r * 4096 + col) = w;
        }
    }
}
#ifndef ONE_LAUNCH
#define ONE_LAUNCH 0
#endif
constexpr int N_PHASES = 21;
constexpr int NO_SPLIT = 1 << 30;

template <class Epi> __device__ __forceinline__ void run_gemm(unsigned char* lds, const bf16_t* A, const bf16_t* Bt, int M, int N, int K, const Epi& E) {
    pg8::Gemm g{A, Bt, M, N, K}; pg8::StaticOrder S; S.init(M, N, (int)gridDim.x, (int)blockIdx.x);
    pg8::gemm_phase<Epi, pg8::StaticOrder, false>((PG8_LAS unsigned char*)lds, g, S, E, nullptr);
}
template <class Epi> __device__ __forceinline__ void run_gemm_grouped(unsigned char* lds, const bf16_t* A, const bf16_t* Bt, int K, const unsigned* ctl, int layer, const Epi& E) {
    const int nt = (int)__hip_atomic_load(ctl + hk::CW_NT + layer * 64, __ATOMIC_RELAXED, __HIP_MEMORY_SCOPE_AGENT);
    pg8::Gemm g{A, Bt, nt * 256, 16 * 2048, K};
    pg8::GroupedOrder S{(const int*)(ctl + hk::CW_TILEE + layer * 320), nt, 8, (int)gridDim.x, (int)blockIdx.x};
    pg8::gemm_phase<Epi, pg8::GroupedOrder, false>((PG8_LAS unsigned char*)lds, g, S, E, nullptr);
}

__global__ void __launch_bounds__(512, 2) hybrid_fwd(Params p) {
    extern __shared__ __attribute__((aligned(16))) unsigned char lds[];
    unsigned char* ws = p.ws; unsigned char* act = ws + hk::WS_ACT;
    unsigned* ctl = (unsigned*)(ws + hk::WS_CTL);
#if ONE_LAUNCH
    volatile LAS unsigned* xbw = (volatile LAS unsigned*)(lds + hk::LDS_BYTES - 16);
    if (threadIdx.x == 0) { xbw[0] = 0u; xbw[1] = 0u; xbw[2] = 0u; xbw[3] = 0u; }
    __syncthreads();
    XcdBarrier bar = xcd_barrier_post(ctl + hk::CW_BAR, xbw);
#define SEAM(k) do { if ((k) + 1 < p.ph_hi) xcd_barrier(bar); } while (0)
#else
#define SEAM(k) do { } while (0)
#endif
#ifndef PH_MASK
#define PH_MASK 0xFFFFFFFFu
#endif
#define IN(k) ((((PH_MASK) >> (k)) & 1u) && p.ph_lo <= (k) && (k) < p.ph_hi)
    bf16_t* HA = (bf16_t*)(act + hk::A_HA);
    if (IN(0)) { ph_mod(p, lds); __syncthreads(); ph_conv_weights(p, lds); __syncthreads(); ph_conv_experts(p, 0, lds); __syncthreads(); ph_hid(p, lds); __syncthreads(); SEAM(0); }
    if (IN(1)) { ph_modulate0(p); SEAM(1); }
    if (IN(2)) {
        run_gemm(lds, (const bf16_t*)(ws + hk::WS_WU), HA, 3072, hk::TA, 2048, pg8::EpiStore{(bf16_t*)(act + hk::A_UT), hk::TA, NO_SPLIT, nullptr, 0, 0});
        run_gemm(lds, HA, (const bf16_t*)(ws + hk::WS_WGLA), hk::TA, 3328, 2048, pg8::EpiStore{(bf16_t*)(act + hk::A_GL), hk::GL_LD, NO_SPLIT, nullptr, 0, 0});
        run_gemm(lds, (const bf16_t*)(ws + hk::WS_W3T), (const bf16_t*)(ws + hk::WS_HID2), 4096, 16384, 256, pg8::EpiStore{(bf16_t*)(act + hk::A_HF), 16384, NO_SPLIT, nullptr, 0, 0});
        run_gemm(lds, (const bf16_t*)(ws + hk::WS_W3T), (const bf16_t*)(ws + hk::WS_HID2C), 4096, 256, 256, pg8::EpiStore{(bf16_t*)(act + hk::A_HFC), 256, NO_SPLIT, nullptr, 0, 0});
        SEAM(2);
    }
    if (IN(3)) {
#ifndef NO_HY
        ph_hyena_naive(p, lds); __syncthreads();
#endif
#ifndef NO_GLA
        ph_gla_scan_naive(p, lds);
#endif
        SEAM(3); }
    if (IN(4)) { ph_mix_finish(p, lds); SEAM(4); }
    if (IN(5)) { run_gemm(lds, HA, (const bf16_t*)(ws + hk::WS_WOUT0), hk::TA, 2048, 2048, pg8::EpiStore{(bf16_t*)(act + hk::A_YO), 2048, NO_SPLIT, nullptr, 0, 0}); SEAM(5); }
    if (IN(6)) { ph_ln1_router(p, 0, lds, (const bf16_t*)(act + hk::A_YO), HA); SEAM(6); }
    if (IN(7)) { ph_dispatch(p, 0, HA, (bf16_t*)(act + hk::A_AG)); SEAM(7); }
    if (IN(8)) { run_gemm_grouped(lds, (const bf16_t*)(act + hk::A_AG), (const bf16_t*)(ws + hk::WS_WE), 2048, ctl, 0, pg8::EpiSwiGLU{(bf16_t*)(act + hk::A_HB), 1024, 8}); SEAM(8); }
    if (IN(9)) { run_gemm_grouped(lds, (const bf16_t*)(act + hk::A_HB), (const bf16_t*)(ws + hk::WS_WE_DN), 1024, ctl, 0, pg8::EpiStore{(bf16_t*)(act + hk::A_YR), 2048, NO_SPLIT, nullptr, 0, 8}); SEAM(9); }
    if (IN(10)) { ph_ln2(p, 0, (const bf16_t*)(act + hk::A_YR), (bf16_t*)(act + hk::A_HA1)); SEAM(10); }
    if (IN(11)) { run_gemm(lds, (const bf16_t*)(act + hk::A_HA1), (const bf16_t*)(ws + hk::WS_WSSDIN), hk::TA, 10496, 2048, pg8::EpiStore{(bf16_t*)(act + hk::A_Z), 4096, 16, (bf16_t*)(act + hk::A_XBC), hk::XBC_LD, 0}); SEAM(11); }
    if (IN(12)) { ph_ssd_conv(p); SEAM(12); }
    if (IN(13)) { ph_ssd_scan_naive(p, lds); SEAM(13); }
    if (IN(14)) { ph_ssd_finish(p); SEAM(14); }
    if (IN(15)) {
        run_gemm(lds, (const bf16_t*)(act + hk::A_Z), (const bf16_t*)(ws + hk::WS_WOUT1), hk::TL, 2048, 4096, pg8::EpiStore{(bf16_t*)(act + hk::A_YO1), 2048, NO_SPLIT, nullptr, 0, 0});
        __syncthreads(); ph_conv_experts(p, 1, lds); SEAM(15);
    }
    if (IN(16)) { ph_ln1_router(p, 1, lds, (const bf16_t*)(act + hk::A_YO1), (bf16_t*)(act + hk::A_HA2)); SEAM(16); }
    if (IN(17)) { ph_dispatch(p, 1, (const bf16_t*)(act + hk::A_HA2), (bf16_t*)(act + hk::A_AG1)); SEAM(17); }
    if (IN(18)) { run_gemm_grouped(lds, (const bf16_t*)(act + hk::A_AG1), (const bf16_t*)(ws + hk::WS_WE), 2048, ctl, 1, pg8::EpiSwiGLU{(bf16_t*)(act + hk::A_HB1), 1024, 8}); SEAM(18); }
    if (IN(19)) { run_gemm_grouped(lds, (const bf16_t*)(act + hk::A_HB1), (const bf16_t*)(ws + hk::WS_WE_DN), 1024, ctl, 1, pg8::EpiStore{(bf16_t*)(act + hk::A_YR1), 2048, NO_SPLIT, nullptr, 0, 8}); SEAM(19); }
    if (IN(20)) { ph_ln2(p, 1, (const bf16_t*)(act + hk::A_YR1), nullptr); }
#undef IN
#undef SEAM
}

extern "C" void kernel_launch(void* const* d_in, const int* in_sizes, int n_in, void* d_out, int out_size, void* d_ws, size_t ws_size, hipStream_t stream) {
    static int grid = 0;
    if (grid == 0) {
        if (n_in != hk::N_IN || ws_size < hk::WS_NEED) { fprintf(stderr, "kernel_launch: need %d inputs and %zu bytes of workspace; got %d, %zu\n", hk::N_IN, (size_t)hk::WS_NEED, n_in, ws_size); grid = -1; return; }
        int dev = 0, cus = 0, per_cu = 0;
        if (hipGetDevice(&dev) != hipSuccess || hipDeviceGetAttribute(&cus, hipDeviceAttributeMultiprocessorCount, dev) != hipSuccess) { grid = -1; return; }
        if (hipFuncSetAttribute((const void*)hybrid_fwd, hipFuncAttributeMaxDynamicSharedMemorySize, hk::LDS_BYTES) != hipSuccess) { fprintf(stderr, "kernel_launch: hipFuncSetAttribute failed\n"); grid = -1; return; }
        if (hipOccupancyMaxActiveBlocksPerMultiprocessor(&per_cu, (const void*)hybrid_fwd, hk::NTHREADS, hk::LDS_BYTES) != hipSuccess || per_cu < 1) fprintf(stderr, "kernel_launch: occupancy query reports %d\n", per_cu);
        (void)hipGetLastError();
        grid = cus;
    }
    if (grid < 0) return;
    (void)hipMemsetAsync((char*)d_ws + hk::WS_CTL, 0, 64 * 1024, stream);
    Params prm{};
    for (int i = 0; i < hk::N_IN; ++i) prm.in[i] = (const float*)d_in[i];
    prm.out = (float*)d_out; prm.ws = (unsigned char*)d_ws;
#if ONE_LAUNCH
    prm.ph_lo = 0; prm.ph_hi = N_PHASES;
    hipLaunchKernelGGL(hybrid_fwd, dim3(grid), dim3(hk::NTHREADS), hk::LDS_BYTES, stream, prm);
#else
    for (int k = 0; k < N_PHASES; ++k) { prm.ph_lo = k; prm.ph_hi = k + 1; hipLaunchKernelGGL(hybrid_fwd, dim3(grid), dim3(hk::NTHREADS), hk::LDS_BYTES, stream, prm); }
#endif
}
```

```cpp
#include <hip/hip_runtime.h>
#include <cstdio>
#include <cstdint>
#define ONE_LAUNCH 1
namespace pg8 {
#define PG8_LAS __attribute__((address_space(3)))
typedef unsigned short bf16_t;
typedef short bf16x8 __attribute__((ext_vector_type(8)));
typedef float f32x4 __attribute__((ext_vector_type(4)));
typedef unsigned u32x4 __attribute__((ext_vector_type(4)));
constexpr int BM = 256, BK = 64, HALF = 128, HTB = HALF * BK * 2  , STAGE_BYTES = 8 * HTB, NXCD = 8, WGM = 8;

__host__ __device__ __forceinline__ int lds_byte(int r, int c) { const int st = (r >> 4) * 2 + (c >> 5), rr = r & 15, cc = c & 31, ob = rr * 64 + cc * 2; return st * 1024 + (ob ^ (((ob >> 9) & 1) << 5)); }
__host__ __device__ __forceinline__ void stage_rc(int b, int& R, int& C) { const int st = b / 1024, sb = b % 1024, swz = sb ^ (((sb >> 9) & 1) << 5); R = (st >> 1) * 16 + swz / 64; C = (st & 1) * 32 + (swz % 64) / 2; }
__host__ __device__ __forceinline__ int perm32(int rho) { const int n = rho >> 4, i = rho & 15; return 8 * (i >> 2) + 4 * n + (i & 3); }

struct Unit { int pm, pn; };
struct Gemm { const bf16_t* A; const bf16_t* Bt; int M, N, K; const int* rowmap = nullptr; };

struct StaticOrder {
    int nM, nN, nwg, G, c;
    __host__ __device__ void init(int M, int N, int G_, int c_) { nM = M / BM; nN = N / BM; nwg = nM * nN; G = G_; c = c_; }
    __host__ __device__ bool next(int i, Unit& u) const {
        const long L = (long)i * G + c; if (L >= nwg) return false;
        int wgid = (int)L; { const int q = nwg / NXCD, r = nwg % NXCD, xcd = wgid % NXCD, off = wgid / NXCD; wgid = (xcd < r ? xcd * (q + 1) : r * (q + 1) + (xcd - r) * q) + off; }
        const int nig = WGM * nN, gid = wgid / nig, fm = gid * WGM, gsz = (nM - fm) < WGM ? (nM - fm) : WGM;
        u.pm = fm + ((wgid % nig) % gsz); u.pn = (wgid % nig) / gsz; return true;
    }
    __device__ __forceinline__ void a_ready(const Unit&) const {}
    __device__ __forceinline__ void done(const Unit&) const {}
};
__device__ __forceinline__ unsigned cvt_pk_bf16(float lo, float hi) { unsigned r; asm volatile("v_cvt_pk_bf16_f32 %0, %1, %2" : "=v"(r) : "v"(lo), "v"(hi)); return r; }
typedef unsigned u32x4 __attribute__((ext_vector_type(4)));
struct EpiStore {
    static constexpr bool PERM = true, AFTER_DRAIN = false;
    bf16_t* O; int ld; int split; bf16_t* O2; int ld2; int pn_mod;
    __device__ __forceinline__ void operator()(const f32x4 (&acc)[2][2][4][2], const Unit& u, int wr, int wc, int fr, int fq) const {
        const int pn = pn_mod > 0 ? (u.pn % pn_mod) : u.pn;
        const int row0 = u.pm * BM + wr * 64 + fr;
        bf16_t* base = O; int ldc = ld, colt = pn * BM;
        if (pn >= split) { base = O2; ldc = ld2; colt = (pn - split) * BM; }
        const int col0 = colt + wc * 32 + 8 * fq;
#pragma unroll
        for (int ai = 0; ai < 2; ++ai)
#pragma unroll
            for (int m = 0; m < 4; ++m) { bf16_t* rowp = base + (size_t)(row0 + ai * HALF + m * 16) * ldc + col0;
#pragma unroll
                for (int bj = 0; bj < 2; ++bj) { const f32x4 v0 = acc[ai][bj][m][0], v1 = acc[ai][bj][m][1];
                    u32x4 w; w.x = cvt_pk_bf16(v0[0], v0[1]); w.y = cvt_pk_bf16(v0[2], v0[3]); w.z = cvt_pk_bf16(v1[0], v1[1]); w.w = cvt_pk_bf16(v1[2], v1[3]);
                    *(u32x4*)(rowp + bj * HALF) = w; } }
    }
};
struct EpiSwiGLU {
    static constexpr bool PERM = true, AFTER_DRAIN = false;
    bf16_t* O; int ld; int pn_mod;
    __device__ __forceinline__ void operator()(const f32x4 (&acc)[2][2][4][2], const Unit& u, int wr, int wc, int fr, int fq) const {
        const int pn = u.pn % pn_mod;
        const int row0 = u.pm * BM + wr * 64 + fr, col0 = pn * HALF + wc * 32 + 8 * fq;
#pragma unroll
        for (int ai = 0; ai < 2; ++ai)
#pragma unroll
            for (int m = 0; m < 4; ++m) { bf16_t* rowp = O + (size_t)(row0 + ai * HALF + m * 16) * ld + col0;
                float h[8];
#pragma unroll
                for (int n = 0; n < 2; ++n)
#pragma unroll
                    for (int j = 0; j < 4; ++j) { const float g = acc[ai][0][m][n][j], uu = acc[ai][1][m][n][j]; h[n * 4 + j] = g * __builtin_amdgcn_rcpf(1.0f + __expf(-g)) * uu; }
                u32x4 w; w.x = cvt_pk_bf16(h[0], h[1]); w.y = cvt_pk_bf16(h[2], h[3]); w.z = cvt_pk_bf16(h[4], h[5]); w.w = cvt_pk_bf16(h[6], h[7]);
                *(u32x4*)rowp = w; }
    }
};
struct GroupedOrder {
    int ps[17];
    int ntiles, ncol, G, c, cap;
    __device__ __forceinline__ int expert_of(int rt) const { int e = 0;
#pragma unroll
        for (int q = 1; q < 16; ++q) e = (rt * BM >= ps[q]) ? q : e;
        return e; }
    __device__ __forceinline__ int tile_rt(int i) const {
        if (G == 256 && ncol == 8) { const int rt = i * 32 + 4 * (c & 7) + (c >> 6); return rt < ntiles ? rt : -1; }
        const long L = (long)i * G + c; return L < (long)ntiles * ncol ? (int)(L / ncol) : -1;
    }
    __device__ __forceinline__ bool next(int i, Unit& u) const {
        const int rt = tile_rt(i); if (rt < 0) return false;
        const int pl = (G == 256 && ncol == 8) ? ((c >> 3) & 7) : (int)(((long)i * G + c) % ncol);
        u.pm = rt; u.pn = expert_of(rt) * ncol + pl; return true;
    }
    __device__ __forceinline__ int peek_pm(int i) const { return tile_rt(i); }
    __device__ __forceinline__ int row_base(int rt) const { const int e = expert_of(rt); int pse = 0;
#pragma unroll
        for (int q = 0; q < 16; ++q) pse = e == q ? ps[q] : pse;
        return e * cap + rt * BM - pse; }
    __device__ __forceinline__ void a_ready(const Unit&) const {}
    __device__ __forceinline__ void done(const Unit&) const {}
};

struct ChainOrder {
    int nM1, nN1, pm1, pn1, nM2, nN2, pm2, pn2, G, c;
    __device__ __forceinline__ static void unit_of(int wgid, int nM, int nN, Unit& u) {
        const int nwg = nM * nN;
        { const int q = nwg / NXCD, r = nwg % NXCD, xcd = wgid % NXCD, off = wgid / NXCD; wgid = (xcd < r ? xcd * (q + 1) : r * (q + 1) + (xcd - r) * q) + off; }
        const int nig = WGM * nN, gid = wgid / nig, fm = gid * WGM, gsz = (nM - fm) < WGM ? (nM - fm) : WGM;
        u.pm = fm + ((wgid % nig) % gsz); u.pn = (wgid % nig) / gsz;
    }
    __device__ __forceinline__ bool next(int i, Unit& u) const {
        long L = (long)i * G + c; const int n1 = nM1 * nN1;
        if (L < n1) { unit_of((int)L, nM1, nN1, u); u.pm += pm1; u.pn += pn1; return true; }
        L -= n1; if (L >= (long)nM2 * nN2) return false;
        unit_of((int)L, nM2, nN2, u); u.pm += pm2; u.pn += pn2; return true;
    }
    __device__ __forceinline__ void a_ready(const Unit&) const {}
    __device__ __forceinline__ void done(const Unit&) const {}
};
struct EpiChain {
    static constexpr bool PERM = true, AFTER_DRAIN = false;
    EpiStore e1, e2; int pm1, pn1, pm2, pn2;
    __device__ __forceinline__ void operator()(const f32x4 (&acc)[2][2][4][2], const Unit& u, int wr, int wc, int fr, int fq) const {
        if (u.pm >= pm2) { const Unit v{u.pm - pm2, u.pn - pn2}; e2(acc, v, wr, wc, fr, fq); }
        else { const Unit v{u.pm - pm1, u.pn - pn1}; e1(acc, v, wr, wc, fr, fq); }
    }
};

template <class Epi, class Sched, bool STAMP = false, bool GATHER = false>
__device__ __forceinline__ void gemm_phase(PG8_LAS unsigned char* lds, const Gemm g, const Sched& S, const Epi& E, unsigned long long* stamps) {
    const int tid = threadIdx.x, wid = __builtin_amdgcn_readfirstlane(tid >> 6), lane = tid & 63, wr = wid >> 2, wc = wid & 3, fr = lane & 15, fq = lane >> 4;
    const int K = g.K, nt = K / BK;
    int ts_lo = 0, ts_hi = 0, nts = 0; const unsigned long long rt_entry = STAMP ? (unsigned long long)wall_clock64() : 0ull;
#define PG8_STAMP() do { if (STAMP && wid == 0 && nts < 64) { const unsigned long long _c = (unsigned long long)clock64(); \
        ts_lo = (lane == nts) ? (int)(unsigned)_c : ts_lo; ts_hi = (lane == nts) ? (int)(unsigned)(_c >> 32) : ts_hi; ++nts; } } while (0)
    PG8_STAMP();
    unsigned voffA[2], voffB[2]; int gR[2]; unsigned gC2[2];
    unsigned gcx[2][2] = {{0u, 0u}, {0u, 0u}}, gnx[2][2] = {{0u, 0u}, {0u, 0u}};
#define PG8_GOFF(dst, pm_) do { _Pragma("unroll") for (int h_ = 0; h_ < 2; ++h_) _Pragma("unroll") for (int i_ = 0; i_ < 2; ++i_) \
        dst[h_][i_] = (unsigned)g.rowmap[S.row_base(pm_) + h_ * HALF + gR[i_]] * (unsigned)(K * 2) + gC2[i_]; } while (0)
#define PG8_STAGE_A(bufoff, base, h, usenext) do { if constexpr (!GATHER) { PG8_STAGE(bufoff, (base) + ((h) ? hstep : (size_t)0), voffA); } \
        else { const unsigned vo_[2] = {(usenext) ? gnx[h][0] : gcx[h][0], (usenext) ? gnx[h][1] : gcx[h][1]}; PG8_STAGE(bufoff, base, vo_); } } while (0)
#pragma unroll
    for (int i = 0; i < 2; ++i) { int R, C; stage_rc(tid * 16 + i * 8192, R, C); const int Rb = Epi::PERM ? ((R & ~31) + perm32(R & 31)) : R;
        voffA[i] = (unsigned)(R * K + C) * 2u; voffB[i] = (unsigned)(Rb * K + C) * 2u; gR[i] = R; gC2[i] = (unsigned)C * 2u; }
    const size_t kstep = (size_t)(BK * 2);
    const size_t hstep = (size_t)HALF * K * 2;
    const size_t tstep = 2 * hstep;
    const unsigned ldsw = (unsigned)wid * 1024u;
    const int aoff = lds_byte(wr * 64 + fr, fq * 8), boff = lds_byte(wc * 32 + fr, fq * 8);
#define PG8_SA(b, h) (((b) * 2 + (h)) * HTB)
#define PG8_SB(b, h) ((4 + (b) * 2 + (h)) * HTB)
#define PG8_STAGE(bufoff, gbase, voff) do { _Pragma("unroll") for (int _i = 0; _i < 2; ++_i) \
        __builtin_amdgcn_global_load_lds((const unsigned*)((const char*)(gbase) + (voff)[_i]), (PG8_LAS unsigned*)(lds + (bufoff) + ldsw + _i * 8192), 16, 0, 0); } while (0)
#define PG8_LDA(dst, b, h) do { _Pragma("unroll") for (int m = 0; m < 4; ++m) _Pragma("unroll") for (int k = 0; k < 2; ++k) dst[m][k] = *(const PG8_LAS bf16x8*)(lds + PG8_SA(b, h) + aoff + m * 2048 + k * 1024); } while (0)
#define PG8_LDB(dst, b, h) do { _Pragma("unroll") for (int n = 0; n < 2; ++n) _Pragma("unroll") for (int k = 0; k < 2; ++k) dst[n][k] = *(const PG8_LAS bf16x8*)(lds + PG8_SB(b, h) + boff + n * 2048 + k * 1024); } while (0)
#define PG8_MMA(ai, bj, At, Bt) do { __builtin_amdgcn_s_setprio(1); _Pragma("unroll") for (int m = 0; m < 4; ++m) _Pragma("unroll") for (int n = 0; n < 2; ++n) _Pragma("unroll") for (int k = 0; k < 2; ++k) \
        acc[ai][bj][m][n] = __builtin_amdgcn_mfma_f32_16x16x32_bf16(Bt[n][k], At[m][k], acc[ai][bj][m][n], 0, 0, 0); __builtin_amdgcn_s_setprio(0); } while (0)
#define PG8_WAIT_V(n) asm volatile("s_waitcnt vmcnt(" #n ")" ::: "memory")
#define PG8_WAIT_L(n) asm volatile("s_waitcnt lgkmcnt(" #n ")" ::: "memory")
#define PG8_BAR __builtin_amdgcn_s_barrier()
#define PG8_SCHED __builtin_amdgcn_sched_barrier(0)
    Unit cur, nxt; int ui = 0;
    if (!S.next(0, cur)) return;
    f32x4 acc[2][2][4][2];
#pragma unroll
    for (int a = 0; a < 2; ++a)
#pragma unroll
        for (int b = 0; b < 2; ++b)
#pragma unroll
            for (int m = 0; m < 4; ++m)
#pragma unroll
                for (int n = 0; n < 2; ++n) acc[a][b][m][n] = (f32x4){0.f, 0.f, 0.f, 0.f};
    bf16x8 At[4][2], B0[2][2], B1[2][2];
    const char* cA = (const char*)g.A + (GATHER ? (size_t)0 : (size_t)cur.pm * tstep); const char* cB = (const char*)g.Bt + (size_t)cur.pn * tstep;
    S.a_ready(cur);
    if constexpr (GATHER) PG8_GOFF(gcx, cur.pm);
    PG8_STAGE(PG8_SB(0, 0), cB, voffB); PG8_STAGE_A(PG8_SA(0, 0), cA, 0, false); PG8_STAGE(PG8_SB(0, 1), cB + hstep, voffB); PG8_STAGE_A(PG8_SA(0, 1), cA, 1, false);
    if (wr == 1) PG8_BAR;
    PG8_WAIT_V(4); PG8_BAR;
    PG8_STAGE(PG8_SB(1, 0), cB + kstep, voffB); PG8_STAGE_A(PG8_SA(1, 0), cA + kstep, 0, false); PG8_STAGE(PG8_SB(1, 1), cB + hstep + kstep, voffB);
    PG8_WAIT_V(6); PG8_BAR;
    PG8_STAMP();
    for (;;) {
        int graw[2][2] = {{0, 0}, {0, 0}};
        if constexpr (GATHER) { const int pmn_ = S.peek_pm(ui + 1);
            if (pmn_ >= 0) { _Pragma("unroll") for (int h_ = 0; h_ < 2; ++h_) _Pragma("unroll") for (int i_ = 0; i_ < 2; ++i_) graw[h_][i_] = g.rowmap[S.row_base(pmn_) + h_ * HALF + gR[i_]]; } }
        const bool has_next = S.next(ui + 1, nxt);
        const char* nA = (has_next && !GATHER) ? (const char*)g.A + (size_t)nxt.pm * tstep : cA; const char* nB = has_next ? (const char*)g.Bt + (size_t)nxt.pn * tstep : cB;
        if constexpr (GATHER) { _Pragma("unroll") for (int h_ = 0; h_ < 2; ++h_) _Pragma("unroll") for (int i_ = 0; i_ < 2; ++i_) gnx[h_][i_] = has_next ? (unsigned)graw[h_][i_] * (unsigned)(K * 2) + gC2[i_] : gcx[h_][i_]; }
        for (int t = 0; t < nt; t += 2) {
            const bool last = (t == nt - 2);
            const char* a1 = cA + (size_t)(t + 1) * kstep;
            const char* a2 = last ? nA : cA + (size_t)(t + 2) * kstep; const char* b2 = last ? nB : cB + (size_t)(t + 2) * kstep;
            const char* a3 = a2 + kstep; const char* b3 = b2 + kstep;
            if (last && has_next) S.a_ready(nxt);
            PG8_LDB(B0, 0, 0); PG8_SCHED; PG8_LDA(At, 0, 0); PG8_STAGE_A(PG8_SA(1, 1), a1, 1, false);
            PG8_WAIT_L(8); PG8_BAR; PG8_WAIT_L(0); PG8_MMA(0, 0, At, B0); PG8_BAR; PG8_SCHED;
            PG8_LDB(B1, 0, 1); PG8_STAGE(PG8_SB(0, 0), b2, voffB);
            PG8_BAR; PG8_WAIT_L(0); PG8_MMA(0, 1, At, B1); PG8_BAR;
            PG8_LDA(At, 0, 1); PG8_STAGE_A(PG8_SA(0, 0), a2, 0, last);
            PG8_BAR; PG8_WAIT_L(0); PG8_MMA(1, 0, At, B0); PG8_BAR; PG8_SCHED;
            PG8_STAGE(PG8_SB(0, 1), b2 + hstep, voffB);
            PG8_WAIT_V(6); PG8_BAR; PG8_MMA(1, 1, At, B1); PG8_BAR;
            PG8_LDB(B0, 1, 0); PG8_SCHED; PG8_LDA(At, 1, 0); PG8_STAGE_A(PG8_SA(0, 1), a2, 1, last);
            PG8_WAIT_L(8); PG8_BAR; PG8_WAIT_L(0); PG8_MMA(0, 0, At, B0); PG8_BAR; PG8_SCHED;
            PG8_LDB(B1, 1, 1); PG8_STAGE(PG8_SB(1, 0), b3, voffB);
            PG8_BAR; PG8_WAIT_L(0); PG8_MMA(0, 1, At, B1); PG8_BAR;
            PG8_LDA(At, 1, 1); PG8_STAGE_A(PG8_SA(1, 0), a3, 0, last);
            PG8_BAR; PG8_WAIT_L(0); PG8_MMA(1, 0, At, B0); PG8_BAR; PG8_SCHED;
            PG8_STAGE(PG8_SB(1, 1), b3 + hstep, voffB);
            PG8_WAIT_V(6); PG8_BAR; PG8_MMA(1, 1, At, B1); PG8_BAR;
        }
        PG8_STAMP();
        if constexpr (!Epi::AFTER_DRAIN) { E(acc, cur, wr, wc, fr, fq); S.done(cur); }
        PG8_STAMP();
        if (!has_next) break;
#pragma unroll
        for (int a = 0; a < 2; ++a)
#pragma unroll
            for (int b = 0; b < 2; ++b)
#pragma unroll
                for (int m = 0; m < 4; ++m)
#pragma unroll
                    for (int n = 0; n < 2; ++n) acc[a][b][m][n] = (f32x4){0.f, 0.f, 0.f, 0.f};
        cur = nxt; cA = nA; cB = nB; ++ui;
        if constexpr (GATHER) { gcx[0][0] = gnx[0][0]; gcx[0][1] = gnx[0][1]; gcx[1][0] = gnx[1][0]; gcx[1][1] = gnx[1][1]; }
    }
    PG8_WAIT_V(0);
    if (wr == 0) PG8_BAR;
    PG8_BAR;
    if constexpr (Epi::AFTER_DRAIN) { E.fused(acc, cur, wr, wc, fr, fq, lds, wid, lane); S.done(cur); }
    PG8_STAMP();
    if (STAMP && wid == 0) { stamps[lane] = lane < nts ? (((unsigned long long)(unsigned)ts_hi << 32) | (unsigned)ts_lo) : 0ull;
        if (lane == 62) stamps[62] = rt_entry; if (lane == 63) stamps[63] = (unsigned long long)wall_clock64(); }
#undef PG8_STAMP
#undef PG8_SA
#undef PG8_SB
#undef PG8_STAGE
#undef PG8_STAGE_A
#undef PG8_GOFF
#undef PG8_LDA
#undef PG8_LDB
#undef PG8_MMA
#undef PG8_WAIT_V
#undef PG8_WAIT_L
#undef PG8_BAR
#undef PG8_SCHED
}
}

#define XB_TMO      128
#define XB_XCNT(j)  (256  + 64 * (j))
#define XB_XSUB(j)  (1280 + 64 * (j))
#define XB_XGEN(j)  (2304 + 64 * (j))
#define XB_TOP      3328
#define XB_TOPGEN   3392
#define XCD_BAR_WORDS 3456
#define XB_SPIN_CAP (1u << 21)
#define LAS __attribute__((address_space(3)))

__device__ __forceinline__ unsigned xb_ld(unsigned* p)              { return __hip_atomic_load(p, __ATOMIC_RELAXED, __HIP_MEMORY_SCOPE_AGENT); }
__device__ __forceinline__ unsigned xb_add(unsigned* p, unsigned v) { return __hip_atomic_fetch_add(p, v, __ATOMIC_RELAXED, __HIP_MEMORY_SCOPE_AGENT); }
__device__ __forceinline__ unsigned xb_xcc_id() { return (unsigned)__builtin_amdgcn_s_getreg((3 << 11) | 20) & 0xFu; }
#define XB_SPIN(cond, bar) do { unsigned _sp = 0; while (cond) { __builtin_amdgcn_s_sleep(1); \
    if ((++_sp & 255u) == 0u) { if (xb_ld(&(bar)[XB_TMO])) break; if (_sp > XB_SPIN_CAP) { atomicAdd(&(bar)[XB_TMO], 1u); break; } } } } while (0)

struct XcdBarrier {
    unsigned* bar; unsigned x;
    volatile LAS unsigned* st;
};

__device__ __forceinline__ XcdBarrier xcd_barrier_post(unsigned* bar, volatile LAS unsigned* st) {
    XcdBarrier b; b.bar = bar; b.x = xb_xcc_id(); b.st = st;
    if (threadIdx.x == 0) (void)xb_add(&bar[XB_XCNT(b.x)], 1u);
    return b;
}
__device__ __forceinline__ void xcd_barrier_complete(unsigned* bar, unsigned x, unsigned& nloc, unsigned& nx) {
    const unsigned G = gridDim.x * gridDim.y * gridDim.z;
    unsigned sum, cnt, mine, sp = 0u;
    for (;;) {
        sum = 0u; cnt = 0u; mine = 0u;
#pragma unroll
        for (unsigned j = 0; j < 16; ++j) { const unsigned c = xb_ld(&bar[XB_XCNT(j)]); sum += c; cnt += (c > 0u) ? 1u : 0u; mine = (j == x) ? c : mine; }
        if (sum == G) break;
        __builtin_amdgcn_s_sleep(1);
        if ((++sp & 255u) == 0u) { if (xb_ld(&bar[XB_TMO])) break; if (sp > XB_SPIN_CAP) { atomicAdd(&bar[XB_TMO], 1u); break; } }
    }
    nloc = mine > 0u ? mine : 1u; nx = cnt > 0u ? cnt : 1u;
}

__device__ __forceinline__ void xcd_barrier(const XcdBarrier& b) {
    asm volatile("s_waitcnt vmcnt(0)" ::: "memory");
    __syncthreads();
    if (threadIdx.x == 0) {
        unsigned* bar = b.bar;
        __builtin_amdgcn_s_waitcnt(0);
        unsigned nloc = b.st[0], nx = b.st[1];
        if (nloc == 0u) { xcd_barrier_complete(bar, b.x, nloc, nx); b.st[0] = nloc; b.st[1] = nx; }
        const unsigned old = xb_add(&bar[XB_XSUB(b.x)], 1u);
        const unsigned gen = old / nloc;
        if (old + 1u == (gen + 1u) * nloc) {
            __builtin_amdgcn_fence(__ATOMIC_RELEASE, "agent");
            asm volatile("s_waitcnt vmcnt(0)" ::: "memory");
            const unsigned og = xb_add(&bar[XB_TOP], 1u);
            const unsigned tg = og / nx;
            if (og + 1u == (tg + 1u) * nx) xb_add(&bar[XB_TOPGEN], 1u);
            else XB_SPIN(xb_ld(&bar[XB_TOPGEN]) == tg, bar);
            __builtin_amdgcn_fence(__ATOMIC_ACQUIRE, "agent");
            xb_add(&bar[XB_XGEN(b.x)], 1u);
            asm volatile("s_waitcnt vmcnt(0)" ::: "memory");
        } else {
            XB_SPIN(xb_ld(&bar[XB_XGEN(b.x)]) == gen, bar);
            __builtin_amdgcn_fence(__ATOMIC_ACQUIRE, "agent");
            asm volatile("s_waitcnt vmcnt(0)" ::: "memory");
        }
    }
    __syncthreads();
}
typedef unsigned short bf16_t;
typedef float f32x4 __attribute__((ext_vector_type(4)));
typedef unsigned u32x4 __attribute__((ext_vector_type(4)));
typedef unsigned u32x2 __attribute__((ext_vector_type(2)));
namespace hk {
constexpr int D = 2048, SEQ = 16384, CTXL = 256, TL = 32768, TC = 512, TA = 33280;
constexpr float ALPHA = 1.41421356237309515f;
constexpr float LN_EPS = 1e-6f;
constexpr int NTHREADS = 512;
constexpr int LDS_BYTES = 156 * 1024;
enum { I_X = 0, I_C, I_CTX, I_CCTX, I_RW, I_RB, I_MODW, I_MODB, I_LNG, I_LNB, I_EG, I_EU, I_ED, I_ABIN, I_ABOUT, I_HCW, I_HCB, I_FW1, I_FB1, I_FFR1, I_FW2, I_FB2, I_FFR2, I_FW3, I_HLB,
       I_GW2, I_GB, I_GNG, I_SWIN, I_SCW, I_SCB, I_SDTB, I_SALOG, I_SD, I_SNG, I_SWOUT, N_IN };
constexpr size_t MiB = 1024 * 1024;
constexpr size_t WS_CTL = 0;
constexpr int CW_BAR = 0;
constexpr int CW_CNT = 4096;
constexpr int CW_NT = 4096 + 256;
constexpr int CW_TILEE = 4096 + 512;
constexpr int CW_HYQ = 4096 + 1280;
constexpr int CW_PROBE = 4096 + 1344;
constexpr int CW_CTXF = 4096 + 1408;
constexpr size_t WS_MOD = 64 * 1024;
constexpr size_t WS_CTXS = 384 * 1024;
constexpr size_t WS_MISC = 4608 * 1024;
constexpr size_t MISC_EXP = 0, MISC_GATE = 272 * 1024, MISC_SLOT = 544 * 1024, MISC_DEST = 816 * 1024, MISC_ROWTOK = 1088 * 1024;
constexpr int ROWTOK_N = 70656;
constexpr size_t WS_WOUT1 = 6 * MiB;
constexpr size_t WS_WE = 22 * MiB;
constexpr size_t WS_WE_DN = WS_WE + 128 * MiB;
constexpr size_t WS_R0 = 214 * MiB;
constexpr size_t WS_WU = WS_R0;
constexpr size_t WS_WGLA = WS_R0 + 16 * MiB;
constexpr size_t WS_WOUT0 = WS_R0 + 25 * MiB;
constexpr size_t WS_W3T = WS_R0 + 33 * MiB;
constexpr size_t WS_HID2 = WS_R0 + 35 * MiB;
constexpr size_t WS_HID2C = WS_R0 + 43 * MiB;
constexpr size_t WS_WSSDIN = WS_R0 + 44 * MiB;
constexpr size_t WS_ACT = 299 * MiB;
constexpr size_t A_HA = 0;
constexpr size_t A_UT = 130 * MiB;
constexpr size_t A_GL = 390 * MiB;
constexpr size_t A_HF = 537 * MiB;
constexpr size_t A_HFC = 665 * MiB;
constexpr size_t A_YT = 667 * MiB;
constexpr size_t A_OF = 732 * MiB;
constexpr size_t A_OB = 797 * MiB;
constexpr size_t A_QK = 862 * MiB;
constexpr size_t A_VTG = 325 * MiB;
constexpr size_t A_EB = 992 * MiB;
constexpr size_t A_HYTMP = 1000 * MiB;
constexpr size_t A_HYS = 0;
constexpr size_t A_YO = 130 * MiB;
constexpr size_t A_AG = 260 * MiB;
constexpr size_t A_HB = 536 * MiB;
constexpr size_t A_YR = 0;
constexpr size_t A_HA1 = 700 * MiB;
constexpr size_t A_Z = 0;
constexpr size_t A_XBC = 260 * MiB;
constexpr size_t A_XT = 407 * MiB;
constexpr size_t A_XC = 667 * MiB;
constexpr size_t A_XTG = 797 * MiB;
constexpr size_t A_DT = 1057 * MiB;
constexpr size_t A_YF = 260 * MiB;
constexpr size_t WS_YB = WS_WE;
constexpr size_t A_YO1 = 260 * MiB;
constexpr size_t A_HA2 = 400 * MiB;
constexpr size_t A_AG1 = 530 * MiB;
constexpr size_t A_HB1 = 806 * MiB;
constexpr size_t A_YR1 = 0;
constexpr size_t A_ROWS = 1075 * MiB;
constexpr int ROWS_CAP = 33280;
constexpr size_t WS_NEED = WS_ACT + 1078 * MiB;
constexpr int XBC_LD = 2304, GL_LD = 2304, GL_G = 1024, GL_GK = 2048;
}

struct Params { const float* in[hk::N_IN]; float* out; unsigned char* ws; int ph_lo, ph_hi; };

__device__ __forceinline__ float bf2f(bf16_t v) { return __uint_as_float(((unsigned)v) << 16); }
__device__ __forceinline__ bf16_t f2bf(float f) { unsigned u = __float_as_uint(f); u += 0x7FFFu + ((u >> 16) & 1u); return (bf16_t)(u >> 16); }
typedef __bf16 hw_bf16x2 __attribute__((ext_vector_type(2)));
typedef float hw_f32x2 __attribute__((ext_vector_type(2)));
__device__ __forceinline__ unsigned pk2(float lo, float hi) { const hw_f32x2 f = {lo, hi}; const hw_bf16x2 v = __builtin_convertvector(f, hw_bf16x2); return __builtin_bit_cast(unsigned, v); }
__device__ __forceinline__ float silu_f(float v) { return v * __builtin_amdgcn_rcpf(1.0f + __expf(-v)); }
__device__ __forceinline__ float wave_sum(float v) {
#pragma unroll
    for (int o = 32; o > 0; o >>= 1) v += __shfl_xor(v, o);
    return v;
}
__device__ __forceinline__ void unpack8(const u32x4 w, float (&f)[8]) {
    f[0] = __uint_as_float(w.x << 16); f[1] = __uint_as_float(w.x & 0xFFFF0000u); f[2] = __uint_as_float(w.y << 16); f[3] = __uint_as_float(w.y & 0xFFFF0000u);
    f[4] = __uint_as_float(w.z << 16); f[5] = __uint_as_float(w.z & 0xFFFF0000u); f[6] = __uint_as_float(w.w << 16); f[7] = __uint_as_float(w.w & 0xFFFF0000u);
}
__device__ __forceinline__ int mod_vec(int r) { return r < hk::TL ? (r >> 14) : 2; }
#define MODP(ws, l, mv, k) ((const float*)((ws) + hk::WS_MOD) + ((size_t)((l) * 3 + (mv)) * 6 + (k)) * 2048)
__device__ __forceinline__ void ph_mod(const Params& p, unsigned char* ldsb) {
    float* svec = (float*)ldsb; float* red = svec + 3 * 2048;
    const int tid = threadIdx.x;
    const float* c = p.in[hk::I_C]; const float* cc = p.in[hk::I_CCTX];
    for (int i = tid; i < 3 * 2048; i += 512) { const float v = i < 4096 ? c[i] : cc[i - 4096]; svec[i] = v / (1.0f + expf(-v)); }
    __syncthreads();
    float* MOD = (float*)(p.ws + hk::WS_MOD);
    for (int slab = blockIdx.x; slab < 768; slab += gridDim.x) {
        const int l = slab / 384, j0 = (slab % 384) * 32;
        const float* W = p.in[hk::I_MODW] + (size_t)l * 2048 * 12288;
        const int cq = tid & 7, rg = tid >> 3;
        float acc[3][4];
#pragma unroll
        for (int v = 0; v < 3; ++v)
#pragma unroll
            for (int j = 0; j < 4; ++j) acc[v][j] = 0.f;
#pragma unroll 4
        for (int i = 0; i < 32; ++i) {
            const int r = rg + 64 * i;
            const f32x4 w = *(const f32x4*)(W + (size_t)r * 12288 + j0 + cq * 4);
#pragma unroll
            for (int v = 0; v < 3; ++v) { const float s = svec[v * 2048 + r];
#pragma unroll
                for (int j = 0; j < 4; ++j) acc[v][j] += s * w[j]; }
        }
#pragma unroll
        for (int v = 0; v < 3; ++v)
#pragma unroll
            for (int j = 0; j < 4; ++j) red[tid * 12 + v * 4 + j] = acc[v][j];
        __syncthreads();
        if (tid < 96) {
            const int v = tid >> 5, col = tid & 31, q = col >> 2, j = col & 3;
            float s = 0.f;
            for (int g = 0; g < 64; ++g) s += red[(g * 8 + q) * 12 + v * 4 + j];
            const int jj = j0 + col;
            MOD[(size_t)(l * 3 + v) * 12288 + jj] = s + p.in[hk::I_MODB][l * 12288 + jj];
        }
        __syncthreads();
    }
}

__device__ __forceinline__ void conv_mat(const float* src, int ld, int K, int ncol0, int nvalid, int npad, bf16_t* dst, int Kd, int mode, unsigned char* ldsb) {
    float* tile = (float*)ldsb;
    const int tid = threadIdx.x, nkt = K / 64, ntile = nkt * (npad / 64);
    for (int t = blockIdx.x; t < ntile; t += gridDim.x) {
        const int kt = t % nkt, nt = t / nkt, k0 = kt * 64, n0 = nt * 64;
#pragma unroll
        for (int it = 0; it < 2; ++it) {
            const int r = (tid >> 4) + 32 * it, c4 = (tid & 15) * 4;
            f32x4 v = (f32x4){0.f, 0.f, 0.f, 0.f};
            if (n0 + c4 < nvalid) v = *(const f32x4*)(src + (size_t)(k0 + r) * ld + ncol0 + n0 + c4);
            tile[r * 65 + c4 + 0] = v[0]; tile[r * 65 + c4 + 1] = v[1]; tile[r * 65 + c4 + 2] = v[2]; tile[r * 65 + c4 + 3] = v[3];
        }
        __syncthreads();
        {
            const int n = tid >> 3, kq = tid & 7;
            float f[8];
#pragma unroll
            for (int j = 0; j < 8; ++j) f[j] = tile[(kq * 8 + j) * 65 + n];
            int drow = n0 + n;
            if (mode != 0) drow = 256 * (n0 >> 7) + (n0 & 127) + n + (mode == 2 ? 128 : 0);
            u32x4 w; w.x = pk2(f[0], f[1]); w.y = pk2(f[2], f[3]); w.z = pk2(f[4], f[5]); w.w = pk2(f[6], f[7]);
            *(u32x4*)(dst + (size_t)drow * Kd + k0 + kq * 8) = w;
        }
        __syncthreads();
    }
}
__device__ __forceinline__ void ph_conv_experts(const Params& p, int layer, unsigned char* ldsb) {
    bf16_t* GU = (bf16_t*)(p.ws + hk::WS_WE); bf16_t* DN = (bf16_t*)(p.ws + hk::WS_WE_DN);
    for (int e = 0; e < 16; ++e) {
        const size_t eo = ((size_t)layer * 16 + e) * 2048 * 1024;
        conv_mat(p.in[hk::I_EG] + eo, 1024, 2048, 0, 1024, 1024, GU + (size_t)e * 2048 * 2048, 2048, 1, ldsb);
        conv_mat(p.in[hk::I_EU] + eo, 1024, 2048, 0, 1024, 1024, GU + (size_t)e * 2048 * 2048, 2048, 2, ldsb);
        conv_mat(p.in[hk::I_ED] + eo, 2048, 1024, 0, 2048, 2048, DN + (size_t)e * 2048 * 1024, 1024, 0, ldsb);
    }
}
__device__ __forceinline__ void ph_conv_weights(const Params& p, unsigned char* ldsb) {
    unsigned char* ws = p.ws;
    conv_mat(p.in[hk::I_ABIN], 6176, 2048, 0, 3072, 3072, (bf16_t*)(ws + hk::WS_WU), 2048, 0, ldsb);
    conv_mat(p.in[hk::I_ABIN], 6176, 2048, 3072 + 1024, 1024, 1024, (bf16_t*)(ws + hk::WS_WU) + (size_t)3072 * 2048, 2048, 0, ldsb);
    conv_mat(p.in[hk::I_ABIN], 6176, 2048, 3072, 1024, 1024, (bf16_t*)(ws + hk::WS_WGLA), 2048, 0, ldsb);
    conv_mat(p.in[hk::I_ABIN], 6176, 2048, 3072 + 2048, 1056, 1280, (bf16_t*)(ws + hk::WS_WGLA) + (size_t)1024 * 2048, 2048, 0, ldsb);
    conv_mat(p.in[hk::I_ABOUT], 2048, 2048, 0, 2048, 2048, (bf16_t*)(ws + hk::WS_WOUT0), 2048, 0, ldsb);
    conv_mat(p.in[hk::I_SWIN], 10368, 2048, 4096, 4096, 4096, (bf16_t*)(ws + hk::WS_WSSDIN), 2048, 0, ldsb);
    conv_mat(p.in[hk::I_SWIN], 10368, 2048, 0, 4096, 4096, (bf16_t*)(ws + hk::WS_WSSDIN) + (size_t)4096 * 2048, 2048, 0, ldsb);
    conv_mat(p.in[hk::I_SWIN], 10368, 2048, 8192, 2176, 2304, (bf16_t*)(ws + hk::WS_WSSDIN) + (size_t)8192 * 2048, 2048, 0, ldsb);
    conv_mat(p.in[hk::I_SWOUT], 2048, 4096, 0, 2048, 2048, (bf16_t*)(ws + hk::WS_WOUT1), 4096, 0, ldsb);
    bf16_t* W3T = (bf16_t*)(ws + hk::WS_W3T); const float* w3 = p.in[hk::I_FW3];
    for (int i = blockIdx.x * 512 + threadIdx.x; i < 4096 * 32; i += gridDim.x * 512) {
        const int col = i >> 5, k8 = (i & 31) * 8;
        u32x4 w = (u32x4){0u, 0u, 0u, 0u};
        if (k8 < 64) { float f[8];
#pragma unroll
            for (int j = 0; j < 8; ++j) f[j] = w3[(size_t)(k8 + j) * 4096 + col];
            w.x = pk2(f[0], f[1]); w.y = pk2(f[2], f[3]); w.z = pk2(f[4], f[5]); w.w = pk2(f[6], f[7]); }
        *(u32x4*)(W3T + (size_t)col * 256 + k8) = w;
    }
}
__device__ __forceinline__ void ph_hid(const Params& p, unsigned char* ldsb) {
    float* w1 = (float*)ldsb; float* b1 = w1 + 33 * 64; float* fr1 = b1 + 64; float* w2 = fr1 + 64; float* b2 = w2 + 64 * 64; float* fr2 = b2 + 64; float* h1 = fr2 + 64;
    const int tid = threadIdx.x;
    for (int i = tid; i < 33 * 64; i += 512) w1[i] = p.in[hk::I_FW1][i];
    for (int i = tid; i < 64 * 64; i += 512) w2[i] = p.in[hk::I_FW2][i];
    if (tid < 64) { b1[tid] = p.in[hk::I_FB1][tid]; fr1[tid] = p.in[hk::I_FFR1][tid]; b2[tid] = p.in[hk::I_FB2][tid]; fr2[tid] = p.in[hk::I_FFR2][tid]; }
    __syncthreads();
    const int j = tid & 63, pl = tid >> 6;
    bf16_t* HID2 = (bf16_t*)(p.ws + hk::WS_HID2); bf16_t* HID2C = (bf16_t*)(p.ws + hk::WS_HID2C);
    for (int pg = blockIdx.x; pg < (16384 + 256) / 8; pg += gridDim.x) {
        const int pid = pg * 8 + pl;
        const bool lat = pid < 16384; const int L = lat ? 16384 : 256, pos = lat ? pid : pid - 16384;
        const float t = (float)pos / (float)(L - 1);
        float s = b1[j] + t * w1[j];
        for (int b = 0; b < 16; ++b) {
            const float band = 1e-4f + (float)b * ((15.0f - 1e-4f) / 15.0f);
            float turns = band * (float)pos / (float)L; turns -= floorf(turns);
            const float ang = 6.283185307179586f * turns;
            s += cosf(ang) * w1[(1 + b) * 64 + j] - sinf(ang) * w1[(17 + b) * 64 + j];
        }
        h1[pl * 64 + j] = sinf(fr1[j] * s);
        __syncthreads();
        float s2 = b2[j];
        for (int i = 0; i < 64; ++i) s2 += h1[pl * 64 + i] * w2[i * 64 + j];
        const float v = sinf(fr2[j] * s2);
        bf16_t* row = (lat ? HID2 : HID2C) + (size_t)pos * 256;
        row[j] = f2bf(v); row[64 + j] = 0; row[128 + j] = 0; row[192 + j] = 0;
        __syncthreads();
    }
}
__device__ __forceinline__ void ph_modulate0(const Params& p, unsigned char* ldsb) {
    const int lane = threadIdx.x & 63, wave = __builtin_amdgcn_readfirstlane(threadIdx.x >> 6);
    bf16_t* HA = (bf16_t*)(p.ws + hk::WS_ACT + hk::A_HA);
    float* Lv = (float*)ldsb;
    { int t0 = threadIdx.x; asm volatile("" : "+v"(t0));
      for (int vct = 0; vct < 6; ++vct) *(f32x4*)(Lv + vct * 2048 + t0 * 4) = *(const f32x4*)(MODP(p.ws, 0, vct % 3, vct / 3) + t0 * 4);
      __syncthreads(); }
    for (int r = blockIdx.x * 8 + wave; r < hk::TA; r += gridDim.x * 8) {
        const int mv = mod_vec(r);
        const float* xin = r < hk::TL ? p.in[hk::I_X] + (size_t)r * 2048 : p.in[hk::I_CTX] + (size_t)(r - hk::TL) * 2048;
        const float* sh = Lv + mv * 2048; const float* sc = Lv + (3 + mv) * 2048;
#pragma unroll
        for (int i = 0; i < 8; ++i) {
            const int j = 4 * (lane + 64 * i);
            const f32x4 x = *(const f32x4*)(xin + j), a = *(const f32x4*)(sc + j), b = *(const f32x4*)(sh + j);
            u32x2 w; w.x = pk2(x[0] * (1.f + a[0]) + b[0], x[1] * (1.f + a[1]) + b[1]); w.y = pk2(x[2] * (1.f + a[2]) + b[2], x[3] * (1.f + a[3]) + b[3]);
            *(u32x2*)(HA + (size_t)r * 2048 + j) = w;
        }
    }
}

__device__ __forceinline__ void ph_ln1_router(const Params& p, int layer, unsigned char* ldsb, const bf16_t* YO, bf16_t* TOK) {
    float* rwT = (float*)ldsb; int* lcnt = (int*)(ldsb + 131072); int* lbase = lcnt + 16;
    const int tid = threadIdx.x, lane = tid & 63, wave = __builtin_amdgcn_readfirstlane(tid >> 6);
    const int T = layer == 0 ? hk::TA : hk::TL;
    for (int i = tid; i < 2048 * 16; i += 512) { const int j = i >> 4, e = i & 15; rwT[e * 2048 + j] = p.in[hk::I_RW][i]; }
    if (tid < 16) lcnt[tid] = 0;
    __syncthreads();
    float* CTXS = (float*)(p.ws + hk::WS_CTXS); int* ROWS = (int*)(p.ws + hk::WS_ACT + hk::A_ROWS);
    int* EXPERT = (int*)(p.ws + hk::WS_MISC + hk::MISC_EXP); float* GATE = (float*)(p.ws + hk::WS_MISC + hk::MISC_GATE); int* SLOT = (int*)(p.ws + hk::WS_MISC + hk::MISC_SLOT);
    const float* lng = p.in[hk::I_LNG] + (size_t)(layer * 2 + 0) * 2048; const float* lnb = p.in[hk::I_LNB] + (size_t)(layer * 2 + 0) * 2048;
    const float* rb = p.in[hk::I_RB];
    const bool deal0 = layer == 0 && gridDim.x == 256;
    const int nrnd = deal0 ? 17 : (T + (int)gridDim.x * 8 - 1) / ((int)gridDim.x * 8);
    auto row_at = [&](int kk) -> int {
        const int b = (int)blockIdx.x;
        if (!deal0) { const int r = b * 8 + wave + kk * (int)gridDim.x * 8; return r < T ? r : -1; }
        if (kk < 16) return (b >= 240 && kk < 4) ? -1 : b * 8 + wave + kk * 2048;
        if (b < 64) return hk::TL + b * 8 + wave;
        if (b < 128) { const int e = (b - 64) * 8 + wave, k4 = e >> 7, rem = e & 127; return (240 + (rem >> 3)) * 8 + (rem & 7) + k4 * 2048; }
        return -1;
    };
    for (int kk = 0; kk < nrnd; ++kk) {
        const int r = row_at(kk); if (r < 0) continue;
        if (deal0 && kk == 16 && blockIdx.x < 64) {
            const unsigned* fl = (const unsigned*)(p.ws + hk::WS_CTL) + hk::CW_CTXF; unsigned sp = 0u;
            while (__hip_atomic_load(fl, __ATOMIC_RELAXED, __HIP_MEMORY_SCOPE_AGENT) < 16u && ++sp < (1u << 22)) __builtin_amdgcn_s_sleep(2);
            __builtin_amdgcn_fence(__ATOMIC_ACQUIRE, "agent");
        }
        const int mv = mod_vec(r);
        const float* xin; float* xout;
        if (r < hk::TL) { xin = (layer == 0 ? p.in[hk::I_X] : p.out) + (size_t)r * 2048; xout = p.out + (size_t)r * 2048; }
        else { xin = (layer == 0 ? p.in[hk::I_CTX] : CTXS) + (size_t)(r - hk::TL) * 2048; xout = CTXS + (size_t)(r - hk::TL) * 2048; }
        const float* g1 = MODP(p.ws, layer, mv, 2); const float* sh2 = MODP(p.ws, layer, mv, 3); const float* sc2 = MODP(p.ws, layer, mv, 4);
        float sum = 0.f, sq = 0.f;
        f32x4 v[8];
#pragma unroll
        for (int hh = 0; hh < 2; ++hh) {   f32x4 xr[4], gr[4]; u32x2 yr[4];
#pragma unroll
            for (int i = 0; i < 4; ++i) { const int j = 4 * (lane + 64 * (4 * hh + i)); xr[i] = *(const f32x4*)(xin + j); yr[i] = *(const u32x2*)(YO + (size_t)r * 2048 + j); gr[i] = *(const f32x4*)(g1 + j); }
#pragma unroll
            for (int i = 0; i < 4; ++i) {
                const float y0 = __uint_as_float(yr[i].x << 16), y1 = __uint_as_float(yr[i].x & 0xFFFF0000u), y2 = __uint_as_float(yr[i].y << 16), y3 = __uint_as_float(yr[i].y & 0xFFFF0000u);
                const f32x4 t = (f32x4){hk::ALPHA * xr[i][0] + gr[i][0] * y0, hk::ALPHA * xr[i][1] + gr[i][1] * y1, hk::ALPHA * xr[i][2] + gr[i][2] * y2, hk::ALPHA * xr[i][3] + gr[i][3] * y3};
                v[4 * hh + i] = t;
                sum += (t[0] + t[1]) + (t[2] + t[3]); sq += (t[0] * t[0] + t[1] * t[1]) + (t[2] * t[2] + t[3] * t[3]);
            }
            asm volatile("" ::: "memory");
        }
        const float mean = wave_sum(sum) * (1.0f / 2048.0f);
        const float var = fmaxf(wave_sum(sq) * (1.0f / 2048.0f) - mean * mean, 0.f);
        const float rstd = rsqrtf(var + hk::LN_EPS);
        float lg[16];
#pragma unroll
        for (int e = 0; e < 16; ++e) lg[e] = 0.f;
        f32x4 ng = *(const f32x4*)(lng + 4 * lane), nb = *(const f32x4*)(lnb + 4 * lane), na2 = *(const f32x4*)(sc2 + 4 * lane), nb2 = *(const f32x4*)(sh2 + 4 * lane);
#pragma unroll
        for (int i = 0; i < 8; ++i) {
            const int j = 4 * (lane + 64 * i);
            const f32x4 g = ng, b = nb, a2 = na2, b2 = nb2;
            if (i < 7) { const int jn = j + 256; ng = *(const f32x4*)(lng + jn); nb = *(const f32x4*)(lnb + jn); na2 = *(const f32x4*)(sc2 + jn); nb2 = *(const f32x4*)(sh2 + jn); }
            asm volatile("" ::: "memory");
            f32x4 xn, tk;
#pragma unroll
            for (int q = 0; q < 4; ++q) { xn[q] = (v[i][q] - mean) * rstd * g[q] + b[q]; tk[q] = xn[q] * (1.f + a2[q]) + b2[q]; }
            *(f32x4*)(xout + j) = xn;
            u32x2 w; w.x = pk2(tk[0], tk[1]); w.y = pk2(tk[2], tk[3]);
            *(u32x2*)(TOK + (size_t)r * 2048 + j) = w;
#pragma unroll
            for (int e = 0; e < 16; ++e) { const f32x4 rw = *(const f32x4*)(rwT + e * 2048 + j); lg[e] += (tk[0] * rw[0] + tk[1] * rw[1]) + (tk[2] * rw[2] + tk[3] * rw[3]); }
            asm volatile("" ::: "memory");
        }
        float a8[8], a4[4], a2[2], tot;
        { const bool u = (lane & 32) != 0;
#pragma unroll
          for (int k = 0; k < 8; ++k) { const float send = u ? lg[k] : lg[8 + k], keep = u ? lg[8 + k] : lg[k]; a8[k] = keep + __shfl_xor(send, 32); } }
        { const bool u = (lane & 16) != 0;
#pragma unroll
          for (int k = 0; k < 4; ++k) { const float send = u ? a8[k] : a8[4 + k], keep = u ? a8[4 + k] : a8[k]; a4[k] = keep + __shfl_xor(send, 16); } }
        { const bool u = (lane & 8) != 0;
#pragma unroll
          for (int k = 0; k < 2; ++k) { const float send = u ? a4[k] : a4[2 + k], keep = u ? a4[2 + k] : a4[k]; a2[k] = keep + __shfl_xor(send, 8); } }
        { const bool u = (lane & 4) != 0; const float send = u ? a2[0] : a2[1], keep = u ? a2[1] : a2[0]; tot = keep + __shfl_xor(send, 4); }
        tot += __shfl_xor(tot, 2); tot += __shfl_xor(tot, 1);
        const float scE = __builtin_amdgcn_rcpf(1.0f + __expf(-tot)), selE = scE + rb[(lane >> 2) & 15];
        const int gl = lane & 48;
        const float s4[4] = {__shfl(selE, gl), __shfl(selE, gl + 4), __shfl(selE, gl + 8), __shfl(selE, gl + 12)};
        const float u4[4] = {__shfl(scE, gl), __shfl(scE, gl + 4), __shfl(scE, gl + 8), __shfl(scE, gl + 12)};
        float m1 = -1e30f, m2 = -1e30f;
#pragma unroll
        for (int q = 0; q < 4; ++q) { const float s = s4[q]; if (s > m1) { m2 = m1; m1 = s; } else if (s > m2) m2 = s; }
        const float gs = m1 + m2;
        int li1 = 0; float b1 = s4[0];
#pragma unroll
        for (int q = 1; q < 4; ++q) if (s4[q] > b1) { b1 = s4[q]; li1 = q; }
        int li2 = -1; float b2v = -1e30f;
#pragma unroll
        for (int q = 0; q < 4; ++q) if (q != li1 && s4[q] > b2v) { b2v = s4[q]; li2 = q; }
        const float lga = li1 == 0 ? u4[0] : li1 == 1 ? u4[1] : li1 == 2 ? u4[2] : u4[3];
        const float lgb = li2 == 0 ? u4[0] : li2 == 1 ? u4[1] : li2 == 2 ? u4[2] : u4[3];
        const float g4[4] = {__shfl(gs, 0), __shfl(gs, 16), __shfl(gs, 32), __shfl(gs, 48)};
        int grp = 0; float best = g4[0];
#pragma unroll
        for (int g = 1; g < 4; ++g) if (g4[g] > best) { best = g4[g]; grp = g; }
        const int i1 = __shfl(li1, 16 * grp), i2 = __shfl(li2, 16 * grp);
        const float ga = __shfl(lga, 16 * grp), gb = __shfl(lgb, 16 * grp);
        const float inv = __builtin_amdgcn_rcpf(ga + gb);
        if (lane == 0) {
            const int e1 = grp * 4 + i1, e2 = grp * 4 + i2;
            const int s1 = atomicAdd(&lcnt[e1], 1), s2 = atomicAdd(&lcnt[e2], 1);
            EXPERT[2 * r] = e1; EXPERT[2 * r + 1] = e2; GATE[2 * r] = ga * inv; GATE[2 * r + 1] = gb * inv; SLOT[2 * r] = s1; SLOT[2 * r + 1] = s2;
        }
    }
    __syncthreads();
    unsigned* gcnt = (unsigned*)(p.ws + hk::WS_CTL) + hk::CW_CNT + layer * 64;
    if (tid < 16) lbase[tid] = (int)atomicAdd(&gcnt[tid], (unsigned)lcnt[tid]);
    __syncthreads();
    for (int kk = 0; kk < nrnd; ++kk) {
        const int r = row_at(kk); if (r < 0) continue;
        if (lane == 0) {
            const int e1 = EXPERT[2 * r], e2 = EXPERT[2 * r + 1], s1 = SLOT[2 * r] + lbase[e1], s2 = SLOT[2 * r + 1] + lbase[e2];
            SLOT[2 * r] = s1; SLOT[2 * r + 1] = s2; ROWS[e1 * hk::ROWS_CAP + s1] = r; ROWS[e2 * hk::ROWS_CAP + s2] = r; }
    }
}

__device__ __forceinline__ void expert_starts(const unsigned* gcnt, int (&pstart)[17]) {
    int acc = 0;
#pragma unroll
    for (int e = 0; e < 16; ++e) { pstart[e] = acc; acc += (int)((__hip_atomic_load(gcnt + e, __ATOMIC_RELAXED, __HIP_MEMORY_SCOPE_AGENT) + 255u) & ~255u); }
    pstart[16] = acc;
}
__device__ __forceinline__ void ph_dispatch(const Params& p, int layer, const bf16_t* TOK, bf16_t* AG) {
    const int tid = threadIdx.x, lane = tid & 63, wave = tid >> 6;
    const int T = layer == 0 ? hk::TA : hk::TL;
    unsigned* ctl = (unsigned*)(p.ws + hk::WS_CTL);
    int pstart[17]; expert_starts(ctl + hk::CW_CNT + layer * 64, pstart);
    if (blockIdx.x == 0) {
        const int nt = pstart[16] >> 8;
        if (tid == 0) ctl[hk::CW_NT + layer * 64] = (unsigned)nt;
        for (int rt = tid; rt < nt; rt += 512) { int e = 0;
#pragma unroll
            for (int q = 1; q < 16; ++q) if (rt * 256 >= pstart[q]) e = q;
            ctl[hk::CW_TILEE + layer * 320 + rt] = (unsigned)e; }
    }
    const int* EXPERT = (const int*)(p.ws + hk::WS_MISC + hk::MISC_EXP); const int* SLOT = (const int*)(p.ws + hk::WS_MISC + hk::MISC_SLOT); int* DEST = (int*)(p.ws + hk::WS_MISC + hk::MISC_DEST); int* ROWTOK = (int*)(p.ws + hk::WS_MISC + hk::MISC_ROWTOK);
    (void)lane; (void)wave; (void)TOK; (void)AG;
    for (int r = blockIdx.x * 512 + tid; r < T; r += gridDim.x * 512) {
#pragma unroll
        for (int k = 0; k < 2; ++k) {
            const int e = EXPERT[2 * r + k], s = SLOT[2 * r + k];
            int ps = 0;
#pragma unroll
            for (int q = 0; q < 16; ++q) ps = (e == q) ? pstart[q] : ps;
            const int d = ps + s;
            DEST[2 * r + k] = d; ROWTOK[d] = r;
        }
    }
}

__device__ __forceinline__ void ph_ln2(const Params& p, int layer, const bf16_t* YR, bf16_t* HNEXT, unsigned char* ldsb) {
    const int lane = threadIdx.x & 63, wave = __builtin_amdgcn_readfirstlane(threadIdx.x >> 6);
    const int T = layer == 0 ? hk::TA : hk::TL;
    if (layer == 0) { int* ROWS = (int*)(p.ws + hk::WS_ACT + hk::A_ROWS);
        for (int i = blockIdx.x * 512 + threadIdx.x; i < 16 * hk::ROWS_CAP; i += gridDim.x * 512) ROWS[i] = 0; }
    int pstart[17]; expert_starts((const unsigned*)(p.ws + hk::WS_CTL) + hk::CW_CNT + layer * 64, pstart);
#pragma unroll
    for (int q = 0; q < 17; ++q) pstart[q] = __builtin_amdgcn_readfirstlane(pstart[q]);
    float* CTXS = (float*)(p.ws + hk::WS_CTXS);
    const int* EXPERT = (const int*)(p.ws + hk::WS_MISC + hk::MISC_EXP); const int* SLOT = (const int*)(p.ws + hk::WS_MISC + hk::MISC_SLOT); const float* GATE = (const float*)(p.ws + hk::WS_MISC + hk::MISC_GATE);
    const float* lng = p.in[hk::I_LNG] + (size_t)(layer * 2 + 1) * 2048; const float* lnb = p.in[hk::I_LNB] + (size_t)(layer * 2 + 1) * 2048;
    float* Lv = (float*)ldsb;
    { const int nvec = layer == 0 ? 11 : 5; int t0 = threadIdx.x; asm volatile("" : "+v"(t0));
      for (int vct = 0; vct < nvec; ++vct) { const int j = t0 * 4;
          const float* src = vct == 0 ? lng : vct == 1 ? lnb : vct < 5 ? MODP(p.ws, layer, vct - 2, 5) : vct < 8 ? MODP(p.ws, 1, vct - 5, 1) : MODP(p.ws, 1, vct - 8, 0);
          *(f32x4*)(Lv + vct * 2048 + j) = *(const f32x4*)(src + j); }
      __syncthreads(); }
    for (int r = blockIdx.x * 8 + wave; r < T; r += gridDim.x * 8) {
        const int mv = mod_vec(r);
        float* xio = r < hk::TL ? p.out + (size_t)r * 2048 : CTXS + (size_t)(r - hk::TL) * 2048;
        const float* g2 = Lv + (2 + mv) * 2048;
        const int ea = __builtin_amdgcn_readfirstlane(EXPERT[2 * r]), eb = __builtin_amdgcn_readfirstlane(EXPERT[2 * r + 1]); int pa = 0, pb = 0;
#pragma unroll
        for (int q = 0; q < 16; ++q) { pa = ea == q ? pstart[q] : pa; pb = eb == q ? pstart[q] : pb; }
        const int d0 = pa + __builtin_amdgcn_readfirstlane(SLOT[2 * r]), d1 = pb + __builtin_amdgcn_readfirstlane(SLOT[2 * r + 1]);
        const float w0 = __int_as_float(__builtin_amdgcn_readfirstlane(__float_as_int(GATE[2 * r]))), w1 = __int_as_float(__builtin_amdgcn_readfirstlane(__float_as_int(GATE[2 * r + 1])));
        float v[32]; float sum = 0.f;
#pragma unroll
        for (int i = 0; i < 8; ++i) {
            const int j = 4 * (lane + 64 * i);
            const f32x4 x = *(const f32x4*)(xio + j), g = *(const f32x4*)(g2 + j);
            const u32x2 ya = *(const u32x2*)(YR + (size_t)d0 * 2048 + j), yb = *(const u32x2*)(YR + (size_t)d1 * 2048 + j);
            float y[4];
            y[0] = w0 * __uint_as_float(ya.x << 16) + w1 * __uint_as_float(yb.x << 16); y[1] = w0 * __uint_as_float(ya.x & 0xFFFF0000u) + w1 * __uint_as_float(yb.x & 0xFFFF0000u);
            y[2] = w0 * __uint_as_float(ya.y << 16) + w1 * __uint_as_float(yb.y << 16); y[3] = w0 * __uint_as_float(ya.y & 0xFFFF0000u) + w1 * __uint_as_float(yb.y & 0xFFFF0000u);
#pragma unroll
            for (int q = 0; q < 4; ++q) { v[4 * i + q] = hk::ALPHA * x[q] + g[q] * y[q]; sum += v[4 * i + q]; }
        }
        const float mean = wave_sum(sum) * (1.0f / 2048.0f);
        float sq = 0.f;
#pragma unroll
        for (int k = 0; k < 32; ++k) { const float d = v[k] - mean; sq += d * d; }
        const float rstd = rsqrtf(wave_sum(sq) * (1.0f / 2048.0f) + hk::LN_EPS);
        const float* sh = Lv + (8 + mv) * 2048; const float* sc = Lv + (5 + mv) * 2048;
#pragma unroll
        for (int i = 0; i < 8; ++i) {
            const int j = 4 * (lane + 64 * i);
            const f32x4 g = *(const f32x4*)(Lv + j), b = *(const f32x4*)(Lv + 2048 + j);
            f32x4 xn;
#pragma unroll
            for (int q = 0; q < 4; ++q) xn[q] = (v[4 * i + q] - mean) * rstd * g[q] + b[q];
#if PROBE_STAMP || defined(PROBE_PHASE)
            if (layer == 1 && r == 0 && i == 0 && lane == 0) { const float fr = ((const float*)(p.ws + hk::WS_CTL))[hk::CW_PROBE]; xn[0] += sqrtf((1e-4f + 8e-4f * fr) * 6.72e7f); }
#endif
            *(f32x4*)(xio + j) = xn;
            if (layer == 0) {
                const f32x4 a = *(const f32x4*)(sc + j), bb = *(const f32x4*)(sh + j);
                u32x2 w; w.x = pk2(xn[0] * (1.f + a[0]) + bb[0], xn[1] * (1.f + a[1]) + bb[1]); w.y = pk2(xn[2] * (1.f + a[2]) + bb[2], xn[3] * (1.f + a[3]) + bb[3]);
                *(u32x2*)(HNEXT + (size_t)r * 2048 + j) = w;
            }
            asm volatile("" ::: "memory");
        }
    }
}
__device__ __forceinline__ void ph_gla_scan_naive(const Params& p, unsigned char* ldsb) {
    float* w2s = (float*)ldsb;
    float* bs = w2s + 16 * 128;
    float* qs = bs + 128;
    float* ks = qs + 32 * 128; float* as = ks + 32 * 128;
    float* vv = as + 32 * 128;
    float* part = vv + 32 * 16;
    const int tid = threadIdx.x, lane = tid & 63, wave = tid >> 6;
    const bf16_t* GL = (const bf16_t*)(p.ws + hk::WS_ACT + hk::A_GL);
    for (int it = blockIdx.x; it < 256; it += gridDim.x) {
        const int b = it >> 7, dir = (it >> 6) & 1, h = (it >> 4) & 3, vs = it & 15;
        bf16_t* OUT = (bf16_t*)(p.ws + hk::WS_ACT + (dir == 0 ? hk::A_OF : hk::A_OB));
        __syncthreads();
        for (int i = tid; i < 16 * 128; i += 512) { const int r = i >> 7, kk = i & 127; w2s[i] = p.in[hk::I_GW2][(size_t)(dir * 16 + r) * 512 + h * 128 + kk]; }
        if (tid < 128) bs[tid] = p.in[hk::I_GB][dir * 512 + h * 128 + tid];
        __syncthreads();
        const int v = tid & 15, kg = tid >> 4;
        float S[4] = {0.f, 0.f, 0.f, 0.f};
        for (int seg = 0; seg < 2; ++seg) {
            const int n = seg == 0 ? hk::CTXL : hk::SEQ, rowbase = seg == 0 ? hk::TL + b * hk::CTXL : b * hk::SEQ;
            for (int t0 = 0; t0 < n; t0 += 32) {
                for (int idx = tid; idx < 32 * 128; idx += 512) {
                    const int s = idx >> 7, kk = idx & 127, tt = t0 + s, t = dir == 0 ? tt : n - 1 - tt;
                    const bf16_t* row = GL + (size_t)(rowbase + t) * hk::GL_LD;
                    qs[idx] = bf2f(row[h * 128 + kk]) * 0.08838834764831845f;
                    ks[idx] = bf2f(row[512 + h * 128 + kk]);
                    float z = bs[kk];
#pragma unroll
                    for (int r = 0; r < 16; ++r) z += bf2f(row[hk::GL_GK + dir * 16 + r]) * w2s[r * 128 + kk];
                    const float ls = z >= 0.f ? -log1pf(expf(-z)) : z - log1pf(expf(z));
                    as[idx] = expf(ls * (1.0f / 16.0f));
                }
                { const int s = tid >> 4, tt = t0 + s, t = dir == 0 ? tt : n - 1 - tt;
                  vv[tid] = bf2f(((const bf16_t*)(p.ws + hk::WS_ACT + hk::A_VTG))[(size_t)(h * 256 + vs * 16 + v) * hk::TA + rowbase + t]); }
                __syncthreads();
#pragma unroll 4
                for (int s = 0; s < 32; ++s) {
                    const f32x4 a4 = *(const f32x4*)(as + s * 128 + kg * 4), k4 = *(const f32x4*)(ks + s * 128 + kg * 4), q4 = *(const f32x4*)(qs + s * 128 + kg * 4);
                    const float vval = vv[s * 16 + v];
                    float o = 0.f;
#pragma unroll
                    for (int i = 0; i < 4; ++i) { S[i] = a4[i] * S[i] + k4[i] * vval; o += q4[i] * S[i]; }
                    o += __shfl_xor(o, 16); o += __shfl_xor(o, 32);
                    if (lane < 16) part[(s * 8 + wave) * 16 + lane] = o;
                }
                __syncthreads();
                { const int s = tid >> 4, tt = t0 + s, t = dir == 0 ? tt : n - 1 - tt;
                  float o = 0.f;
#pragma unroll
                  for (int w = 0; w < 8; ++w) o += part[(s * 8 + w) * 16 + v];
                  OUT[(size_t)(rowbase + t) * 1024 + h * 256 + vs * 16 + v] = f2bf(o); }
                __syncthreads();
            }
        }
    }
}
__device__ __forceinline__ void ph_mix_finish(const Params& p, unsigned char* ldsb) {
    const int tid = threadIdx.x, lane = tid & 63, wave = tid >> 6;
    const bf16_t* OF = (const bf16_t*)(p.ws + hk::WS_ACT + hk::A_OF); const bf16_t* OB = (const bf16_t*)(p.ws + hk::WS_ACT + hk::A_OB);
    const bf16_t* GL = (const bf16_t*)(p.ws + hk::WS_ACT + hk::A_GL);
    bf16_t* MIX = (bf16_t*)(p.ws + hk::WS_ACT + hk::A_HA);
    const float* ng = p.in[hk::I_GNG];
    for (int r = blockIdx.x * 8 + wave; r < hk::TA; r += gridDim.x * 8) {
        float o[16]; float ss = 0.f;
#pragma unroll
        for (int i = 0; i < 2; ++i) {
            float a[8], bq[8]; unpack8(*(const u32x4*)(OF + (size_t)r * 1024 + lane * 16 + 8 * i), a); unpack8(*(const u32x4*)(OB + (size_t)r * 1024 + lane * 16 + 8 * i), bq);
#pragma unroll
            for (int q = 0; q < 8; ++q) { o[8 * i + q] = a[q] + bq[q]; ss += o[8 * i + q] * o[8 * i + q]; }
        }
        ss += __shfl_xor(ss, 1); ss += __shfl_xor(ss, 2); ss += __shfl_xor(ss, 4); ss += __shfl_xor(ss, 8);
        const float rs = rsqrtf(ss * (1.0f / 256.0f) + hk::LN_EPS);
        const u32x4 r0 = *(const u32x4*)(GL + (size_t)r * hk::GL_LD + hk::GL_G + lane * 16), r1 = *(const u32x4*)(GL + (size_t)r * hk::GL_LD + hk::GL_G + lane * 16 + 8);
        float rr[16]; { float t8[8]; unpack8(r0, t8);
#pragma unroll
            for (int q = 0; q < 8; ++q) rr[q] = t8[q]; unpack8(r1, t8);
#pragma unroll
            for (int q = 0; q < 8; ++q) rr[8 + q] = t8[q]; }
        float f[16];
#pragma unroll
        for (int q = 0; q < 16; ++q) f[q] = o[q] * rs * ng[lane * 16 + q] * silu_f(rr[q]);
        u32x4 w0, w1; w0.x = pk2(f[0], f[1]); w0.y = pk2(f[2], f[3]); w0.z = pk2(f[4], f[5]); w0.w = pk2(f[6], f[7]); w1.x = pk2(f[8], f[9]); w1.y = pk2(f[10], f[11]); w1.z = pk2(f[12], f[13]); w1.w = pk2(f[14], f[15]);
        *(u32x4*)(MIX + (size_t)r * 2048 + 1024 + lane * 16) = w0; *(u32x4*)(MIX + (size_t)r * 2048 + 1024 + lane * 16 + 8) = w1;
    }
    const bf16_t* YT = (const bf16_t*)(p.ws + hk::WS_ACT + hk::A_YT);
    bf16_t* tile = (bf16_t*)ldsb;
    __syncthreads();
    for (int t = blockIdx.x; t < 16 * (hk::TA / 64); t += gridDim.x) {
        const int ct = t & 15, tt = t >> 4, c0 = ct * 64, tok0 = tt * 64;
        { const int c = tid >> 3, q = tid & 7;
          const u32x4 w = *(const u32x4*)(YT + (size_t)(c0 + c) * hk::TA + tok0 + q * 8);
          unsigned* dstw = (unsigned*)(tile + c * 66 + q * 8);
          dstw[0] = w.x; dstw[1] = w.y; dstw[2] = w.z; dstw[3] = w.w; }
        __syncthreads();
        { const int tk = tid >> 3, q = tid & 7;
          bf16_t e[8];
#pragma unroll
          for (int j = 0; j < 8; ++j) e[j] = tile[(q * 8 + j) * 66 + tk];
          u32x4 w; w.x = e[0] | ((unsigned)e[1] << 16); w.y = e[2] | ((unsigned)e[3] << 16); w.z = e[4] | ((unsigned)e[5] << 16); w.w = e[6] | ((unsigned)e[7] << 16);
          *(u32x4*)(MIX + (size_t)(tok0 + tk) * 2048 + c0 + q * 8) = w; }
        __syncthreads();
    }
}
namespace hy {
constexpr int PADF = 1024, L = 16384;
__device__ __forceinline__ float sconv(const bf16_t* row, int t, int n, float w0, float w1, float w2, float bias) {
    const float a = t > 0 ? bf2f(row[t - 1]) : 0.f, b = bf2f(row[t]), c = t + 1 < n ? bf2f(row[t + 1]) : 0.f;
    return w0 * a + w1 * b + w2 * c + bias;
}
template <int SGN> __device__ __forceinline__ void lconv8(const float* u, const bf16_t* f, int t0, int trips, float (&acc)[8]) {
    float W[16];
    if (SGN > 0) {
#pragma unroll
        for (int x = 0; x < 8; ++x) W[8 + x] = u[PADF + t0 + x];
        for (int it = 0; it < trips; ++it) {
            const int d0 = it * 8;
            const f32x4 lo0 = *(const f32x4*)(u + PADF + t0 - d0 - 8), lo1 = *(const f32x4*)(u + PADF + t0 - d0 - 4);
            W[0] = lo0[0]; W[1] = lo0[1]; W[2] = lo0[2]; W[3] = lo0[3]; W[4] = lo1[0]; W[5] = lo1[1]; W[6] = lo1[2]; W[7] = lo1[3];
            float fe[8]; unpack8(*(const u32x4*)(f + d0), fe);
#pragma unroll
            for (int e = 0; e < 8; ++e)
#pragma unroll
                for (int i = 0; i < 8; ++i) acc[i] += fe[e] * W[8 + i - e];
#pragma unroll
            for (int x = 0; x < 8; ++x) W[8 + x] = W[x];
        }
    } else {
#pragma unroll
        for (int x = 0; x < 8; ++x) W[x] = u[PADF + t0 + x];
        for (int it = 0; it < trips; ++it) {
            const int d0 = it * 8;
            const f32x4 hi0 = *(const f32x4*)(u + PADF + t0 + d0 + 8), hi1 = *(const f32x4*)(u + PADF + t0 + d0 + 12);
            W[8] = hi0[0]; W[9] = hi0[1]; W[10] = hi0[2]; W[11] = hi0[3]; W[12] = hi1[0]; W[13] = hi1[1]; W[14] = hi1[2]; W[15] = hi1[3];
            float fe[8]; unpack8(*(const u32x4*)(f + d0), fe);
#pragma unroll
            for (int e = 0; e < 8; ++e)
#pragma unroll
                for (int i = 0; i < 8; ++i) acc[i] += fe[e] * W[i + e];
#pragma unroll
            for (int x = 0; x < 8; ++x) W[x] = W[8 + x];
        }
    }
}
}
__device__ __forceinline__ void ph_hyena_naive(const Params& p, unsigned char* ldsb) {
    using namespace hy;
    float* u = (float*)ldsb;
    bf16_t* f = (bf16_t*)(u + (PADF + L + PADF));
    float* tmp = (float*)(p.ws + hk::WS_ACT + hk::A_HYTMP) + (size_t)blockIdx.x * L;
    const int tid = threadIdx.x, wave = tid >> 6;
    const bf16_t* UT = (const bf16_t*)(p.ws + hk::WS_ACT + hk::A_UT);
    const bf16_t* HF = (const bf16_t*)(p.ws + hk::WS_ACT + hk::A_HF); const bf16_t* HFC = (const bf16_t*)(p.ws + hk::WS_ACT + hk::A_HFC);
    bf16_t* YT = (bf16_t*)(p.ws + hk::WS_ACT + hk::A_YT);
    const float* cw = p.in[hk::I_HCW]; const float* cb = p.in[hk::I_HCB]; const float* lb = p.in[hk::I_HLB];
    for (int c = blockIdx.x; c < 1024; c += gridDim.x) {
        const float delta = fabsf(-3.0701134573253945f + (-15.350567286626973f + 3.0701134573253945f) * ((float)c / 1023.0f));
        float wv[3][4];
#pragma unroll
        for (int q = 0; q < 3; ++q) { wv[q][0] = cw[0 * 3072 + q * 1024 + c]; wv[q][1] = cw[1 * 3072 + q * 1024 + c]; wv[q][2] = cw[2 * 3072 + q * 1024 + c]; wv[q][3] = cb[q * 1024 + c]; }
        const bf16_t* rv = UT + (size_t)c * hk::TA; const bf16_t* r1 = UT + (size_t)(1024 + c) * hk::TA; const bf16_t* r2 = UT + (size_t)(2048 + c) * hk::TA;
        for (int b = 0; b < 2; ++b) {
            const int base = b * L;
            __syncthreads();
            for (int i = tid; i < PADF; i += 512) { u[i] = 0.f; u[PADF + L + i] = 0.f; }
            for (int t = tid; t < L; t += 512) u[PADF + t] = sconv(rv + base, t, L, wv[0][0], wv[0][1], wv[0][2], wv[0][3]);
            for (int o = 0; o < 2; ++o) {
                __syncthreads();
                for (int dir = 0; dir < 2; ++dir) {
                    const bf16_t* hrow = HF + (size_t)((o * 2 + dir) * 1024 + c) * L;
                    for (int m = tid; m < L; m += 512) f[dir * L + m] = (dir == 1 && m == 0) ? (bf16_t)0 : f2bf(bf2f(hrow[m]) * expf(-((float)m / (float)(L - 1)) * delta));
                }
                __syncthreads();
                const float d = lb[o * 1024 + c];
#pragma unroll 1
                for (int jj = 0; jj < 4; ++jj) {
                    const int t0 = 8 * (tid + 512 * jj), tw0 = 8 * (wave * 64 + 512 * jj);
                    float acc[8];
#pragma unroll
                    for (int i = 0; i < 8; ++i) acc[i] = 0.f;
                    lconv8<1>(u, f, t0, (tw0 + 8 * 63 + 7) / 8 + 1, acc);
                    lconv8<-1>(u, f + L, t0, (L - tw0 + 7) / 8, acc);
                    float res[8];
#pragma unroll
                    for (int i = 0; i < 8; ++i) {
                        const int t = t0 + i;
                        const float g = o == 0 ? sconv(r1 + base, t, L, wv[1][0], wv[1][1], wv[1][2], wv[1][3]) : sconv(r2 + base, t, L, wv[2][0], wv[2][1], wv[2][2], wv[2][3]);
                        res[i] = g * (acc[i] + d * u[PADF + t]);
                    }
                    if (o == 0) {
                        *(f32x4*)(tmp + t0) = (f32x4){res[0], res[1], res[2], res[3]}; *(f32x4*)(tmp + t0 + 4) = (f32x4){res[4], res[5], res[6], res[7]};
                    } else {
                        u32x4 w; w.x = pk2(res[0], res[1]); w.y = pk2(res[2], res[3]); w.z = pk2(res[4], res[5]); w.w = pk2(res[6], res[7]);
                        *(u32x4*)(YT + (size_t)c * hk::TA + base + t0) = w;
                    }
                }
                if (o == 0) {
                    __syncthreads();
#pragma unroll 1
                    for (int jj = 0; jj < 4; ++jj) {
                        const int t0 = 8 * (tid + 512 * jj);
                        *(f32x4*)(u + PADF + t0) = *(const f32x4*)(tmp + t0); *(f32x4*)(u + PADF + t0 + 4) = *(const f32x4*)(tmp + t0 + 4);
                    }
                }
            }
        }
        {
            __syncthreads();
            float* uc = u;
            float* fc = u + 512;
            const int b = tid >> 8, t = tid & 255, cbase = hk::TL + b * 256;
            uc[tid] = sconv(rv + cbase, t, 256, wv[0][0], wv[0][1], wv[0][2], wv[0][3]);
            for (int i = tid; i < 1024; i += 512) { const int od = i >> 8, m = i & 255; fc[i] = bf2f(HFC[(size_t)(od * 1024 + c) * 256 + m]) * expf(-((float)m / 255.0f) * delta); }
            __syncthreads();
            float y = uc[tid];
            for (int o = 0; o < 2; ++o) {
                float a = 0.f;
                for (int s = 0; s <= t; ++s) a += fc[(o * 2 + 0) * 256 + (t - s)] * uc[b * 256 + s];
                for (int s = t + 1; s < 256; ++s) a += fc[(o * 2 + 1) * 256 + (s - t)] * uc[b * 256 + s];
                const float g = o == 0 ? sconv(r1 + cbase, t, 256, wv[1][0], wv[1][1], wv[1][2], wv[1][3]) : sconv(r2 + cbase, t, 256, wv[2][0], wv[2][1], wv[2][2], wv[2][3]);
                y = g * (a + lb[o * 1024 + c] * y);
                __syncthreads();
                uc[tid] = y;
                __syncthreads();
            }
            YT[(size_t)c * hk::TA + cbase + t] = f2bf(y);
        }
    }
}
#ifndef HY_LO
#define HY_LO 2
#endif
namespace hf {
constexpr int N = 32768, L = 16384, ROWB = 144, PLB = 4624, WBYTES = 32 * PLB;
typedef short bf16x8 __attribute__((ext_vector_type(8)));
typedef float f32x16 __attribute__((ext_vector_type(16)));
__device__ __forceinline__ unsigned waddr(int p, int r, int i) { return (unsigned)(p * PLB + r * ROWB + i * 4); }
struct Dft { bf16x8 re[4], im[4]; };
__device__ __forceinline__ void make_dft(Dft& d, int lane) {
    const int k = lane & 31, g = lane >> 5;
#pragma unroll
    for (int s = 0; s < 4; ++s) {
        unsigned pr[4], pi[4];
#pragma unroll
        for (int jj = 0; jj < 4; ++jj) {
            const int a = 8 * s + 4 * g + jj;
            const float t = (float)((a * k) & 31) * (1.0f / 32.0f);
            const float c = __builtin_amdgcn_cosf(t), sn = __builtin_amdgcn_sinf(t);
            pr[jj] = pk2(c, sn);
            pi[jj] = pk2(-sn, c);
        }
        u32x4 a4 = (u32x4){pr[0], pr[1], pr[2], pr[3]}, b4 = (u32x4){pi[0], pi[1], pi[2], pi[3]};
        d.re[s] = __builtin_bit_cast(bf16x8, a4); d.im[s] = __builtin_bit_cast(bf16x8, b4);
    }
}
enum { EPI_TW0 = 0, EPI_TW1 = 1, EPI_HSTORE = 2, EPI_HMUL = 3, EPI_GATE = 4, EPI_RAW = 5 };
struct EpiArgs { unsigned* hs; const unsigned* xg; unsigned* vg; float d; int store_vg; };
template <bool ROWBLK, bool BFORM, int KS, int EPI>
__device__ __forceinline__ void fft_stage(unsigned char* W, const Dft& dft, int wave, int lane, const EpiArgs& ea) {
    const int k = lane & 31, g = lane >> 5;
    const float twc = __builtin_amdgcn_cosf((float)k * (1.0f / 1024.0f)), tws = __builtin_amdgcn_sinf((float)k * (1.0f / 1024.0f));
#pragma unroll 1
    for (int bi = 0; bi < 4; ++bi) {
        const int l = wave + 8 * bi;
        int kx = k; asm volatile("" : "+v"(kx));
        const unsigned base = ROWBLK ? waddr(kx, l, 0) : waddr(l, kx, 0);
        u32x4 pre0[4], pre1[2];
        if (EPI == EPI_HMUL) {
#pragma unroll
            for (int q = 0; q < 4; ++q) pre0[q] = *(const u32x4*)(ea.hs + ((kx * 32 + l) * 32 + 8 * q + 4 * g));
        }
        if (EPI == EPI_GATE) {
#pragma unroll
            for (int q = 0; q < 2; ++q) { const int gi = (l * 32 + kx) * 16 + 8 * q + 4 * g; pre0[q] = *(const u32x4*)(ea.xg + gi); pre1[q] = *(const u32x4*)(ea.vg + gi); }
        }
        bf16x8 dat[KS];
#pragma unroll
        for (int s = 0; s < KS; ++s) dat[s] = *(const bf16x8*)(W + base + 16 * (2 * s + g));
        f32x16 dre, dim;
#pragma unroll
        for (int i = 0; i < 16; ++i) { dre[i] = 0.f; dim[i] = 0.f; }
#pragma unroll
        for (int s = 0; s < KS; ++s) {
            if (!BFORM) { dre = __builtin_amdgcn_mfma_f32_32x32x16_bf16(dat[s], dft.re[s], dre, 0, 0, 0); dim = __builtin_amdgcn_mfma_f32_32x32x16_bf16(dat[s], dft.im[s], dim, 0, 0, 0); }
            else        { dre = __builtin_amdgcn_mfma_f32_32x32x16_bf16(dft.re[s], dat[s], dre, 0, 0, 0); dim = __builtin_amdgcn_mfma_f32_32x32x16_bf16(dft.im[s], dat[s], dim, 0, 0, 0); }
        }
#pragma unroll
        for (int q = 0; q < 4; ++q) {
            if (EPI == EPI_GATE && q >= 2) continue;
            const int ri0 = 8 * q + 4 * g;
            float orr[4], oii[4];
            if (EPI == EPI_TW0 || EPI == EPI_TW1) {
                const int e = (kx * (32 * ri0 + (EPI == EPI_TW1 ? l : 0))) & (N - 1);
                const float t = (float)e * (1.0f / (float)N);
                float c = __builtin_amdgcn_cosf(t), sn = __builtin_amdgcn_sinf(t);
#pragma unroll
                for (int r = 0; r < 4; ++r) {
                    const float a = dre[4 * q + r], b = dim[4 * q + r];
                    orr[r] = a * c + b * sn; oii[r] = b * c - a * sn;
                    const float c2 = c * twc - sn * tws, s2 = sn * twc + c * tws; c = c2; sn = s2;
                }
            } else if (EPI == EPI_HSTORE || EPI == EPI_RAW) {
#pragma unroll
                for (int r = 0; r < 4; ++r) { orr[r] = dre[4 * q + r]; oii[r] = dim[4 * q + r]; }
            } else if (EPI == EPI_HMUL) {
                const u32x4 h4 = pre0[q];
                const unsigned hw[4] = {h4.x, h4.y, h4.z, h4.w};
#pragma unroll
                for (int r = 0; r < 4; ++r) {
                    const float hr = __uint_as_float(hw[r] << 16), hi = __uint_as_float(hw[r] & 0xFFFF0000u);
                    const float a = dre[4 * q + r], b = dim[4 * q + r];
                    orr[r] = a * hr - b * hi; oii[r] = -(a * hi + b * hr);
                }
            } else {
                const u32x4 x4 = pre0[q & 1], v4 = pre1[q & 1];
                const unsigned xw[4] = {x4.x, x4.y, x4.z, x4.w}, vw[4] = {v4.x, v4.y, v4.z, v4.w};
#pragma unroll
                for (int r = 0; r < 4; ++r) {
                    const float xr = __uint_as_float(xw[r] << 16), xi = __uint_as_float(xw[r] & 0xFFFF0000u), vr = __uint_as_float(vw[r] << 16), vi = __uint_as_float(vw[r] & 0xFFFF0000u);
                    orr[r] = xr * (dre[4 * q + r] + ea.d * vr); oii[r] = xi * (-dim[4 * q + r] + ea.d * vi);
                }
            }
            u32x4 w; w.x = pk2(orr[0], oii[0]); w.y = pk2(orr[1], oii[1]); w.z = pk2(orr[2], oii[2]); w.w = pk2(orr[3], oii[3]);
            if (EPI == EPI_HSTORE) *(u32x4*)(ea.hs + ((kx * 32 + l) * 32 + ri0)) = w;
            else {
                *(u32x4*)(W + base + 4 * ri0) = w;
                if (EPI == EPI_GATE && ea.store_vg) *(u32x4*)(ea.vg + ((l * 32 + kx) * 16 + ri0)) = w;
            }
        }
    }
}

__device__ __forceinline__ void sconv8(const bf16_t* row, int t0, int n, const float (&w)[4], float (&out)[8]) {
    float f[8]; unpack8(*(const u32x4*)(row + t0), f);
    const float lo = t0 > 0 ? bf2f(row[t0 - 1]) : 0.f, hi = t0 + 8 < n ? bf2f(row[t0 + 8]) : 0.f;
#pragma unroll
    for (int i = 0; i < 8; ++i) { const float a = i == 0 ? lo : f[i - 1], c = i == 7 ? hi : f[i + 1]; out[i] = w[0] * a + w[1] * f[i] + w[2] * c + w[3]; }
}
__device__ __forceinline__ void sconv8_pack(const bf16_t* row, int t0, const float (&w)[4], unsigned* dst) {
    float a[8], b[8]; sconv8(row, t0, L, w, a); sconv8(row + L, t0, L, w, b);
    u32x4 p0, p1; p0.x = pk2(a[0], b[0]); p0.y = pk2(a[1], b[1]); p0.z = pk2(a[2], b[2]); p0.w = pk2(a[3], b[3]); p1.x = pk2(a[4], b[4]); p1.y = pk2(a[5], b[5]); p1.z = pk2(a[6], b[6]); p1.w = pk2(a[7], b[7]);
    *(u32x4*)(dst + t0) = p0; *(u32x4*)(dst + t0 + 4) = p1;
}
}

__device__ __forceinline__ void ph_hyena_fft(const Params& p, unsigned char* ldsb) {
    using namespace hf;
    unsigned char* W = ldsb;
    const int tid0 = threadIdx.x;
    const bf16_t* UT = (const bf16_t*)(p.ws + hk::WS_ACT + hk::A_UT);
    const bf16_t* HF = (const bf16_t*)(p.ws + hk::WS_ACT + hk::A_HF); const bf16_t* HFC = (const bf16_t*)(p.ws + hk::WS_ACT + hk::A_HFC);
    bf16_t* YT = (bf16_t*)(p.ws + hk::WS_ACT + hk::A_YT);
    unsigned* scr = (unsigned*)(p.ws + hk::WS_ACT + hk::A_HYS) + (size_t)blockIdx.x * (448 * 1024 / 4);
    unsigned* HS = scr; unsigned* XG1 = scr + 65536; unsigned* XG2 = XG1 + 16384; unsigned* VG = XG2 + 16384;
    const float* cw = p.in[hk::I_HCW]; const float* cb = p.in[hk::I_HCB]; const float* lb = p.in[hk::I_HLB];
    EpiArgs ea{};
    int c_lo, c_hi;
    if (gridDim.x == 256) { const int bx = blockIdx.x; if (bx < 128) { c_lo = bx * HY_LO; c_hi = c_lo + HY_LO; } else { c_lo = 128 * HY_LO + (bx - 128) * (8 - HY_LO); c_hi = c_lo + (8 - HY_LO); } }
    else { const int per = (1024 + gridDim.x - 1) / gridDim.x; c_lo = blockIdx.x * per; c_hi = c_lo + per < 1024 ? c_lo + per : 1024; }
    for (int c = c_lo; c < c_hi; ++c) {
        int tid = tid0; asm volatile("" : "+v"(tid));
        const int wave = __builtin_amdgcn_readfirstlane(tid >> 6), lane = tid & 63;
        const float delta = fabsf(-3.0701134573253945f + (-15.350567286626973f + 3.0701134573253945f) * ((float)c / 1023.0f));
        float wv[3][4];
#pragma unroll
        for (int q = 0; q < 3; ++q) { wv[q][0] = cw[0 * 3072 + q * 1024 + c]; wv[q][1] = cw[1 * 3072 + q * 1024 + c]; wv[q][2] = cw[2 * 3072 + q * 1024 + c]; wv[q][3] = cb[q * 1024 + c]; }
        const bf16_t* rv = UT + (size_t)c * hk::TA; const bf16_t* r1 = UT + (size_t)(1024 + c) * hk::TA; const bf16_t* r2 = UT + (size_t)(2048 + c) * hk::TA;
        { int ln = lane; asm volatile("" : "+v"(ln)); Dft dft; make_dft(dft, ln);
            __syncthreads();
            const bf16_t* hc0 = HF + (size_t)(0 * 1024 + c) * L; const bf16_t* ha0 = HF + (size_t)(1 * 1024 + c) * L;
            const bf16_t* hc1 = HF + (size_t)(2 * 1024 + c) * L; const bf16_t* ha1 = HF + (size_t)(3 * 1024 + c) * L;
            const float dsc = delta / (float)(L - 1);
#pragma unroll 1
            for (int i = 0; i < 4; ++i) {
                const int n0 = 8 * (tid + 512 * i);
                const u32x4 fc0 = *(const u32x4*)(hc0 + n0), fc1 = *(const u32x4*)(hc1 + n0), fa0 = *(const u32x4*)(ha0 + (L - 8 - n0)), fa1 = *(const u32x4*)(ha1 + (L - 8 - n0));
                float f[8], g[8]; unpack8(fc0, f); unpack8(fc1, g);
#pragma unroll
                for (int e = 0; e < 8; ++e) { const int n = n0 + e; const float s = __expf(-(float)n * dsc) * (1.0f / (float)N); *(unsigned*)(W + waddr(n & 31, (n >> 5) & 31, n >> 10)) = pk2(f[e] * s, g[e] * s); }
                unpack8(fa0, f); unpack8(fa1, g);
#pragma unroll
                for (int e = 0; e < 8; ++e) { const int m = L - 8 - n0 + e, n = N - m; const float s = __expf(-(float)m * dsc) * (1.0f / (float)N);
                    if (m != 0) *(unsigned*)(W + waddr(n & 31, (n >> 5) & 31, n >> 10)) = pk2(f[e] * s, g[e] * s); }
            }
            if (tid == 0) *(unsigned*)(W + waddr(L & 31, (L >> 5) & 31, L >> 10)) = 0u;
            __syncthreads();
            fft_stage<false, false, 4, EPI_TW1>(W, dft, wave, lane, ea); __syncthreads();
            fft_stage<true, false, 4, EPI_TW0>(W, dft, wave, lane, ea); __syncthreads();
            fft_stage<true, true, 4, EPI_RAW>(W, dft, wave, lane, ea); __syncthreads();
#pragma unroll 1
            for (int it = 0; it < 16; ++it) {
                const int gi = tid + 512 * it, j = gi & 7, k1 = (gi >> 3) & 31, k2 = gi >> 8;
                if ((k1 | k2) != 0) {
                    const int k1m = (32 - k1) & 31, k2m = k1 == 0 ? 32 - k2 : 31 - k2;
                    const u32x4 z4 = *(const u32x4*)(W + waddr(k2, k1, 4 * j)), m4 = *(const u32x4*)(W + waddr(k2m, k1m, 28 - 4 * j));
                    const unsigned zw[4] = {z4.x, z4.y, z4.z, z4.w}, mw[4] = {m4.w, m4.z, m4.y, m4.x};
                    unsigned h0[4], h1[4];
#pragma unroll
                    for (int r = 0; r < 4; ++r) {
                        const float a = __uint_as_float(zw[r] << 16), b = __uint_as_float(zw[r] & 0xFFFF0000u), cc = __uint_as_float(mw[r] << 16), d = __uint_as_float(mw[r] & 0xFFFF0000u);
                        h0[r] = pk2(0.5f * (a + cc), 0.5f * (b - d)); h1[r] = pk2(0.5f * (b + d), 0.5f * (cc - a));
                    }
                    const int hi = (k2 * 32 + k1) * 32 + 4 * j;
                    *(u32x4*)(HS + hi) = (u32x4){h0[0], h0[1], h0[2], h0[3]}; *(u32x4*)(HS + 32768 + hi) = (u32x4){h1[0], h1[1], h1[2], h1[3]};
                }
            }
            if (tid < 32) {
                const unsigned z = *(const unsigned*)(W + waddr(0, 0, tid)), zm = *(const unsigned*)(W + waddr(0, 0, (32 - tid) & 31));
                const float a = __uint_as_float(z << 16), b = __uint_as_float(z & 0xFFFF0000u), cc = __uint_as_float(zm << 16), d = __uint_as_float(zm & 0xFFFF0000u);
                HS[tid] = pk2(0.5f * (a + cc), 0.5f * (b - d)); HS[32768 + tid] = pk2(0.5f * (b + d), 0.5f * (cc - a));
            }
        }
        __syncthreads();
        {
            unsigned* xs1 = (unsigned*)W; unsigned* xs2 = xs1 + L;
            const int tix = tid;
#pragma unroll 1
            for (int t0 = 8 * tid; t0 < L; t0 += 8 * 512) { sconv8_pack(r1, t0, wv[1], xs1); asm volatile("" ::: "memory"); sconv8_pack(r2, t0, wv[2], xs2); }
            __syncthreads();
#pragma unroll 1
            for (int idx = tix; idx < 4096; idx += 512) {
                const int t3 = idx & 31, cq = (idx >> 5) & 3, t2 = idx >> 7;
                u32x4 a, b;
                a.x = xs1[1024 * (4 * cq + 0) + 32 * t2 + t3]; a.y = xs1[1024 * (4 * cq + 1) + 32 * t2 + t3]; a.z = xs1[1024 * (4 * cq + 2) + 32 * t2 + t3]; a.w = xs1[1024 * (4 * cq + 3) + 32 * t2 + t3];
                b.x = xs2[1024 * (4 * cq + 0) + 32 * t2 + t3]; b.y = xs2[1024 * (4 * cq + 1) + 32 * t2 + t3]; b.z = xs2[1024 * (4 * cq + 2) + 32 * t2 + t3]; b.w = xs2[1024 * (4 * cq + 3) + 32 * t2 + t3];
                *(u32x4*)(XG1 + (t3 * 32 + t2) * 16 + 4 * cq) = a; *(u32x4*)(XG2 + (t3 * 32 + t2) * 16 + 4 * cq) = b;
            }
            __syncthreads();
#pragma unroll 1
            for (int t0 = 8 * tid; t0 < L; t0 += 8 * 512) sconv8_pack(rv, t0, wv[0], xs1);
            __syncthreads();
            u32x4 hold[8];
#pragma unroll
            for (int i = 0; i < 8; ++i) {
                const int idx = tix + 512 * i, t3 = idx & 31, cq = (idx >> 5) & 3, t2 = idx >> 7;
                hold[i].x = xs1[1024 * (4 * cq + 0) + 32 * t2 + t3]; hold[i].y = xs1[1024 * (4 * cq + 1) + 32 * t2 + t3]; hold[i].z = xs1[1024 * (4 * cq + 2) + 32 * t2 + t3]; hold[i].w = xs1[1024 * (4 * cq + 3) + 32 * t2 + t3];
            }
            __syncthreads();
#pragma unroll
            for (int i = 0; i < 8; ++i) {
                const int idx = tix + 512 * i, t3 = idx & 31, cq = (idx >> 5) & 3, t2 = idx >> 7;
                *(u32x4*)(W + waddr(t3, t2, 4 * cq)) = hold[i];
                *(u32x4*)(VG + (t3 * 32 + t2) * 16 + 4 * cq) = hold[i];
            }
            __syncthreads();
        }
        { int ln = lane; asm volatile("" : "+v"(ln)); Dft dft; make_dft(dft, ln);
        for (int o = 0; o < 2; ++o) {
            fft_stage<false, false, 2, EPI_TW1>(W, dft, wave, lane, ea); __syncthreads();
            fft_stage<true, false, 4, EPI_TW0>(W, dft, wave, lane, ea); __syncthreads();
            ea.hs = HS + o * 32768;
            fft_stage<true, true, 4, EPI_HMUL>(W, dft, wave, lane, ea); __syncthreads();
            fft_stage<true, false, 4, EPI_TW1>(W, dft, wave, lane, ea); __syncthreads();
            fft_stage<false, false, 4, EPI_TW0>(W, dft, wave, lane, ea); __syncthreads();
            ea.xg = o == 0 ? XG1 : XG2; ea.vg = VG; ea.d = lb[o * 1024 + c]; ea.store_vg = o == 0 ? 1 : 0;
            fft_stage<false, true, 4, EPI_GATE>(W, dft, wave, lane, ea); __syncthreads();
        } }
        for (int t = tid; t < L; t += 512) {
            const unsigned v = *(const unsigned*)(W + waddr(t & 31, (t >> 5) & 31, t >> 10));
            YT[(size_t)c * hk::TA + t] = (bf16_t)(v & 0xFFFFu); YT[(size_t)c * hk::TA + L + t] = (bf16_t)(v >> 16);
        }
        {
            __syncthreads();
            float* uc = (float*)W;
            float* G = uc + 512;
            const int b = tid >> 8, t = tid & 255, cbase = hk::TL + b * 256;
            uc[tid] = hy::sconv(rv + cbase, t, 256, wv[0][0], wv[0][1], wv[0][2], wv[0][3]);
#pragma unroll 1
            for (int i = tid; i < 2 * 4 * 512; i += 512) {
                const int o = i >> 11, kap = (i >> 9) & 3, j = (i & 511) + kap;
                float val = 0.f;
                if (j <= 510) { const int d = 255 - j, m = d >= 0 ? d : -d; val = bf2f(HFC[(size_t)((o * 2 + (d >= 0 ? 0 : 1)) * 1024 + c) * 256 + m]) * __expf(-((float)m / 255.0f) * delta); }
                G[i] = val;
            }
            __syncthreads();
            float y = uc[tid];
            for (int o = 0; o < 2; ++o) {
                const int off = 255 - t;
                const float* Gp = G + (o * 4 + (off & 3)) * 512 + (off & ~3); const float* up = uc + b * 256;
                float a = 0.f;
#pragma unroll 2
                for (int s4 = 0; s4 < 64; ++s4) { const f32x4 g4 = *(const f32x4*)(Gp + 4 * s4), u4 = *(const f32x4*)(up + 4 * s4); a += (g4[0] * u4[0] + g4[1] * u4[1]) + (g4[2] * u4[2] + g4[3] * u4[3]); }
                const float g = o == 0 ? hy::sconv(r1 + cbase, t, 256, wv[1][0], wv[1][1], wv[1][2], wv[1][3]) : hy::sconv(r2 + cbase, t, 256, wv[2][0], wv[2][1], wv[2][2], wv[2][3]);
                y = g * (a + lb[o * 1024 + c] * y);
                __syncthreads();
                uc[tid] = y;
                __syncthreads();
            }
            YT[(size_t)c * hk::TA + cbase + t] = f2bf(y);
        }
    }
}
__device__ __forceinline__ void ph_ssd_conv(const Params& p, unsigned char* ldsb) {
    const bf16_t* XBC = (const bf16_t*)(p.ws + hk::WS_ACT + hk::A_XBC); bf16_t* XC = (bf16_t*)(p.ws + hk::WS_ACT + hk::A_XC); float* DT = (float*)(p.ws + hk::WS_ACT + hk::A_DT);
    const float* cw = p.in[hk::I_SCW]; const float* cb = p.in[hk::I_SCB];
    bf16_t* XTG = (bf16_t*)(p.ws + hk::WS_ACT + hk::A_XTG);
    const int tid = threadIdx.x;
    {   const bf16_t* XT = (const bf16_t*)(p.ws + hk::WS_ACT + hk::A_XT);
        const int lane = tid & 63, wave = __builtin_amdgcn_readfirstlane(tid >> 6);
        constexpr int NWU = 4096 * 65; const int step = (int)gridDim.x * 8;
        int wu = blockIdx.x * 8 + wave;
        u32x4 R0 = (u32x4){0u, 0u, 0u, 0u}, R1 = R0, R2 = R0;
#define XC_LOAD3(wu_, A0, A1, A2) do { const int c_ = (wu_) / 65, s_ = (wu_) - c_ * 65, t_ = s_ * 512 + lane * 8, y_ = (t_ >> 6) & 255; \
            const bool up_ = s_ < 64 && y_ > 0, dn_ = s_ < 64 && y_ < 255; const bf16_t* row_ = XT + (size_t)c_ * hk::TA + t_; \
            A1 = *(const u32x4*)row_; A0 = *(const u32x4*)(row_ - (up_ ? 64 : 0)); A2 = *(const u32x4*)(row_ + (dn_ ? 64 : 0)); \
            if (!up_) A0 = (u32x4){0u, 0u, 0u, 0u}; if (!dn_) A2 = (u32x4){0u, 0u, 0u, 0u}; } while (0)
        if (wu < NWU) XC_LOAD3(wu, R0, R1, R2);
#pragma unroll 1
        for (; wu < NWU; wu += step) {
            u32x4 N0 = R0, N1 = R1, N2 = R2;
            { const int wn = wu + step; if (wn < NWU) XC_LOAD3(wn, N0, N1, N2); }
            const int c = wu / 65, s = wu - c * 65, t0 = s * 512 + lane * 8;
            const int x0 = s < 64 ? (t0 & 63) : (t0 & 255); const bool lf = x0 > 0, rt = x0 < (s < 64 ? 56 : 248);
            float w[9];
#pragma unroll
            for (int t = 0; t < 9; ++t) w[t] = cw[(size_t)t * 6144 + c];
            const float bias = cb[c];
            float acc[8];
#pragma unroll
            for (int i = 0; i < 8; ++i) acc[i] = bias;
#pragma unroll
            for (int dy = 0; dy < 3; ++dy) {
                const u32x4 R = dy == 0 ? R0 : dy == 1 ? R1 : R2;
                float g8[8]; unpack8(R, g8);
                const unsigned lw = (unsigned)__shfl_up((int)R.w, 1), rw = (unsigned)__shfl_down((int)R.x, 1);
                float f[10]; f[0] = lf ? __uint_as_float(lw & 0xFFFF0000u) : 0.f; f[9] = rt ? __uint_as_float(rw << 16) : 0.f;
#pragma unroll
                for (int i = 0; i < 8; ++i) f[1 + i] = g8[i];
#pragma unroll
                for (int i = 0; i < 8; ++i)
#pragma unroll
                    for (int dx = 0; dx < 3; ++dx) acc[i] += f[i + dx] * w[dy * 3 + dx];
            }
            u32x4 o; o.x = pk2(silu_f(acc[0]), silu_f(acc[1])); o.y = pk2(silu_f(acc[2]), silu_f(acc[3])); o.z = pk2(silu_f(acc[4]), silu_f(acc[5])); o.w = pk2(silu_f(acc[6]), silu_f(acc[7]));
            *(u32x4*)(XTG + (size_t)c * hk::TA + t0) = o;
            R0 = N0; R1 = N1; R2 = N2;
        }
#undef XC_LOAD3
    }
#pragma unroll 1
    for (int tb = blockIdx.x; tb < 4160; tb += gridDim.x) {
        const int c0 = 4096 + 4 * tid;
        int tok0, x0, rowlen; bool up, dn;
        if (tb < 4096) { const int b = tb >> 11, rem = tb & 2047, y = rem >> 3; x0 = 8 * (rem & 7); tok0 = b * hk::SEQ + y * 64 + x0; up = y > 0; dn = y < 255; rowlen = 64; }
        else { const int q = tb - 4096, b = q >> 5; x0 = 8 * (q & 31); tok0 = hk::TL + b * 256 + x0; up = false; dn = false; rowlen = 256; }
        float w[9][4];
#pragma unroll
        for (int t = 0; t < 9; ++t) { const f32x4 wv = *(const f32x4*)(cw + (size_t)t * 6144 + c0); w[t][0] = wv[0]; w[t][1] = wv[1]; w[t][2] = wv[2]; w[t][3] = wv[3]; }
        const f32x4 bias = *(const f32x4*)(cb + c0);
        u32x2 v[3][10];
#pragma unroll
        for (int dy = 0; dy < 3; ++dy) {
            const bool rowok = dy == 1 || (dy == 0 ? up : dn);
#pragma unroll
            for (int dx = 0; dx < 10; ++dx) {
                const int x = x0 - 1 + dx;
                v[dy][dx] = (u32x2){0u, 0u};
                if (rowok && x >= 0 && x < rowlen) v[dy][dx] = *(const u32x2*)(XBC + (size_t)(tok0 + (dy - 1) * 64 - 1 + dx) * hk::XBC_LD + (c0 - 4096));
            }
        }
#pragma unroll
        for (int i = 0; i < 8; ++i) {
            float acc[4] = {bias[0], bias[1], bias[2], bias[3]};
#pragma unroll
            for (int dy = 0; dy < 3; ++dy)
#pragma unroll
                for (int dx = 0; dx < 3; ++dx) { const u32x2 q = v[dy][i + dx]; const int t = dy * 3 + dx;
                    acc[0] += __uint_as_float(q.x << 16) * w[t][0]; acc[1] += __uint_as_float(q.x & 0xFFFF0000u) * w[t][1]; acc[2] += __uint_as_float(q.y << 16) * w[t][2]; acc[3] += __uint_as_float(q.y & 0xFFFF0000u) * w[t][3]; }
            u32x2 o; o.x = pk2(silu_f(acc[0]), silu_f(acc[1])); o.y = pk2(silu_f(acc[2]), silu_f(acc[3])); *(u32x2*)(XC + (size_t)(tok0 + i) * 2048 + (c0 - 4096)) = o;
        }
    }
    for (int idx = blockIdx.x * 512 + tid; idx < hk::TA * 16; idx += gridDim.x * 512) {
        const int r = idx >> 4, q8 = (idx & 15) * 8, dir = q8 >> 6, h0 = q8 & 63;
        float z[8]; unpack8(*(const u32x4*)(XBC + (size_t)r * hk::XBC_LD + 2048 + q8), z);
        const f32x4 b0 = *(const f32x4*)(p.in[hk::I_SDTB] + dir * 64 + h0), b1 = *(const f32x4*)(p.in[hk::I_SDTB] + dir * 64 + h0 + 4);
        f32x4 o0, o1;
#pragma unroll
        for (int j = 0; j < 4; ++j) { const float za = z[j] + b0[j], zb = z[4 + j] + b1[j]; o0[j] = za > 20.f ? za : log1pf(expf(za)); o1[j] = zb > 20.f ? zb : log1pf(expf(zb)); }
        float* d = DT + ((size_t)dir * hk::TA + r) * 64 + h0;
        *(f32x4*)d = o0; *(f32x4*)(d + 4) = o1;
    }
}
__device__ __forceinline__ void ph_ssd_scan_naive(const Params& p, unsigned char* ldsb) {
    float* Bs = (float*)ldsb;
    float* Cs = Bs + 32 * 128;
    float* xs = Cs + 32 * 128;
    float* dts = xs + 32 * 64;
    const int tid = threadIdx.x;
    const bf16_t* XC = (const bf16_t*)(p.ws + hk::WS_ACT + hk::A_XC); const float* DT = (const float*)(p.ws + hk::WS_ACT + hk::A_DT);
    for (int it = blockIdx.x; it < 256; it += gridDim.x) {
        const int b = it >> 7, dir = (it >> 6) & 1, h = it & 63, g = h >> 3;
        bf16_t* Y = (bf16_t*)(dir == 0 ? p.ws + hk::WS_ACT + hk::A_YF : p.ws + hk::WS_YB);
        const float aneg = -expf(p.in[hk::I_SALOG][dir * 64 + h]), dsk = p.in[hk::I_SD][dir * 64 + h];
        const int pp = tid >> 3, ns = tid & 7;
        float S[16];
#pragma unroll
        for (int i = 0; i < 16; ++i) S[i] = 0.f;
        for (int seg = 0; seg < 2; ++seg) {
            const int n = seg == 0 ? hk::CTXL : hk::SEQ, rowbase = seg == 0 ? hk::TL + b * hk::CTXL : b * hk::SEQ;
            for (int t0 = 0; t0 < n; t0 += 32) {
                __syncthreads();
                for (int idx = tid; idx < 32 * 128; idx += 512) {
                    const int s = idx >> 7, nn = idx & 127, tt = t0 + s, t = dir == 0 ? tt : n - 1 - tt;
                    const bf16_t* row = XC + (size_t)(rowbase + t) * 6144;
                    Bs[idx] = bf2f(row[4096 + g * 128 + nn]); Cs[idx] = bf2f(row[5120 + g * 128 + nn]);
                }
                for (int idx = tid; idx < 32 * 64; idx += 512) {
                    const int s = idx >> 6, q = idx & 63, tt = t0 + s, t = dir == 0 ? tt : n - 1 - tt;
                    xs[idx] = bf2f(XC[(size_t)(rowbase + t) * 6144 + h * 64 + q]);
                }
                if (tid < 32) { const int tt = t0 + tid, t = dir == 0 ? tt : n - 1 - tt; dts[tid] = DT[((size_t)dir * hk::TA + rowbase + t) * 64 + h]; }
                __syncthreads();
#pragma unroll 2
                for (int s = 0; s < 32; ++s) {
                    const float dt = dts[s], da = expf(dt * aneg), xv = xs[s * 64 + pp], xd = dt * xv;
                    float y = 0.f;
#pragma unroll
                    for (int q = 0; q < 4; ++q) {
                        const f32x4 b4 = *(const f32x4*)(Bs + s * 128 + ns * 16 + q * 4), c4 = *(const f32x4*)(Cs + s * 128 + ns * 16 + q * 4);
#pragma unroll
                        for (int j = 0; j < 4; ++j) { S[q * 4 + j] = da * S[q * 4 + j] + xd * b4[j]; y += S[q * 4 + j] * c4[j]; }
                    }
                    y += __shfl_xor(y, 1); y += __shfl_xor(y, 2); y += __shfl_xor(y, 4);
                    if (seg == 1 && ns == 0) { const int tt = t0 + s, t = dir == 0 ? tt : n - 1 - tt; Y[(size_t)(rowbase + t) * 4096 + h * 64 + pp] = f2bf(y + dsk * xv); }
                }
            }
        }
    }
}
__device__ __forceinline__ void ph_ssd_finish(const Params& p) {
    const int lane = threadIdx.x & 63, wave = threadIdx.x >> 6;
    bf16_t* Z = (bf16_t*)(p.ws + hk::WS_ACT + hk::A_Z);
    const bf16_t* YF = (const bf16_t*)(p.ws + hk::WS_ACT + hk::A_YF); const bf16_t* YB = (const bf16_t*)(p.ws + hk::WS_YB);
    const float* ng = p.in[hk::I_SNG];
    for (int r = blockIdx.x * 8 + wave; r < hk::TL; r += gridDim.x * 8) {
#pragma unroll 2
        for (int g = 0; g < 8; ++g) {
            const int col = g * 512 + lane * 8;
            float a[8], bq[8], z[8], uu[8];
            unpack8(*(const u32x4*)(YF + (size_t)r * 4096 + col), a); unpack8(*(const u32x4*)(YB + (size_t)r * 4096 + col), bq); unpack8(*(const u32x4*)(Z + (size_t)r * 4096 + col), z);
            float ss = 0.f;
#pragma unroll
            for (int j = 0; j < 8; ++j) { uu[j] = (a[j] + bq[j]) * silu_f(z[j]); ss += uu[j] * uu[j]; }
            const float rs = rsqrtf(wave_sum(ss) * (1.0f / 512.0f) + hk::LN_EPS);
            const f32x4 g0 = *(const f32x4*)(ng + col), g1 = *(const f32x4*)(ng + col + 4);
            u32x4 w; w.x = pk2(uu[0] * rs * g0[0], uu[1] * rs * g0[1]); w.y = pk2(uu[2] * rs * g0[2], uu[3] * rs * g0[3]); w.z = pk2(uu[4] * rs * g1[0], uu[5] * rs * g1[1]); w.w = pk2(uu[6] * rs * g1[2], uu[7] * rs * g1[3]);
            *(u32x4*)(Z + (size_t)r * 4096 + col) = w;
        }
    }
}
namespace sc {
typedef short bf16x8 __attribute__((ext_vector_type(8)));
typedef float f32x16 __attribute__((ext_vector_type(16)));
constexpr int RS = 272, SCN = 1024;
constexpr float LOG2E = 1.4426950408889634f;
constexpr int O_BM = 0, O_CM = 128 * 256, O_XT = O_CM + 128 * RS, O_XW = O_XT + 64 * RS, O_SB = O_XW + 64 * RS, O_SC = O_SB + 64 * RS, O_GI = O_SC + 2 * SCN * 4;
__device__ __forceinline__ unsigned off_b(unsigned row, unsigned ch) { return 256u * row + 16u * (ch ^ (((row & 3u) << 2) | ((row >> 2) & 3u))); }
__device__ __forceinline__ f32x16 zero16() { f32x16 z;
#pragma unroll
    for (int i = 0; i < 16; ++i) z[i] = 0.f; return z; }
__device__ __forceinline__ bf16x8 ldf(const unsigned char* base, int row, int colb) { return *(const bf16x8*)(base + row * RS + colb); }
__device__ __forceinline__ f32x16 chain8_xa(f32x16 acc, const unsigned char* A, int arow, const unsigned char* B, int brow, int g2) {
    const unsigned xr = (((unsigned)arow & 3u) << 2) | (((unsigned)arow >> 2) & 3u);
#pragma unroll
    for (int hh = 0; hh < 2; ++hh) {
        bf16x8 fa[4], fb[4];
#pragma unroll
        for (int k = 0; k < 4; ++k) { fa[k] = *(const bf16x8*)(A + 256 * arow + 16 * ((unsigned)(2 * (4 * hh + k) + g2) ^ xr)); fb[k] = ldf(B, brow, 32 * (4 * hh + k) + 16 * g2); }
        __builtin_amdgcn_sched_barrier(0);
#pragma unroll
        for (int k = 0; k < 4; ++k) acc = __builtin_amdgcn_mfma_f32_32x32x16_bf16(fa[k], fb[k], acc, 0, 0, 0);
        __builtin_amdgcn_sched_barrier(0);
    }
    return acc;
}
__device__ __forceinline__ f32x16 chain8_tr(f32x16 acc, unsigned ta0, unsigned ta1, const unsigned char* B, int brow, int g2) {
    u32x2 l0, l1, l2, l3, h0, h1, h2, h3;
    {
        bf16x8 fb[4];
#pragma unroll
        for (int k = 0; k < 4; ++k) fb[k] = ldf(B, brow, 32 * k + 16 * g2);
        asm volatile("ds_read_b64_tr_b16 %0, %8\n\tds_read_b64_tr_b16 %1, %9\n\tds_read_b64_tr_b16 %2, %8 offset:4096\n\tds_read_b64_tr_b16 %3, %9 offset:4096\n\t"
                     "ds_read_b64_tr_b16 %4, %8 offset:8192\n\tds_read_b64_tr_b16 %5, %9 offset:8192\n\tds_read_b64_tr_b16 %6, %8 offset:12288\n\tds_read_b64_tr_b16 %7, %9 offset:12288\n\ts_waitcnt lgkmcnt(0)"
                     : "=&v"(l0), "=&v"(h0), "=&v"(l1), "=&v"(h1), "=&v"(l2), "=&v"(h2), "=&v"(l3), "=&v"(h3) : "v"(ta0), "v"(ta1) : "memory");
        __builtin_amdgcn_sched_barrier(0);
        acc = __builtin_amdgcn_mfma_f32_32x32x16_bf16(__builtin_bit_cast(bf16x8, (u32x4){l0.x, l0.y, h0.x, h0.y}), fb[0], acc, 0, 0, 0);
        acc = __builtin_amdgcn_mfma_f32_32x32x16_bf16(__builtin_bit_cast(bf16x8, (u32x4){l1.x, l1.y, h1.x, h1.y}), fb[1], acc, 0, 0, 0);
        acc = __builtin_amdgcn_mfma_f32_32x32x16_bf16(__builtin_bit_cast(bf16x8, (u32x4){l2.x, l2.y, h2.x, h2.y}), fb[2], acc, 0, 0, 0);
        acc = __builtin_amdgcn_mfma_f32_32x32x16_bf16(__builtin_bit_cast(bf16x8, (u32x4){l3.x, l3.y, h3.x, h3.y}), fb[3], acc, 0, 0, 0);
        __builtin_amdgcn_sched_barrier(0);
    }
    {
        bf16x8 fb[4];
#pragma unroll
        for (int k = 0; k < 4; ++k) fb[k] = ldf(B, brow, 32 * (4 + k) + 16 * g2);
        asm volatile("ds_read_b64_tr_b16 %0, %8 offset:16384\n\tds_read_b64_tr_b16 %1, %9 offset:16384\n\tds_read_b64_tr_b16 %2, %8 offset:20480\n\tds_read_b64_tr_b16 %3, %9 offset:20480\n\t"
                     "ds_read_b64_tr_b16 %4, %8 offset:24576\n\tds_read_b64_tr_b16 %5, %9 offset:24576\n\tds_read_b64_tr_b16 %6, %8 offset:28672\n\tds_read_b64_tr_b16 %7, %9 offset:28672\n\ts_waitcnt lgkmcnt(0)"
                     : "=&v"(l0), "=&v"(h0), "=&v"(l1), "=&v"(h1), "=&v"(l2), "=&v"(h2), "=&v"(l3), "=&v"(h3) : "v"(ta0), "v"(ta1) : "memory");
        __builtin_amdgcn_sched_barrier(0);
        acc = __builtin_amdgcn_mfma_f32_32x32x16_bf16(__builtin_bit_cast(bf16x8, (u32x4){l0.x, l0.y, h0.x, h0.y}), fb[0], acc, 0, 0, 0);
        acc = __builtin_amdgcn_mfma_f32_32x32x16_bf16(__builtin_bit_cast(bf16x8, (u32x4){l1.x, l1.y, h1.x, h1.y}), fb[1], acc, 0, 0, 0);
        acc = __builtin_amdgcn_mfma_f32_32x32x16_bf16(__builtin_bit_cast(bf16x8, (u32x4){l2.x, l2.y, h2.x, h2.y}), fb[2], acc, 0, 0, 0);
        acc = __builtin_amdgcn_mfma_f32_32x32x16_bf16(__builtin_bit_cast(bf16x8, (u32x4){l3.x, l3.y, h3.x, h3.y}), fb[3], acc, 0, 0, 0);
        __builtin_amdgcn_sched_barrier(0);
    }
    return acc;
}
__device__ __forceinline__ unsigned tr_addr(unsigned img, int lane, int c, int t) {
    const unsigned hh = (unsigned)lane >> 5, blk = ((unsigned)lane >> 4) & 1u, q = ((unsigned)lane & 15u) >> 2, pp = (unsigned)lane & 3u;
    return img + off_b(8u * hh + 4u * (unsigned)t + q, 4u * (unsigned)c + 2u * blk + (pp >> 1)) + 8u * (pp & 1u);
}
template <int N> __device__ __forceinline__ float dpp_shr(float v) { return __int_as_float(__builtin_amdgcn_update_dpp(0, __float_as_int(v), 0x110 + N, 0xF, 0xF, true)); }
__device__ __forceinline__ float rdl(float v, int l) { return __int_as_float(__builtin_amdgcn_readlane(__float_as_int(v), l)); }
__device__ __forceinline__ int row0_of(int ci, int b, int dir) { const int seg = ci < 2 ? 0 : 1, c2 = seg == 0 ? ci : ci - 2, nc = seg == 0 ? 2 : 128, cs = dir == 0 ? c2 : nc - 1 - c2;
    return (seg == 0 ? hk::TL + b * hk::CTXL : b * hk::SEQ) + 128 * cs; }
__device__ __forceinline__ f32x16 chain8(f32x16 acc, const unsigned char* A, int arow, const unsigned char* B, int brow, int g2) {
#pragma unroll
    for (int hh = 0; hh < 2; ++hh) {
        bf16x8 fa[4], fb[4];
#pragma unroll
        for (int k = 0; k < 4; ++k) { fa[k] = ldf(A, arow, 32 * (4 * hh + k) + 16 * g2); fb[k] = ldf(B, brow, 32 * (4 * hh + k) + 16 * g2); }
        __builtin_amdgcn_sched_barrier(0);
#pragma unroll
        for (int k = 0; k < 4; ++k) acc = __builtin_amdgcn_mfma_f32_32x32x16_bf16(fa[k], fb[k], acc, 0, 0, 0);
        __builtin_amdgcn_sched_barrier(0);
    }
    return acc;
}
__device__ __forceinline__ void load8(bf16x8 (&f)[8], const unsigned char* B, int brow, int g2) {
#pragma unroll
    for (int k = 0; k < 8; ++k) f[k] = ldf(B, brow, 32 * k + 16 * g2);
}
__device__ __forceinline__ f32x16 chain8_xa_b(f32x16 acc, const unsigned char* A, int arow, const bf16x8 (&fb)[8], int g2) {
    const unsigned xr = (((unsigned)arow & 3u) << 2) | (((unsigned)arow >> 2) & 3u);
#pragma unroll
    for (int hh = 0; hh < 2; ++hh) {
        bf16x8 fa[4];
#pragma unroll
        for (int k = 0; k < 4; ++k) fa[k] = *(const bf16x8*)(A + 256 * arow + 16 * ((unsigned)(2 * (4 * hh + k) + g2) ^ xr));
        __builtin_amdgcn_sched_barrier(0);
#pragma unroll
        for (int k = 0; k < 4; ++k) acc = __builtin_amdgcn_mfma_f32_32x32x16_bf16(fa[k], fb[4 * hh + k], acc, 0, 0, 0);
        __builtin_amdgcn_sched_barrier(0);
    }
    return acc;
}
__device__ __forceinline__ f32x16 chain8_b(f32x16 acc, const unsigned char* A, int arow, const bf16x8 (&fb)[8], int g2) {
#pragma unroll
    for (int hh = 0; hh < 2; ++hh) {
        bf16x8 fa[4];
#pragma unroll
        for (int k = 0; k < 4; ++k) fa[k] = ldf(A, arow, 32 * (4 * hh + k) + 16 * g2);
        __builtin_amdgcn_sched_barrier(0);
#pragma unroll
        for (int k = 0; k < 4; ++k) acc = __builtin_amdgcn_mfma_f32_32x32x16_bf16(fa[k], fb[4 * hh + k], acc, 0, 0, 0);
        __builtin_amdgcn_sched_barrier(0);
    }
    return acc;
}
__device__ __forceinline__ f32x16 chain2(f32x16 acc, const unsigned char* A, int arow, const unsigned char* B, int brow, int colb) {
    const bf16x8 a0 = ldf(A, arow, colb), b0 = ldf(B, brow, colb), a1 = ldf(A, arow, colb + 32), b1 = ldf(B, brow, colb + 32);
    __builtin_amdgcn_sched_barrier(0);
    acc = __builtin_amdgcn_mfma_f32_32x32x16_bf16(a0, b0, acc, 0, 0, 0); acc = __builtin_amdgcn_mfma_f32_32x32x16_bf16(a1, b1, acc, 0, 0, 0);
    __builtin_amdgcn_sched_barrier(0);
    return acc;
}
}
__device__ __forceinline__ void ph_ssd_scan_chunk(const Params& p, unsigned char* lds) {
    using namespace sc;
    const int tid = threadIdx.x, lane = tid & 63, wave = __builtin_amdgcn_readfirstlane(tid >> 6), l32 = lane & 31, g2 = lane >> 5;
    const bf16_t* XC = (const bf16_t*)(p.ws + hk::WS_ACT + hk::A_XC); const float* DT = (const float*)(p.ws + hk::WS_ACT + hk::A_DT);
    unsigned char* Bm = lds + O_BM; unsigned char* XW = lds + O_XW; unsigned char* Cm = lds + O_CM; unsigned char* XT = lds + O_XT; unsigned char* Sb = lds + O_SB; unsigned char* Gi = lds + O_GI;
    const bf16_t* XTG = (const bf16_t*)(p.ws + hk::WS_ACT + hk::A_XTG);
    float* SC = (float*)(lds + O_SC);
    const unsigned bm_lds = (unsigned)(size_t)(Bm);
    for (int itx = blockIdx.x; itx < 256; itx += gridDim.x) {
        const int it0 = gridDim.x == 256 ? (((itx >> 3) >> 3) << 6) | (8 * (itx & 7) + ((itx >> 3) & 7)) : itx;
        const int b = it0 >> 7, dir = (it0 >> 6) & 1, h = it0 & 63, grp = h >> 3;
        bf16_t* Y = (bf16_t*)(dir == 0 ? p.ws + hk::WS_ACT + hk::A_YF : p.ws + hk::WS_YB);
        const float aneg = -expf(p.in[hk::I_SALOG][dir * 64 + h]) * LOG2E, dsk = p.in[hk::I_SD][dir * 64 + h];
        f32x16 accST = zero16();
        __syncthreads();
        for (int i = tid; i < 64 * RS / 4; i += 512) ((unsigned*)Sb)[i] = 0u;
        u32x4 xq[2], bq[4], cc[4]; float dt0 = 0.f, dt1 = 0.f;
#define SSD_PREFETCH(ci_) do { const int r0_ = sc::row0_of(ci_, b, dir); \
        _Pragma("unroll") for (int k_ = 0; k_ < 2; ++k_) { const int pc = tid + 512 * k_, pr = pc >> 4, ch = pc & 15; xq[k_] = *(const u32x4*)(XTG + (size_t)(h * 64 + pr) * hk::TA + r0_ + 8 * ch); } \
        _Pragma("unroll") for (int k_ = 0; k_ < 4; ++k_) { const int pc = tid + 512 * k_, row = pc >> 4, ch = pc & 15; const bf16_t* s_ = XC + (size_t)(r0_ + row) * 2048 + grp * 128 + 8 * ch; bq[k_] = *(const u32x4*)s_; cc[k_] = *(const u32x4*)(s_ + 1024); } } while (0)
#define SSD_DTLOAD(ci_) do { const int r0_ = sc::row0_of(ci_, b, dir); dt0 = DT[((size_t)dir * hk::TA + r0_ + 2 * lane) * 64 + h]; dt1 = DT[((size_t)dir * hk::TA + r0_ + 2 * lane + 1) * 64 + h]; } while (0)
#define SSD_SCALARS(ci_) do { \
        const float a0 = dt0 * aneg, a1 = dt1 * aneg, s2 = a0 + a1; float P = s2; \
          \
        P += sc::dpp_shr<1>(P); P += sc::dpp_shr<2>(P); P += sc::dpp_shr<4>(P); P += sc::dpp_shr<8>(P); \
        { const float t0_ = sc::rdl(P, 15), t1_ = sc::rdl(P, 31), t2_ = sc::rdl(P, 47); P += lane >= 48 ? t0_ + t1_ + t2_ : lane >= 32 ? t0_ + t1_ : lane >= 16 ? t0_ : 0.f; } \
        const float T_ = sc::rdl(P, 63); \
        float ac0, ac1; if (dir == 0) { ac0 = P - a1; ac1 = P; } else { const float sf = T_ - P + s2; ac0 = sf; ac1 = sf - a0; } \
        float* sc_ = SC + ((ci_) & 1) * SCN; \
          \
        const float R1 = dir == 0 ? sc::rdl(ac1, 15) : sc::rdl(ac0, 16), R2 = dir == 0 ? sc::rdl(ac1, 31) : sc::rdl(ac0, 32), R3 = dir == 0 ? sc::rdl(ac1, 47) : sc::rdl(ac0, 48); \
        const int blk = lane >> 4; const float Rb = dir == 0 ? (blk == 1 ? R1 : blk == 2 ? R2 : R3) : (blk == 0 ? R1 : blk == 1 ? R2 : R3); \
        *(hw_f32x2*)(sc_ + 2 * lane) = (hw_f32x2){ac0, ac1}; *(hw_f32x2*)(sc_ + 128 + 2 * lane) = (hw_f32x2){dt0, dt1}; \
        *(hw_f32x2*)(sc_ + 256 + 2 * lane) = (hw_f32x2){__builtin_amdgcn_exp2f(fminf(ac0 - Rb, 0.f)), __builtin_amdgcn_exp2f(fminf(ac1 - Rb, 0.f))};                                    \
        *(hw_f32x2*)(sc_ + 384 + 2 * lane) = (hw_f32x2){__builtin_amdgcn_exp2f(fminf(R1 - ac0, 0.f)) * dt0, __builtin_amdgcn_exp2f(fminf(R1 - ac1, 0.f)) * dt1};                        \
        *(hw_f32x2*)(sc_ + 512 + 2 * lane) = (hw_f32x2){__builtin_amdgcn_exp2f(fminf(R2 - ac0, 0.f)) * dt0, __builtin_amdgcn_exp2f(fminf(R2 - ac1, 0.f)) * dt1};                        \
        *(hw_f32x2*)(sc_ + 640 + 2 * lane) = (hw_f32x2){__builtin_amdgcn_exp2f(fminf(R3 - ac0, 0.f)) * dt0, __builtin_amdgcn_exp2f(fminf(R3 - ac1, 0.f)) * dt1};                        \
        *(hw_f32x2*)(sc_ + 768 + 2 * lane) = (hw_f32x2){dt0 * __builtin_amdgcn_exp2f(T_ - ac0), dt1 * __builtin_amdgcn_exp2f(T_ - ac1)};                                                \
        if (lane == 0) sc_[896] = __builtin_amdgcn_exp2f(T_); } while (0)
#define SSD_FILL(ci_) do { const float* scn_ = SC + ((ci_) & 1) * SCN; \
        _Pragma("unroll") for (int k_ = 0; k_ < 2; ++k_) { const int pc = tid + 512 * k_, pr = pc >> 4, ch = pc & 15; *(u32x4*)(XT + pr * RS + 16 * ch) = xq[k_]; \
          const f32x4 wa_ = *(const f32x4*)(scn_ + 768 + 8 * ch), wb_ = *(const f32x4*)(scn_ + 768 + 8 * ch + 4); \
          float f_[8]; unpack8(xq[k_], f_); u32x4 o_; o_.x = pk2(wa_[0] * f_[0], wa_[1] * f_[1]); o_.y = pk2(wa_[2] * f_[2], wa_[3] * f_[3]); o_.z = pk2(wb_[0] * f_[4], wb_[1] * f_[5]); o_.w = pk2(wb_[2] * f_[6], wb_[3] * f_[7]); \
          *(u32x4*)(XW + pr * RS + 16 * ch) = o_; } \
        _Pragma("unroll") for (int k_ = 0; k_ < 4; ++k_) { const int pc = tid + 512 * k_, row = pc >> 4, ch = pc & 15; \
          *(u32x4*)(Cm + row * RS + 16 * ch) = cc[k_]; *(u32x4*)(Bm + off_b(row, ch)) = bq[k_]; } } while (0)
        SSD_PREFETCH(0);
        if (wave == 7) { SSD_DTLOAD(0); SSD_SCALARS(0); SSD_DTLOAD(1); }
        __syncthreads();
        SSD_FILL(0);

#if PROBE_STAMP
        long long pst_prev = clock64(), ps_ab = 0, ps_bc = 0, ps_cd = 0, ps_da = 0;
#define PSTAMP(acc_) do { const long long now_ = clock64(); acc_ += now_ - pst_prev; pst_prev = now_; } while (0)
#else
#define PSTAMP(acc_) do { } while (0)
#endif
        for (int ci = 0; ci < 130; ++ci) {
            __syncthreads();
            PSTAMP(ps_da);
            const float* sc = SC + (ci & 1) * SCN; const float dtot = sc[896];
            if (ci + 1 < 130) { SSD_PREFETCH(ci + 1); if (wave == 7) { SSD_SCALARS(ci + 1); if (ci + 2 < 130) SSD_DTLOAD(ci + 2); } }
            const int pt2 = wave >> 2, it2 = wave < 4 ? wave : (dir == 0 ? (wave == 4 ? 0 : 8 - wave) : 3 - (wave == 4 ? 0 : 8 - wave));
            bf16x8 cf[8]; load8(cf, Cm, 32 * it2 + l32, g2);
            int tj[2], ti[2]; const int ntile = (wave == 5 || wave == 6) ? 2 : 1;
            u32x2 gp[2][4];
#define GI_NTL(it_) (dir == 0 ? (it_) + 1 : 4 - (it_))
#define GI_BASE(it_) (dir == 0 ? 32 * (32 * (it_) * ((it_) + 1) + 16 * (it_)) : 32 * (256 * (it_) - 32 * (it_) * ((it_) - 1) + 16 * (it_)))
#define GI_ROW(it_, l_) (Gi + GI_BASE(it_) + (l_) * (64 * GI_NTL(it_) + 16))
#define GI_COL(it_, jt_) (64 * ((jt_) - (dir == 0 ? 0 : (it_))))
#pragma unroll
            for (int s = 0; s < 2; ++s) {
                int a, bq;
                if (wave < 4) { a = wave; bq = wave; }
                else if (wave == 4) { a = 2; bq = 3; }
                else if (wave == 5) { a = s; bq = 3; }
                else if (wave == 6) { a = s; bq = 2; }
                else { a = 0; bq = 1; }
                if (wave < 4) { tj[s] = a; ti[s] = bq; } else { tj[s] = dir == 0 ? a : 3 - a; ti[s] = dir == 0 ? bq : 3 - bq; }
                if (s < ntile) {
                    f32x16 gt = wave == 4 ? chain8_xa(zero16(), Bm, 32 * tj[s] + l32, Cm, 32 * ti[s] + l32, g2) : chain8_xa_b(zero16(), Bm, 32 * tj[s] + l32, cf, g2);
                    const int i = 32 * ti[s] + l32;
                    if (wave < 4) {
                        const float aci = sc[i];
#pragma unroll
                        for (int q = 0; q < 4; ++q) {
                            const int j0 = 32 * tj[s] + 8 * q + 4 * g2;
                            const f32x4 acj = *(const f32x4*)(sc + j0), dtj = *(const f32x4*)(sc + 128 + j0);
                            float v[4];
#pragma unroll
                            for (int r = 0; r < 4; ++r) {
                                const int j = j0 + r; const bool ok = dir == 0 ? (j <= i) : (j >= i);
                                const float e = __builtin_amdgcn_exp2f(fminf(aci - acj[r], 0.f));
                                v[r] = ok ? gt[4 * q + r] * e * dtj[r] + (j == i ? dsk : 0.f) : 0.f;
                            }
                            gp[s][q].x = pk2(v[0], v[1]); gp[s][q].y = pk2(v[2], v[3]);
                        }
                    } else {
                        const float ea = sc[256 + i];
                        const float* eb = sc + 384 + 128 * (dir == 0 ? ti[s] - 1 : ti[s]) + 32 * tj[s] + 4 * g2;
#pragma unroll
                        for (int q = 0; q < 4; ++q) {
                            const f32x4 e4 = *(const f32x4*)(eb + 8 * q);
                            gp[s][q].x = pk2(gt[4 * q] * ea * e4[0], gt[4 * q + 1] * ea * e4[1]); gp[s][q].y = pk2(gt[4 * q + 2] * ea * e4[2], gt[4 * q + 3] * ea * e4[3]);
                        }
                    }
                    { unsigned char* gr_ = GI_ROW(ti[s], l32) + GI_COL(ti[s], tj[s]) + 8 * g2;
#pragma unroll
                      for (int q = 0; q < 4; ++q) *(u32x2*)(gr_ + 16 * q) = gp[s][q]; }
                }
            }
            f32x16 yint = zero16();
            yint = chain8_b(yint, Sb, 32 * pt2 + l32, cf, g2);
            { const float ei = __builtin_amdgcn_exp2f(sc[32 * it2 + l32]);
#pragma unroll
              for (int k = 0; k < 16; ++k) yint[k] *= ei; }
            {
                const int nt = wave & 3, pt = wave >> 2;
#pragma unroll
                for (int i = 0; i < 16; ++i) accST[i] *= dtot;
                accST = chain8_tr(accST, tr_addr(bm_lds, lane, nt, 0), tr_addr(bm_lds, lane, nt, 1), XW, 32 * pt + l32, g2);
            }
            const int jlo = dir == 0 ? 0 : it2, jhi = dir == 0 ? it2 : 3;
            bf16x8 xa[4][2];
#pragma unroll
            for (int jt = 0; jt < 4; ++jt) if (jt >= jlo && jt <= jhi) { xa[jt][0] = ldf(XT, 32 * pt2 + l32, 64 * jt + 16 * g2); xa[jt][1] = ldf(XT, 32 * pt2 + l32, 64 * jt + 16 * g2 + 32); }
            __syncthreads();
            PSTAMP(ps_bc);
            f32x16 yacc = yint;
            {
                const unsigned char* grow = GI_ROW(it2, l32) + 16 * g2;
#pragma unroll
                for (int jt = 0; jt < 4; ++jt) if (jt >= jlo && jt <= jhi) {
                    const bf16x8 b0 = *(const bf16x8*)(grow + GI_COL(it2, jt)), b1 = *(const bf16x8*)(grow + GI_COL(it2, jt) + 32);
                    __builtin_amdgcn_sched_barrier(0);
                    yacc = __builtin_amdgcn_mfma_f32_32x32x16_bf16(xa[jt][0], b0, yacc, 0, 0, 0); yacc = __builtin_amdgcn_mfma_f32_32x32x16_bf16(xa[jt][1], b1, yacc, 0, 0, 0);
                    __builtin_amdgcn_sched_barrier(0);
                }
            }
            if (ci >= 2) {
                const int r0 = sc::row0_of(ci, b, dir), i = 32 * it2 + l32;
                bf16_t* yrow = Y + (size_t)(r0 + i) * 4096 + h * 64 + 32 * pt2 + 4 * g2;
#pragma unroll
                for (int q = 0; q < 4; ++q) { u32x2 w; w.x = pk2(yacc[4 * q], yacc[4 * q + 1]); w.y = pk2(yacc[4 * q + 2], yacc[4 * q + 3]);
                    *(u32x2*)(yrow + 8 * q) = w; }
            }
            {
                const int nt = wave & 3, pt = wave >> 2;
#pragma unroll
                for (int q = 0; q < 4; ++q) { u32x2 w; w.x = pk2(accST[4 * q], accST[4 * q + 1]); w.y = pk2(accST[4 * q + 2], accST[4 * q + 3]);
                    *(u32x2*)(Sb + (32 * pt + l32) * RS + 2 * (32 * nt + 8 * q + 4 * g2)) = w; }
            }
            PSTAMP(ps_cd);
            if (ci + 1 < 130) SSD_FILL(ci + 1);
        }
#if PROBE_STAMP
        if (blockIdx.x == 0 && tid == 0) { const float tot = (float)(ps_ab + ps_bc + ps_cd + ps_da);
            const float sel = PROBE_STAMP == 1 ? (float)ps_ab : PROBE_STAMP == 2 ? (float)ps_bc : PROBE_STAMP == 3 ? (float)ps_cd : (float)ps_da;
            ((float*)(p.ws + hk::WS_CTL))[hk::CW_PROBE] = sel / tot; }
#endif
#undef PSTAMP
#undef GI_NTL
#undef GI_BASE
#undef GI_ROW
#undef GI_COL
#undef SSD_PREFETCH
#undef SSD_FILL
#undef SSD_DTLOAD
#undef SSD_SCALARS
    }
}
namespace gc {
constexpr int NCH = 260;
}
__device__ __forceinline__ void ph_gla_pre(const Params& p, unsigned char* lds) {
    bf16_t* qs = (bf16_t*)lds;
    bf16_t* ks = qs + 128 * 128;
    float* g1s = (float*)(ks + 128 * 128);
    float* w2s = g1s + 128 * 16;
    float* bs = w2s + 16 * 128;
    float* tot = bs + 128;
    const int tid = threadIdx.x;
    const bf16_t* GL = (const bf16_t*)(p.ws + hk::WS_ACT + hk::A_GL);
    for (int itx = blockIdx.x; itx < gc::NCH * 8; itx += gridDim.x) {
        const int item = gridDim.x == 256 ? ((itx >> 4) << 4) | ((itx & 7) << 1) | ((itx >> 3) & 1) : itx;
        const int chunk = item >> 3, h = (item >> 1) & 3, dir = item & 1, r0 = chunk * 128;
        bf16_t* QD = (bf16_t*)(p.ws + hk::WS_ACT + hk::A_QK) + (size_t)(dir * 2 + 0) * hk::TA * 512;
        bf16_t* KD = (bf16_t*)(p.ws + hk::WS_ACT + hk::A_QK) + (size_t)(dir * 2 + 1) * hk::TA * 512;
        float* E = (float*)(p.ws + hk::WS_ACT + hk::A_EB) + ((size_t)(dir * gc::NCH + chunk) * 3) * 512 + h * 128;
        __syncthreads();
        for (int pc = tid; pc < 128 * 16; pc += 512) {
            const int row = pc >> 4, ch = pc & 15;
            *(u32x4*)(qs + row * 128 + 8 * ch) = *(const u32x4*)(GL + (size_t)(r0 + row) * hk::GL_LD + h * 128 + 8 * ch);
            *(u32x4*)(ks + row * 128 + 8 * ch) = *(const u32x4*)(GL + (size_t)(r0 + row) * hk::GL_LD + 512 + h * 128 + 8 * ch);
        }
        for (int i = tid; i < 128 * 16; i += 512) { const int row = i >> 4, r = i & 15; g1s[i] = bf2f(GL[(size_t)(r0 + row) * hk::GL_LD + hk::GL_GK + dir * 16 + r]); }
        for (int i = tid; i < 16 * 128; i += 512) { const int r = i >> 7, kk = i & 127; w2s[i] = p.in[hk::I_GW2][(size_t)(dir * 16 + r) * 512 + h * 128 + kk]; }
        if (tid < 128) bs[tid] = p.in[hk::I_GB][dir * 512 + h * 128 + tid];
        __syncthreads();
        const int kk = tid & 127, tq = tid >> 7;
        float w2r[16];
#pragma unroll
        for (int r = 0; r < 16; ++r) w2r[r] = w2s[r * 128 + kk];
        const float bias = bs[kk];
        float gl[32]; float run = 0.f;
#pragma unroll
        for (int s = 0; s < 32; ++s) {
            const int t = tq * 32 + s;
            float z = bias;
#pragma unroll
            for (int r = 0; r < 16; ++r) z += g1s[t * 16 + r] * w2r[r];
            const float ls = fminf(z, 0.f) - __logf(1.0f + __expf(-fabsf(z)));
            run += ls * (1.0f / 16.0f); gl[s] = run;
        }
        tot[tq * 128 + kk] = run;
        __syncthreads();
        const float t0 = tot[kk], t1 = tot[128 + kk], t2 = tot[256 + kk], t3 = tot[384 + kk];
        const float before = tq == 0 ? 0.f : tq == 1 ? t0 : tq == 2 ? t0 + t1 : t0 + t1 + t2, total = (t0 + t1) + (t2 + t3);
        const float ref = dir == 0 ? t0 + t1 : t2 + t3;
        if (tq == 0) { E[kk] = __expf(total); E[512 + kk] = __expf(total - ref); E[1024 + kk] = __expf(ref); }
        float prev = 0.f;
#pragma unroll
        for (int s = 0; s < 32; ++s) {
            const int t = tq * 32 + s;
            const float pin = before + gl[s];
            const float bt = dir == 0 ? pin : total - (before + prev);
            prev = gl[s];
            const float eq = __expf(bt - ref), ek = __expf(ref - bt);
            qs[t * 128 + kk] = f2bf(bf2f(qs[t * 128 + kk]) * 0.08838834764831845f * eq);
            ks[t * 128 + kk] = f2bf(bf2f(ks[t * 128 + kk]) * ek);
        }
        __syncthreads();
        for (int pc = tid; pc < 128 * 16; pc += 512) {
            const int row = pc >> 4, ch = pc & 15;
            *(u32x4*)(QD + (size_t)(r0 + row) * 512 + h * 128 + 8 * ch) = *(const u32x4*)(qs + row * 128 + 8 * ch);
            *(u32x4*)(KD + (size_t)(r0 + row) * 512 + h * 128 + 8 * ch) = *(const u32x4*)(ks + row * 128 + 8 * ch);
        }
    }
}

__device__ __forceinline__ void ph_gla_scan_chunk(const Params& p, unsigned char* lds) {
    using namespace sc;
    const int tid = threadIdx.x, lane = tid & 63, wave = __builtin_amdgcn_readfirstlane(tid >> 6), l32 = lane & 31, g2 = lane >> 5;
    constexpr int O_KM = 0, O_QM = 128 * RS, O_VT = 2 * 128 * RS, O_SB2 = O_VT + 64 * RS, O_GI = O_SB2 + 32 * RS + 3072;
    unsigned char* Km = lds + O_KM; unsigned char* Qm = lds + O_QM; unsigned char* VT0 = lds + O_VT; unsigned char* Sb = lds + O_SB2; unsigned char* Gi = lds + O_GI;
    const unsigned km_lds = (unsigned)(size_t)Km;
    const bf16_t* VTG = (const bf16_t*)(p.ws + hk::WS_ACT + hk::A_VTG);
    float* Es = (float*)(lds + O_SB2 + 32 * RS);
    const bf16_t* GL = (const bf16_t*)(p.ws + hk::WS_ACT + hk::A_GL);
    if (blockIdx.x < 128) { const int itx = blockIdx.x, it0 = gridDim.x == 256 ? ((2 * (itx & 7) + ((itx >> 3) & 1)) << 3) | (itx >> 4) : itx;
        const int b = it0 >> 6, dir = (it0 >> 5) & 1, h = (it0 >> 3) & 3, vs = it0 & 7;
        const bf16_t* QD = (const bf16_t*)(p.ws + hk::WS_ACT + hk::A_QK) + (size_t)(dir * 2 + 0) * hk::TA * 512;
        const bf16_t* KD = (const bf16_t*)(p.ws + hk::WS_ACT + hk::A_QK) + (size_t)(dir * 2 + 1) * hk::TA * 512;
        const float* EB = (const float*)(p.ws + hk::WS_ACT + hk::A_EB) + (size_t)dir * gc::NCH * 3 * 512 + h * 128;
        bf16_t* OUT = (bf16_t*)(p.ws + hk::WS_ACT + (dir == 0 ? hk::A_OF : hk::A_OB));
        f32x16 accST = zero16();
        __syncthreads();
        for (int i = tid; i < 32 * RS / 4; i += 512) ((unsigned*)Sb)[i] = 0u;
        u32x4 kq[4], qq[4], vq; float ev = 0.f;
#define GLA_PREFETCH(ci_) do { const int r0_ = sc::row0_of(ci_, b, dir); \
        if (tid < 384) ev = EB[(size_t)(r0_ >> 7) * 1536 + (tid >> 7) * 512 + (tid & 127)]; \
        _Pragma("unroll") for (int k_ = 0; k_ < 4; ++k_) { const int pc = tid + 512 * k_, row = pc >> 4, ch = pc & 15; kq[k_] = *(const u32x4*)(KD + (size_t)(r0_ + row) * 512 + h * 128 + 8 * ch); qq[k_] = *(const u32x4*)(QD + (size_t)(r0_ + row) * 512 + h * 128 + 8 * ch); } \
        { const int vr = tid >> 4, ch = tid & 15; vq = *(const u32x4*)(VTG + (size_t)(h * 256 + vs * 32 + vr) * hk::TA + r0_ + 8 * ch); } } while (0)
#define GLA_FILL(VT) do { \
        _Pragma("unroll") for (int k_ = 0; k_ < 4; ++k_) { const int pc = tid + 512 * k_, row = pc >> 4, ch = pc & 15; *(u32x4*)(Km + off_b(row, ch)) = kq[k_]; *(u32x4*)(Qm + row * RS + 16 * ch) = qq[k_]; } \
        { const int vr = tid >> 4, ch = tid & 15; *(u32x4*)(VT + vr * RS + 16 * ch) = vq; } } while (0)
        GLA_PREFETCH(0);
        __syncthreads();
        GLA_FILL(VT0);
        if (tid < 384) Es[tid] = ev;
        GLA_PREFETCH(1);
        for (int ci = 0; ci < 130; ++ci) {
            __syncthreads();
            const float* Ec = Es + (ci & 1) * 384; const float* En = Es + ((ci + 1) & 1) * 384;
            unsigned char* VT = VT0 + (ci & 1) * 32 * RS; unsigned char* VTn = VT0 + ((ci + 1) & 1) * 32 * RS;
            if (ci + 1 < 130 && tid < 384) Es[((ci + 1) & 1) * 384 + tid] = ev;
            bf16x8 cf[8]; if (wave < 4) load8(cf, Qm, 32 * wave + l32, g2);
            int tj[2], ti[2]; const int ntile = (wave == 4 || wave == 5) ? 2 : 1;
            u32x2 gp[2][4];
#pragma unroll
            for (int s = 0; s < 2; ++s) {
                int a, bq;
                if (wave < 4) { a = wave; bq = wave; }
                else if (wave == 4) { a = s == 0 ? 0 : 2; bq = s == 0 ? 1 : 3; }
                else if (wave == 5) { a = s == 0 ? 0 : 1; bq = s == 0 ? 2 : 3; }
                else if (wave == 6) { a = 1; bq = 2; }
                else { a = 0; bq = 3; }
                tj[s] = dir == 0 ? a : bq; ti[s] = dir == 0 ? bq : a;
                if (s < ntile) {
                    const f32x16 gt = wave < 4 ? chain8_xa_b(zero16(), Km, 32 * tj[s] + l32, cf, g2) : chain8_xa(zero16(), Km, 32 * tj[s] + l32, Qm, 32 * ti[s] + l32, g2);
                    if (wave < 4) {
                        const int i = 32 * ti[s] + l32;
#pragma unroll
                        for (int q = 0; q < 4; ++q) {
                            const int j0 = 32 * tj[s] + 8 * q + 4 * g2;
                            float v[4];
#pragma unroll
                            for (int r = 0; r < 4; ++r) { const int j = j0 + r; const bool ok = dir == 0 ? (j <= i) : (j >= i); v[r] = ok ? gt[4 * q + r] : 0.f; }
                            gp[s][q].x = pk2(v[0], v[1]); gp[s][q].y = pk2(v[2], v[3]);
                        }
                    } else {
#pragma unroll
                        for (int q = 0; q < 4; ++q) { gp[s][q].x = pk2(gt[4 * q], gt[4 * q + 1]); gp[s][q].y = pk2(gt[4 * q + 2], gt[4 * q + 3]); }
                    }
#pragma unroll
                    for (int q = 0; q < 4; ++q) *(u32x2*)(Gi + (32 * ti[s] + l32) * RS + 2 * (32 * tj[s] + 8 * q + 4 * g2)) = gp[s][q];
                }
            }
            f32x16 yacc = zero16();
            if (wave < 4) {
                yacc = chain8_b(yacc, Sb, l32, cf, g2);
            } else {
                const int nt = wave - 4;
                f32x16 u = zero16();
                u = chain8_tr(u, tr_addr(km_lds, lane, nt, 0), tr_addr(km_lds, lane, nt, 1), VT, l32, g2);
#pragma unroll
                for (int q = 0; q < 4; ++q) { const int k0 = 32 * nt + 8 * q + 4 * g2; const f32x4 e1 = *(const f32x4*)(Ec + k0), e2 = *(const f32x4*)(Ec + 128 + k0);
#pragma unroll
                    for (int r = 0; r < 4; ++r) accST[4 * q + r] = e1[r] * accST[4 * q + r] + e2[r] * u[4 * q + r]; }
            }
            __syncthreads();
            if (ci + 1 < 130) { GLA_FILL(VTn); if (ci + 2 < 130) GLA_PREFETCH(ci + 2); }
            if (wave < 4) {
                const int it2 = wave, jlo = dir == 0 ? 0 : it2, jhi = dir == 0 ? it2 : 3;
                for (int jt = jlo; jt <= jhi; ++jt) yacc = chain2(yacc, VT, l32, Gi, 32 * it2 + l32, 64 * jt + 16 * g2);
                const int r0 = sc::row0_of(ci, b, dir), i = 32 * it2 + l32;
                bf16_t* orow = OUT + (size_t)(r0 + i) * 1024 + h * 256 + vs * 32 + 4 * g2;
#pragma unroll
                for (int q = 0; q < 4; ++q) { u32x2 w; w.x = pk2(yacc[4 * q], yacc[4 * q + 1]); w.y = pk2(yacc[4 * q + 2], yacc[4 * q + 3]); *(u32x2*)(orow + 8 * q) = w; }
            } else {
                const int nt = wave - 4;
#pragma unroll
                for (int q = 0; q < 4; ++q) { const f32x4 e3 = *(const f32x4*)(En + 256 + 32 * nt + 8 * q + 4 * g2);
                    u32x2 w; w.x = pk2(accST[4 * q] * e3[0], accST[4 * q + 1] * e3[1]); w.y = pk2(accST[4 * q + 2] * e3[2], accST[4 * q + 3] * e3[3]);
                    *(u32x2*)(Sb + l32 * RS + 2 * (32 * nt + 8 * q + 4 * g2)) = w; }
            }
        }
#undef GLA_PREFETCH
#undef GLA_FILL
    }
}
#ifndef ONE_LAUNCH
#define ONE_LAUNCH 0
#endif
#ifndef HY_FFT
#define HY_FFT 1
#endif
#ifndef SSD_CHUNK
#define SSD_CHUNK 1
#endif
#ifndef GLA_CHUNK
#define GLA_CHUNK 1
#endif
#ifndef PROBE_DUP_GEMM
#define PROBE_DUP_GEMM 0
#endif
#ifndef PROBE_STAMP
#define PROBE_STAMP 0
#endif
constexpr int N_PHASES = 22;
constexpr int NO_SPLIT = 1 << 30;

template <class Epi> __device__ __forceinline__ void run_gemm(unsigned char* lds, const bf16_t* A, const bf16_t* Bt, int M, int N, int K, const Epi& E) {
    pg8::Gemm g{A, Bt, M, N, K}; pg8::StaticOrder S; S.init(M, N, (int)gridDim.x, (int)blockIdx.x);
    pg8::gemm_phase<Epi, pg8::StaticOrder, false>((PG8_LAS unsigned char*)lds, g, S, E, nullptr);
#if PROBE_DUP_GEMM
    __syncthreads(); pg8::gemm_phase<Epi, pg8::StaticOrder, false>((PG8_LAS unsigned char*)lds, g, S, E, nullptr);
#endif
}
template <class Epi, bool GATHER = false> __device__ __forceinline__ void run_gemm_grouped(unsigned char* lds, const bf16_t* A, const bf16_t* Bt, int K, const unsigned* ctl, int layer, const Epi& E, const int* rowmap = nullptr) {
    pg8::GroupedOrder S; expert_starts(ctl + hk::CW_CNT + layer * 64, S.ps);
    S.ntiles = S.ps[16] >> 8; S.ncol = 8; S.G = (int)gridDim.x; S.c = (int)blockIdx.x; S.cap = hk::ROWS_CAP;
    pg8::Gemm g{A, Bt, S.ntiles * 256, 16 * 2048, K, rowmap};
    pg8::gemm_phase<Epi, pg8::GroupedOrder, false, GATHER>((PG8_LAS unsigned char*)lds, g, S, E, nullptr);
}

__global__ void __launch_bounds__(512, 2) hybrid_fwd(Params p) {
    extern __shared__ __attribute__((aligned(16))) unsigned char lds[];
    unsigned char* ws = p.ws; unsigned char* act = ws + hk::WS_ACT;
    unsigned* ctl = (unsigned*)(ws + hk::WS_CTL);
#if ONE_LAUNCH
    volatile LAS unsigned* xbw = (volatile LAS unsigned*)(lds + hk::LDS_BYTES - 16);
    if (threadIdx.x == 0) { xbw[0] = 0u; xbw[1] = 0u; xbw[2] = 0u; xbw[3] = 0u; }
    __syncthreads();
    XcdBarrier bar = xcd_barrier_post(ctl + hk::CW_BAR, xbw);
#define SEAM(k) do { if ((k) + 1 < p.ph_hi) xcd_barrier(bar); } while (0)
#else
#define SEAM(k) do { } while (0)
#endif
#ifndef PH_MASK
#define PH_MASK 0xFFFFFFFFu
#endif
#define IN(k) ((((PH_MASK) >> (k)) & 1u) && p.ph_lo <= (k) && (k) < p.ph_hi)
#ifdef PROBE_PHASE
    unsigned long long pp_t0 = __builtin_amdgcn_s_memrealtime(), pp_ta = 0, pp_tb = 0;
#define PP_BEGIN(k) do { if ((k) == PROBE_PHASE) pp_ta = __builtin_amdgcn_s_memrealtime(); if ((k) == 21 && blockIdx.x == 0 && threadIdx.x == 0) { const unsigned long long now_ = __builtin_amdgcn_s_memrealtime(); \
        ((float*)(ws + hk::WS_CTL))[hk::CW_PROBE] = (float)(pp_tb - pp_ta) / (float)(now_ - pp_t0); } } while (0)
#define PP_END(k) do { if ((k) == PROBE_PHASE) pp_tb = __builtin_amdgcn_s_memrealtime(); } while (0)
#else
#define PP_BEGIN(k) do { } while (0)
#define PP_END(k) do { } while (0)
#endif
    bf16_t* HA = (bf16_t*)(act + hk::A_HA);
    if (IN(0)) { PP_BEGIN(0); ph_mod(p, lds); __syncthreads(); ph_conv_weights(p, lds); __syncthreads(); ph_conv_experts(p, 0, lds); __syncthreads(); ph_hid(p, lds); __syncthreads(); SEAM(0); PP_END(0); }
    if (IN(1)) { PP_BEGIN(1); ph_modulate0(p, lds); SEAM(1); PP_END(1); }
    if (IN(2)) { PP_BEGIN(2);
        {
            static_assert(hk::WS_WU % hk::MiB == 0 && hk::WS_WGLA % hk::MiB == 0 && (hk::WS_ACT + hk::A_HA) % hk::MiB == 0, "operand buffers must sit on 1 MiB steps");
            constexpr int T_WU = (int)(hk::WS_WU / hk::MiB), T_WGLA = (int)(hk::WS_WGLA / hk::MiB), T_HA = (int)((hk::WS_ACT + hk::A_HA) / hk::MiB);
            static_assert(T_WU < T_HA && T_WGLA < T_HA, "EpiChain tells the GEMMs apart by pm >= T_HA");
            pg8::Gemm g{(const bf16_t*)ws, (const bf16_t*)ws, 0, 0, 2048};
            pg8::ChainOrder S{16, hk::TA / 256, T_WU, T_HA, hk::TA / 256, 9, T_HA, T_WGLA, (int)gridDim.x, (int)blockIdx.x};
            pg8::EpiChain E{pg8::EpiStore{(bf16_t*)(act + hk::A_UT), hk::TA, NO_SPLIT, nullptr, 0, 0}, pg8::EpiStore{(bf16_t*)(act + hk::A_GL), hk::GL_LD, NO_SPLIT, nullptr, 0, 0}, T_WU, T_HA, T_HA, T_WGLA};
            pg8::gemm_phase<pg8::EpiChain, pg8::ChainOrder, false>((PG8_LAS unsigned char*)lds, g, S, E, nullptr);
        }
        run_gemm(lds, (const bf16_t*)(ws + hk::WS_W3T), (const bf16_t*)(ws + hk::WS_HID2), 4096, 16384, 256, pg8::EpiStore{(bf16_t*)(act + hk::A_HF), 16384, NO_SPLIT, nullptr, 0, 0});
        run_gemm(lds, (const bf16_t*)(ws + hk::WS_W3T), (const bf16_t*)(ws + hk::WS_HID2C), 4096, 256, 256, pg8::EpiStore{(bf16_t*)(act + hk::A_HFC), 256, NO_SPLIT, nullptr, 0, 0});
        SEAM(2);
    }
    if (IN(3)) { PP_BEGIN(3);
#if GLA_CHUNK
        ph_gla_pre(p, lds);
#endif
        SEAM(3); PP_END(3); }
    if (IN(4)) { PP_BEGIN(4);
#if GLA_CHUNK
        ph_gla_scan_chunk(p, lds);
#else
        ph_gla_scan_naive(p, lds);
#endif
        __syncthreads();
#if HY_FFT
        ph_hyena_fft(p, lds);
#else
        ph_hyena_naive(p, lds);
#endif
        SEAM(4); PP_END(4); }
    if (IN(5)) { PP_BEGIN(5); ph_mix_finish(p, lds); SEAM(5); PP_END(5); }
    if (IN(6)) { PP_BEGIN(6); run_gemm(lds, HA, (const bf16_t*)(ws + hk::WS_WOUT0), gridDim.x == 256 ? hk::TL : hk::TA, 2048, 2048, pg8::EpiStore{(bf16_t*)(act + hk::A_YO), 2048, NO_SPLIT, nullptr, 0, 0}); SEAM(6); PP_END(6); }
    if (IN(7)) { PP_BEGIN(7);
        if (gridDim.x == 256 && blockIdx.x >= 240) {
            pg8::Gemm g{HA + (size_t)hk::TL * 2048, (const bf16_t*)(ws + hk::WS_WOUT0), 512, 2048, 2048}; pg8::StaticOrder S; S.init(512, 2048, 16, (int)blockIdx.x - 240);
            pg8::gemm_phase<pg8::EpiStore, pg8::StaticOrder, false>((PG8_LAS unsigned char*)lds, g, S, pg8::EpiStore{(bf16_t*)(act + hk::A_YO) + (size_t)hk::TL * 2048, 2048, NO_SPLIT, nullptr, 0, 0}, nullptr);
            asm volatile("s_waitcnt vmcnt(0)" ::: "memory");
            __syncthreads();
            if (threadIdx.x == 0) { __builtin_amdgcn_fence(__ATOMIC_RELEASE, "agent"); asm volatile("s_waitcnt vmcnt(0)" ::: "memory");
                __hip_atomic_fetch_add(ctl + hk::CW_CTXF, 1u, __ATOMIC_RELAXED, __HIP_MEMORY_SCOPE_AGENT); }
            __syncthreads();
        }
        ph_ln1_router(p, 0, lds, (const bf16_t*)(act + hk::A_YO), HA); SEAM(7); PP_END(7); }
    if (IN(9)) { PP_BEGIN(9); run_gemm_grouped<pg8::EpiSwiGLU, true>(lds, HA, (const bf16_t*)(ws + hk::WS_WE), 2048, ctl, 0, pg8::EpiSwiGLU{(bf16_t*)(act + hk::A_HB), 1024, 8}, (const int*)(act + hk::A_ROWS)); SEAM(9); PP_END(9); }
    if (IN(10)) { PP_BEGIN(10); run_gemm_grouped(lds, (const bf16_t*)(act + hk::A_HB), (const bf16_t*)(ws + hk::WS_WE_DN), 1024, ctl, 0, pg8::EpiStore{(bf16_t*)(act + hk::A_YR), 2048, NO_SPLIT, nullptr, 0, 8}); SEAM(10); PP_END(10); }
    if (IN(11)) { PP_BEGIN(11); ph_ln2(p, 0, (const bf16_t*)(act + hk::A_YR), (bf16_t*)(act + hk::A_HA1), lds); SEAM(11); PP_END(11); }
    if (IN(12)) { PP_BEGIN(12);
        {   static_assert(hk::WS_WSSDIN % hk::MiB == 0 && (hk::WS_ACT + hk::A_HA1) % hk::MiB == 0, "operand buffers must sit on 1 MiB steps");
            constexpr int T_WX = (int)(hk::WS_WSSDIN / hk::MiB), T_H1 = (int)((hk::WS_ACT + hk::A_HA1) / hk::MiB);
            static_assert(T_WX + 41 < T_H1, "EpiChain tells the GEMMs apart by pm >= T_H1");
            pg8::Gemm g{(const bf16_t*)ws, (const bf16_t*)ws, 0, 0, 2048};
            pg8::ChainOrder S{16, hk::TA / 256, T_WX, T_H1, hk::TA / 256, 25, T_H1, T_WX + 16, (int)gridDim.x, (int)blockIdx.x};
            pg8::EpiChain E{pg8::EpiStore{(bf16_t*)(act + hk::A_XT), hk::TA, NO_SPLIT, nullptr, 0, 0}, pg8::EpiStore{(bf16_t*)(act + hk::A_Z), 4096, 16, (bf16_t*)(act + hk::A_XBC), hk::XBC_LD, 0}, T_WX, T_H1, T_H1, T_WX + 16};
            pg8::gemm_phase<pg8::EpiChain, pg8::ChainOrder, false>((PG8_LAS unsigned char*)lds, g, S, E, nullptr);
        }
        SEAM(12); PP_END(12); }
    if (IN(13)) { PP_BEGIN(13); ph_ssd_conv(p, lds); SEAM(13); PP_END(13); }
    if (IN(14)) { PP_BEGIN(14);
#if SSD_CHUNK
        ph_ssd_scan_chunk(p, lds);
#else
        ph_ssd_scan_naive(p, lds);
#endif
        SEAM(14); PP_END(14); }
    if (IN(15)) { PP_BEGIN(15); ph_ssd_finish(p); SEAM(15); PP_END(15); }
    if (IN(16)) { PP_BEGIN(16);
        run_gemm(lds, (const bf16_t*)(act + hk::A_Z), (const bf16_t*)(ws + hk::WS_WOUT1), hk::TL, 2048, 4096, pg8::EpiStore{(bf16_t*)(act + hk::A_YO1), 2048, NO_SPLIT, nullptr, 0, 0});
        __syncthreads(); ph_conv_experts(p, 1, lds); SEAM(16);
    }
    if (IN(17)) { PP_BEGIN(17); ph_ln1_router(p, 1, lds, (const bf16_t*)(act + hk::A_YO1), (bf16_t*)(act + hk::A_HA2)); SEAM(17); PP_END(17); }
    if (IN(19)) { PP_BEGIN(19); run_gemm_grouped<pg8::EpiSwiGLU, true>(lds, (const bf16_t*)(act + hk::A_HA2), (const bf16_t*)(ws + hk::WS_WE), 2048, ctl, 1, pg8::EpiSwiGLU{(bf16_t*)(act + hk::A_HB1), 1024, 8}, (const int*)(act + hk::A_ROWS)); SEAM(19); PP_END(19); }
    if (IN(20)) { PP_BEGIN(20); run_gemm_grouped(lds, (const bf16_t*)(act + hk::A_HB1), (const bf16_t*)(ws + hk::WS_WE_DN), 1024, ctl, 1, pg8::EpiStore{(bf16_t*)(act + hk::A_YR1), 2048, NO_SPLIT, nullptr, 0, 8}); SEAM(20); PP_END(20); }
    if (IN(21)) { PP_BEGIN(21); ph_ln2(p, 1, (const bf16_t*)(act + hk::A_YR1), nullptr, lds); }
#undef IN
#undef SEAM
}

extern "C" void kernel_launch(void* const* d_in, const int* in_sizes, int n_in, void* d_out, int out_size, void* d_ws, size_t ws_size, hipStream_t stream) {
    static int grid = 0;
    if (grid == 0) {
        if (n_in != hk::N_IN || ws_size < hk::WS_NEED) { fprintf(stderr, "kernel_launch: need %d inputs and %zu bytes of workspace; got %d, %zu\n", hk::N_IN, (size_t)hk::WS_NEED, n_in, ws_size); grid = -1; return; }
        int dev = 0, cus = 0, per_cu = 0;
        if (hipGetDevice(&dev) != hipSuccess || hipDeviceGetAttribute(&cus, hipDeviceAttributeMultiprocessorCount, dev) != hipSuccess) { grid = -1; return; }
        if (hipFuncSetAttribute((const void*)hybrid_fwd, hipFuncAttributeMaxDynamicSharedMemorySize, hk::LDS_BYTES) != hipSuccess) { fprintf(stderr, "kernel_launch: hipFuncSetAttribute failed\n"); grid = -1; return; }
        if (hipOccupancyMaxActiveBlocksPerMultiprocessor(&per_cu, (const void*)hybrid_fwd, hk::NTHREADS, hk::LDS_BYTES) != hipSuccess || per_cu < 1) fprintf(stderr, "kernel_launch: occupancy query reports %d\n", per_cu);
        (void)hipGetLastError();
        grid = cus;
    }
    if (grid < 0) return;
    (void)hipMemsetAsync((char*)d_ws + hk::WS_ACT + hk::A_ROWS, 0, (size_t)16 * hk::ROWS_CAP * sizeof(int), stream);
    (void)hipMemsetAsync((char*)d_ws + hk::WS_CTL, 0, 64 * 1024, stream);
    Params prm{};
    for (int i = 0; i < hk::N_IN; ++i) prm.in[i] = (const float*)d_in[i];
    prm.out = (float*)d_out; prm.ws = (unsigned char*)d_ws;
#if ONE_LAUNCH
    prm.ph_lo = 0; prm.ph_hi = N_PHASES;
    hipLaunchKernelGGL(hybrid_fwd, dim3(grid), dim3(hk::NTHREADS), hk::LDS_BYTES, stream, prm);
#else
    for (int k = 0; k < N_PHASES; ++k) { prm.ph_lo = k; prm.ph_hi = k + 1; hipLaunchKernelGGL(hybrid_fwd, dim3(grid), dim3(hk::NTHREADS), hk::LDS_BYTES, stream, prm);
#ifdef PROBE_REP_MASK
        if ((PROBE_REP_MASK >> k) & 1u) hipLaunchKernelGGL(hybrid_fwd, dim3(grid), dim3(hk::NTHREADS), hk::LDS_BYTES, stream, prm);
#endif
    }
#endif
}
```

```cpp
#include <hip/hip_runtime.h>
#include <cstdio>
#include <cstdint>
#define ONE_LAUNCH 1
namespace pg8 {
#define PG8_LAS __attribute__((address_space(3)))
typedef unsigned short bf16_t;
typedef short bf16x8 __attribute__((ext_vector_type(8)));
typedef float f32x4 __attribute__((ext_vector_type(4)));
typedef unsigned u32x4 __attribute__((ext_vector_type(4)));
constexpr int BM = 256, BK = 64, HALF = 128, HTB = HALF * BK * 2  , STAGE_BYTES = 8 * HTB, NXCD = 8, WGM = 8;

__host__ __device__ __forceinline__ int lds_byte(int r, int c) { const int st = (r >> 4) * 2 + (c >> 5), rr = r & 15, cc = c & 31, ob = rr * 64 + cc * 2; return st * 1024 + (ob ^ (((ob >> 9) & 1) << 5)); }
__host__ __device__ __forceinline__ void stage_rc(int b, int& R, int& C) { const int st = b / 1024, sb = b % 1024, swz = sb ^ (((sb >> 9) & 1) << 5); R = (st >> 1) * 16 + swz / 64; C = (st & 1) * 32 + (swz % 64) / 2; }
__host__ __device__ __forceinline__ int perm32(int rho) { const int n = rho >> 4, i = rho & 15; return 8 * (i >> 2) + 4 * n + (i & 3); }

struct Unit { int pm, pn; };
struct Gemm { const bf16_t* A; const bf16_t* Bt; int M, N, K; const int* rowmap = nullptr; };

struct StaticOrder {
    int nM, nN, nwg, G, c;
    __host__ __device__ void init(int M, int N, int G_, int c_) { nM = M / BM; nN = N / BM; nwg = nM * nN; G = G_; c = c_; }
    __host__ __device__ bool next(int i, Unit& u) const {
        const long L = (long)i * G + c; if (L >= nwg) return false;
        int wgid = (int)L; { const int q = nwg / NXCD, r = nwg % NXCD, xcd = wgid % NXCD, off = wgid / NXCD; wgid = (xcd < r ? xcd * (q + 1) : r * (q + 1) + (xcd - r) * q) + off; }
        const int nig = WGM * nN, gid = wgid / nig, fm = gid * WGM, gsz = (nM - fm) < WGM ? (nM - fm) : WGM;
        u.pm = fm + ((wgid % nig) % gsz); u.pn = (wgid % nig) / gsz; return true;
    }
    __device__ __forceinline__ void a_ready(const Unit&) const {}
    __device__ __forceinline__ void done(const Unit&) const {}
};
__device__ __forceinline__ unsigned cvt_pk_bf16(float lo, float hi) { unsigned r; asm volatile("v_cvt_pk_bf16_f32 %0, %1, %2" : "=v"(r) : "v"(lo), "v"(hi)); return r; }
typedef unsigned u32x4 __attribute__((ext_vector_type(4)));
struct EpiStore {
    static constexpr bool PERM = true, AFTER_DRAIN = false;
    bf16_t* O; int ld; int split; bf16_t* O2; int ld2; int pn_mod;
    __device__ __forceinline__ void operator()(const f32x4 (&acc)[2][2][4][2], const Unit& u, int wr, int wc, int fr, int fq) const {
        const int pn = pn_mod > 0 ? (u.pn % pn_mod) : u.pn;
        const int row0 = u.pm * BM + wr * 64 + fr;
        bf16_t* base = O; int ldc = ld, colt = pn * BM;
        if (pn >= split) { base = O2; ldc = ld2; colt = (pn - split) * BM; }
        const int col0 = colt + wc * 32 + 8 * fq;
#pragma unroll
        for (int ai = 0; ai < 2; ++ai)
#pragma unroll
            for (int m = 0; m < 4; ++m) { bf16_t* rowp = base + (size_t)(row0 + ai * HALF + m * 16) * ldc + col0;
#pragma unroll
                for (int bj = 0; bj < 2; ++bj) { const f32x4 v0 = acc[ai][bj][m][0], v1 = acc[ai][bj][m][1];
                    u32x4 w; w.x = cvt_pk_bf16(v0[0], v0[1]); w.y = cvt_pk_bf16(v0[2], v0[3]); w.z = cvt_pk_bf16(v1[0], v1[1]); w.w = cvt_pk_bf16(v1[2], v1[3]);
                    *(u32x4*)(rowp + bj * HALF) = w; } }
    }
};
struct EpiSwiGLU {
    static constexpr bool PERM = true, AFTER_DRAIN = false;
    bf16_t* O; int ld; int pn_mod;
    __device__ __forceinline__ void operator()(const f32x4 (&acc)[2][2][4][2], const Unit& u, int wr, int wc, int fr, int fq) const {
        const int pn = u.pn % pn_mod;
        const int row0 = u.pm * BM + wr * 64 + fr, col0 = pn * HALF + wc * 32 + 8 * fq;
#pragma unroll
        for (int ai = 0; ai < 2; ++ai)
#pragma unroll
            for (int m = 0; m < 4; ++m) { bf16_t* rowp = O + (size_t)(row0 + ai * HALF + m * 16) * ld + col0;
                float h[8];
#pragma unroll
                for (int n = 0; n < 2; ++n)
#pragma unroll
                    for (int j = 0; j < 4; ++j) { const float g = acc[ai][0][m][n][j], uu = acc[ai][1][m][n][j]; h[n * 4 + j] = g * __builtin_amdgcn_rcpf(1.0f + __expf(-g)) * uu; }
                u32x4 w; w.x = cvt_pk_bf16(h[0], h[1]); w.y = cvt_pk_bf16(h[2], h[3]); w.z = cvt_pk_bf16(h[4], h[5]); w.w = cvt_pk_bf16(h[6], h[7]);
                *(u32x4*)rowp = w; }
    }
};
struct GroupedOrder {
    int ps[17];
    int ntiles, ncol, G, c, cap;
    __device__ __forceinline__ int expert_of(int rt) const { int e = 0;
#pragma unroll
        for (int q = 1; q < 16; ++q) e = (rt * BM >= ps[q]) ? q : e;
        return e; }
    __device__ __forceinline__ int tile_rt(int i) const {
        if (G == 256 && ncol == 8) { const int rt = i * 32 + 4 * (c & 7) + (c >> 6); return rt < ntiles ? rt : -1; }
        const long L = (long)i * G + c; return L < (long)ntiles * ncol ? (int)(L / ncol) : -1;
    }
    __device__ __forceinline__ bool next(int i, Unit& u) const {
        const int rt = tile_rt(i); if (rt < 0) return false;
        const int pl = (G == 256 && ncol == 8) ? ((c >> 3) & 7) : (int)(((long)i * G + c) % ncol);
        u.pm = rt; u.pn = expert_of(rt) * ncol + pl; return true;
    }
    __device__ __forceinline__ int peek_pm(int i) const { return tile_rt(i); }
    __device__ __forceinline__ int row_base(int rt) const { const int e = expert_of(rt); int pse = 0;
#pragma unroll
        for (int q = 0; q < 16; ++q) pse = e == q ? ps[q] : pse;
        return e * cap + rt * BM - pse; }
    __device__ __forceinline__ void a_ready(const Unit&) const {}
    __device__ __forceinline__ void done(const Unit&) const {}
};

struct ChainOrder {
    int nM1, nN1, pm1, pn1, nM2, nN2, pm2, pn2, G, c;
    __device__ __forceinline__ static void unit_of(int wgid, int nM, int nN, Unit& u) {
        const int nwg = nM * nN;
        { const int q = nwg / NXCD, r = nwg % NXCD, xcd = wgid % NXCD, off = wgid / NXCD; wgid = (xcd < r ? xcd * (q + 1) : r * (q + 1) + (xcd - r) * q) + off; }
        const int nig = WGM * nN, gid = wgid / nig, fm = gid * WGM, gsz = (nM - fm) < WGM ? (nM - fm) : WGM;
        u.pm = fm + ((wgid % nig) % gsz); u.pn = (wgid % nig) / gsz;
    }
    __device__ __forceinline__ bool next(int i, Unit& u) const {
        long L = (long)i * G + c; const int n1 = nM1 * nN1;
        if (L < n1) { unit_of((int)L, nM1, nN1, u); u.pm += pm1; u.pn += pn1; return true; }
        L -= n1; if (L >= (long)nM2 * nN2) return false;
        unit_of((int)L, nM2, nN2, u); u.pm += pm2; u.pn += pn2; return true;
    }
    __device__ __forceinline__ void a_ready(const Unit&) const {}
    __device__ __forceinline__ void done(const Unit&) const {}
};
struct EpiChain {
    static constexpr bool PERM = true, AFTER_DRAIN = false;
    EpiStore e1, e2; int pm1, pn1, pm2, pn2;
    __device__ __forceinline__ void operator()(const f32x4 (&acc)[2][2][4][2], const Unit& u, int wr, int wc, int fr, int fq) const {
        if (u.pm >= pm2) { const Unit v{u.pm - pm2, u.pn - pn2}; e2(acc, v, wr, wc, fr, fq); }
        else { const Unit v{u.pm - pm1, u.pn - pn1}; e1(acc, v, wr, wc, fr, fq); }
    }
};

template <class Epi, class Sched, bool STAMP = false, bool GATHER = false>
__device__ __forceinline__ void gemm_phase(PG8_LAS unsigned char* lds, const Gemm g, const Sched& S, const Epi& E, unsigned long long* stamps) {
    const int tid = threadIdx.x, wid = __builtin_amdgcn_readfirstlane(tid >> 6), lane = tid & 63, wr = wid >> 2, wc = wid & 3, fr = lane & 15, fq = lane >> 4;
    const int K = g.K, nt = K / BK;
    int ts_lo = 0, ts_hi = 0, nts = 0; const unsigned long long rt_entry = STAMP ? (unsigned long long)wall_clock64() : 0ull;
#define PG8_STAMP() do { if (STAMP && wid == 0 && nts < 64) { const unsigned long long _c = (unsigned long long)clock64(); \
        ts_lo = (lane == nts) ? (int)(unsigned)_c : ts_lo; ts_hi = (lane == nts) ? (int)(unsigned)(_c >> 32) : ts_hi; ++nts; } } while (0)
    PG8_STAMP();
    unsigned voffA[2], voffB[2]; int gR[2]; unsigned gC2[2];
    unsigned gcx[2][2] = {{0u, 0u}, {0u, 0u}}, gnx[2][2] = {{0u, 0u}, {0u, 0u}};
#define PG8_GOFF(dst, pm_) do { _Pragma("unroll") for (int h_ = 0; h_ < 2; ++h_) _Pragma("unroll") for (int i_ = 0; i_ < 2; ++i_) \
        dst[h_][i_] = (unsigned)g.rowmap[S.row_base(pm_) + h_ * HALF + gR[i_]] * (unsigned)(K * 2) + gC2[i_]; } while (0)
#define PG8_STAGE_A(bufoff, base, h, usenext) do { if constexpr (!GATHER) { PG8_STAGE(bufoff, (base) + ((h) ? hstep : (size_t)0), voffA); } \
        else { const unsigned vo_[2] = {(usenext) ? gnx[h][0] : gcx[h][0], (usenext) ? gnx[h][1] : gcx[h][1]}; PG8_STAGE(bufoff, base, vo_); } } while (0)
#pragma unroll
    for (int i = 0; i < 2; ++i) { int R, C; stage_rc(tid * 16 + i * 8192, R, C); const int Rb = Epi::PERM ? ((R & ~31) + perm32(R & 31)) : R;
        voffA[i] = (unsigned)(R * K + C) * 2u; voffB[i] = (unsigned)(Rb * K + C) * 2u; gR[i] = R; gC2[i] = (unsigned)C * 2u; }
    const size_t kstep = (size_t)(BK * 2);
    const size_t hstep = (size_t)HALF * K * 2;
    const size_t tstep = 2 * hstep;
    const unsigned ldsw = (unsigned)wid * 1024u;
    const int aoff = lds_byte(wr * 64 + fr, fq * 8), boff = lds_byte(wc * 32 + fr, fq * 8);
#define PG8_SA(b, h) (((b) * 2 + (h)) * HTB)
#define PG8_SB(b, h) ((4 + (b) * 2 + (h)) * HTB)
#define PG8_STAGE(bufoff, gbase, voff) do { _Pragma("unroll") for (int _i = 0; _i < 2; ++_i) \
        __builtin_amdgcn_global_load_lds((const unsigned*)((const char*)(gbase) + (voff)[_i]), (PG8_LAS unsigned*)(lds + (bufoff) + ldsw + _i * 8192), 16, 0, 0); } while (0)
#define PG8_LDA(dst, b, h) do { _Pragma("unroll") for (int m = 0; m < 4; ++m) _Pragma("unroll") for (int k = 0; k < 2; ++k) dst[m][k] = *(const PG8_LAS bf16x8*)(lds + PG8_SA(b, h) + aoff + m * 2048 + k * 1024); } while (0)
#define PG8_LDB(dst, b, h) do { _Pragma("unroll") for (int n = 0; n < 2; ++n) _Pragma("unroll") for (int k = 0; k < 2; ++k) dst[n][k] = *(const PG8_LAS bf16x8*)(lds + PG8_SB(b, h) + boff + n * 2048 + k * 1024); } while (0)
#define PG8_MMA(ai, bj, At, Bt) do { __builtin_amdgcn_s_setprio(1); _Pragma("unroll") for (int m = 0; m < 4; ++m) _Pragma("unroll") for (int n = 0; n < 2; ++n) _Pragma("unroll") for (int k = 0; k < 2; ++k) \
        acc[ai][bj][m][n] = __builtin_amdgcn_mfma_f32_16x16x32_bf16(Bt[n][k], At[m][k], acc[ai][bj][m][n], 0, 0, 0); __builtin_amdgcn_s_setprio(0); } while (0)
#define PG8_WAIT_V(n) asm volatile("s_waitcnt vmcnt(" #n ")" ::: "memory")
#define PG8_WAIT_L(n) asm volatile("s_waitcnt lgkmcnt(" #n ")" ::: "memory")
#define PG8_BAR __builtin_amdgcn_s_barrier()
#define PG8_SCHED __builtin_amdgcn_sched_barrier(0)
    Unit cur, nxt; int ui = 0;
    if (!S.next(0, cur)) return;
    f32x4 acc[2][2][4][2];
#pragma unroll
    for (int a = 0; a < 2; ++a)
#pragma unroll
        for (int b = 0; b < 2; ++b)
#pragma unroll
            for (int m = 0; m < 4; ++m)
#pragma unroll
                for (int n = 0; n < 2; ++n) acc[a][b][m][n] = (f32x4){0.f, 0.f, 0.f, 0.f};
    bf16x8 At[4][2], B0[2][2], B1[2][2];
    const char* cA = (const char*)g.A + (GATHER ? (size_t)0 : (size_t)cur.pm * tstep); const char* cB = (const char*)g.Bt + (size_t)cur.pn * tstep;
    S.a_ready(cur);
    if constexpr (GATHER) PG8_GOFF(gcx, cur.pm);
    PG8_STAGE(PG8_SB(0, 0), cB, voffB); PG8_STAGE_A(PG8_SA(0, 0), cA, 0, false); PG8_STAGE(PG8_SB(0, 1), cB + hstep, voffB); PG8_STAGE_A(PG8_SA(0, 1), cA, 1, false);
    if (wr == 1) PG8_BAR;
    PG8_WAIT_V(4); PG8_BAR;
    PG8_STAGE(PG8_SB(1, 0), cB + kstep, voffB); PG8_STAGE_A(PG8_SA(1, 0), cA + kstep, 0, false); PG8_STAGE(PG8_SB(1, 1), cB + hstep + kstep, voffB);
    PG8_WAIT_V(6); PG8_BAR;
    PG8_STAMP();
    for (;;) {
        int graw[2][2] = {{0, 0}, {0, 0}};
        if constexpr (GATHER) { const int pmn_ = S.peek_pm(ui + 1);
            if (pmn_ >= 0) { _Pragma("unroll") for (int h_ = 0; h_ < 2; ++h_) _Pragma("unroll") for (int i_ = 0; i_ < 2; ++i_) graw[h_][i_] = g.rowmap[S.row_base(pmn_) + h_ * HALF + gR[i_]]; } }
        const bool has_next = S.next(ui + 1, nxt);
        const char* nA = (has_next && !GATHER) ? (const char*)g.A + (size_t)nxt.pm * tstep : cA; const char* nB = has_next ? (const char*)g.Bt + (size_t)nxt.pn * tstep : cB;
        if constexpr (GATHER) { _Pragma("unroll") for (int h_ = 0; h_ < 2; ++h_) _Pragma("unroll") for (int i_ = 0; i_ < 2; ++i_) gnx[h_][i_] = has_next ? (unsigned)graw[h_][i_] * (unsigned)(K * 2) + gC2[i_] : gcx[h_][i_]; }
        for (int t = 0; t < nt; t += 2) {
            const bool last = (t == nt - 2);
            const char* a1 = cA + (size_t)(t + 1) * kstep;
            const char* a2 = last ? nA : cA + (size_t)(t + 2) * kstep; const char* b2 = last ? nB : cB + (size_t)(t + 2) * kstep;
            const char* a3 = a2 + kstep; const char* b3 = b2 + kstep;
            if (last && has_next) S.a_ready(nxt);
            PG8_LDB(B0, 0, 0); PG8_SCHED; PG8_LDA(At, 0, 0); PG8_STAGE_A(PG8_SA(1, 1), a1, 1, false);
            PG8_WAIT_L(8); PG8_BAR; PG8_WAIT_L(0); PG8_MMA(0, 0, At, B0); PG8_BAR; PG8_SCHED;
            PG8_LDB(B1, 0, 1); PG8_STAGE(PG8_SB(0, 0), b2, voffB);
            PG8_BAR; PG8_WAIT_L(0); PG8_MMA(0, 1, At, B1); PG8_BAR;
            PG8_LDA(At, 0, 1); PG8_STAGE_A(PG8_SA(0, 0), a2, 0, last);
            PG8_BAR; PG8_WAIT_L(0); PG8_MMA(1, 0, At, B0); PG8_BAR; PG8_SCHED;
            PG8_STAGE(PG8_SB(0, 1), b2 + hstep, voffB);
            PG8_WAIT_V(6); PG8_BAR; PG8_MMA(1, 1, At, B1); PG8_BAR;
            PG8_LDB(B0, 1, 0); PG8_SCHED; PG8_LDA(At, 1, 0); PG8_STAGE_A(PG8_SA(0, 1), a2, 1, last);
            PG8_WAIT_L(8); PG8_BAR; PG8_WAIT_L(0); PG8_MMA(0, 0, At, B0); PG8_BAR; PG8_SCHED;
            PG8_LDB(B1, 1, 1); PG8_STAGE(PG8_SB(1, 0), b3, voffB);
            PG8_BAR; PG8_WAIT_L(0); PG8_MMA(0, 1, At, B1); PG8_BAR;
            PG8_LDA(At, 1, 1); PG8_STAGE_A(PG8_SA(1, 0), a3, 0, last);
            PG8_BAR; PG8_WAIT_L(0); PG8_MMA(1, 0, At, B0); PG8_BAR; PG8_SCHED;
            PG8_STAGE(PG8_SB(1, 1), b3 + hstep, voffB);
            PG8_WAIT_V(6); PG8_BAR; PG8_MMA(1, 1, At, B1); PG8_BAR;
        }
        PG8_STAMP();
        if constexpr (!Epi::AFTER_DRAIN) { E(acc, cur, wr, wc, fr, fq); S.done(cur); }
        PG8_STAMP();
        if (!has_next) break;
#pragma unroll
        for (int a = 0; a < 2; ++a)
#pragma unroll
            for (int b = 0; b < 2; ++b)
#pragma unroll
                for (int m = 0; m < 4; ++m)
#pragma unroll
                    for (int n = 0; n < 2; ++n) acc[a][b][m][n] = (f32x4){0.f, 0.f, 0.f, 0.f};
        cur = nxt; cA = nA; cB = nB; ++ui;
        if constexpr (GATHER) { gcx[0][0] = gnx[0][0]; gcx[0][1] = gnx[0][1]; gcx[1][0] = gnx[1][0]; gcx[1][1] = gnx[1][1]; }
    }
    PG8_WAIT_V(0);
    if (wr == 0) PG8_BAR;
    PG8_BAR;
    if constexpr (Epi::AFTER_DRAIN) { E.fused(acc, cur, wr, wc, fr, fq, lds, wid, lane); S.done(cur); }
    PG8_STAMP();
    if (STAMP && wid == 0) { stamps[lane] = lane < nts ? (((unsigned long long)(unsigned)ts_hi << 32) | (unsigned)ts_lo) : 0ull;
        if (lane == 62) stamps[62] = rt_entry; if (lane == 63) stamps[63] = (unsigned long long)wall_clock64(); }
#undef PG8_STAMP
#undef PG8_SA
#undef PG8_SB
#undef PG8_STAGE
#undef PG8_STAGE_A
#undef PG8_GOFF
#undef PG8_LDA
#undef PG8_LDB
#undef PG8_MMA
#undef PG8_WAIT_V
#undef PG8_WAIT_L
#undef PG8_BAR
#undef PG8_SCHED
}
}

#define XB_TMO      128
#define XB_XCNT(j)  (256  + 64 * (j))
#define XB_XSUB(j)  (1280 + 64 * (j))
#define XB_XGEN(j)  (2304 + 64 * (j))
#define XB_TOP      3328
#define XB_TOPGEN   3392
#define XCD_BAR_WORDS 3456
#define XB_SPIN_CAP (1u << 21)
#define LAS __attribute__((address_space(3)))

__device__ __forceinline__ unsigned xb_ld(unsigned* p)              { return __hip_atomic_load(p, __ATOMIC_RELAXED, __HIP_MEMORY_SCOPE_AGENT); }
__device__ __forceinline__ unsigned xb_add(unsigned* p, unsigned v) { return __hip_atomic_fetch_add(p, v, __ATOMIC_RELAXED, __HIP_MEMORY_SCOPE_AGENT); }
__device__ __forceinline__ unsigned xb_xcc_id() { return (unsigned)__builtin_amdgcn_s_getreg((3 << 11) | 20) & 0xFu; }
#define XB_SPIN(cond, bar) do { unsigned _sp = 0; while (cond) { __builtin_amdgcn_s_sleep(1); \
    if ((++_sp & 255u) == 0u) { if (xb_ld(&(bar)[XB_TMO])) break; if (_sp > XB_SPIN_CAP) { atomicAdd(&(bar)[XB_TMO], 1u); break; } } } } while (0)

struct XcdBarrier {
    unsigned* bar; unsigned x;
    volatile LAS unsigned* st;
};

__device__ __forceinline__ XcdBarrier xcd_barrier_post(unsigned* bar, volatile LAS unsigned* st) {
    XcdBarrier b; b.bar = bar; b.x = xb_xcc_id(); b.st = st;
    if (threadIdx.x == 0) (void)xb_add(&bar[XB_XCNT(b.x)], 1u);
    return b;
}
__device__ __forceinline__ void xcd_barrier_complete(unsigned* bar, unsigned x, unsigned& nloc, unsigned& nx) {
    const unsigned G = gridDim.x * gridDim.y * gridDim.z;
    unsigned sum, cnt, mine, sp = 0u;
    for (;;) {
        sum = 0u; cnt = 0u; mine = 0u;
#pragma unroll
        for (unsigned j = 0; j < 16; ++j) { const unsigned c = xb_ld(&bar[XB_XCNT(j)]); sum += c; cnt += (c > 0u) ? 1u : 0u; mine = (j == x) ? c : mine; }
        if (sum == G) break;
        __builtin_amdgcn_s_sleep(1);
        if ((++sp & 255u) == 0u) { if (xb_ld(&bar[XB_TMO])) break; if (sp > XB_SPIN_CAP) { atomicAdd(&bar[XB_TMO], 1u); break; } }
    }
    nloc = mine > 0u ? mine : 1u; nx = cnt > 0u ? cnt : 1u;
}

__device__ __forceinline__ void xcd_barrier(const XcdBarrier& b) {
    asm volatile("s_waitcnt vmcnt(0)" ::: "memory");
    __syncthreads();
    if (threadIdx.x == 0) {
        unsigned* bar = b.bar;
        __builtin_amdgcn_s_waitcnt(0);
        unsigned nloc = b.st[0], nx = b.st[1];
        if (nloc == 0u) { xcd_barrier_complete(bar, b.x, nloc, nx); b.st[0] = nloc; b.st[1] = nx; }
        const unsigned old = xb_add(&bar[XB_XSUB(b.x)], 1u);
        const unsigned gen = old / nloc;
        if (old + 1u == (gen + 1u) * nloc) {
            __builtin_amdgcn_fence(__ATOMIC_RELEASE, "agent");
            asm volatile("s_waitcnt vmcnt(0)" ::: "memory");
            const unsigned og = xb_add(&bar[XB_TOP], 1u);
            const unsigned tg = og / nx;
            if (og + 1u == (tg + 1u) * nx) xb_add(&bar[XB_TOPGEN], 1u);
            else XB_SPIN(xb_ld(&bar[XB_TOPGEN]) == tg, bar);
            __builtin_amdgcn_fence(__ATOMIC_ACQUIRE, "agent");
            xb_add(&bar[XB_XGEN(b.x)], 1u);
            asm volatile("s_waitcnt vmcnt(0)" ::: "memory");
        } else {
            XB_SPIN(xb_ld(&bar[XB_XGEN(b.x)]) == gen, bar);
            __builtin_amdgcn_fence(__ATOMIC_ACQUIRE, "agent");
            asm volatile("s_waitcnt vmcnt(0)" ::: "memory");
        }
    }
    __syncthreads();
}
typedef unsigned short bf16_t;
typedef float f32x4 __attribute__((ext_vector_type(4)));
typedef unsigned u32x4 __attribute__((ext_vector_type(4)));
typedef unsigned u32x2 __attribute__((ext_vector_type(2)));
namespace hk {
constexpr int D = 2048, SEQ = 16384, CTXL = 256, TL = 32768, TC = 512, TA = 33280;
constexpr float ALPHA = 1.41421356237309515f;
constexpr float LN_EPS = 1e-6f;
constexpr int NTHREADS = 512;
constexpr int LDS_BYTES = 156 * 1024;
enum { I_X = 0, I_C, I_CTX, I_CCTX, I_RW, I_RB, I_MODW, I_MODB, I_LNG, I_LNB, I_EG, I_EU, I_ED, I_ABIN, I_ABOUT, I_HCW, I_HCB, I_FW1, I_FB1, I_FFR1, I_FW2, I_FB2, I_FFR2, I_FW3, I_HLB,
       I_GW2, I_GB, I_GNG, I_SWIN, I_SCW, I_SCB, I_SDTB, I_SALOG, I_SD, I_SNG, I_SWOUT, N_IN };
constexpr size_t MiB = 1024 * 1024;
constexpr size_t WS_CTL = 0;
constexpr int CW_BAR = 0;
constexpr int CW_CNT = 4096;
constexpr int CW_NT = 4096 + 256;
constexpr int CW_TILEE = 4096 + 512;
constexpr int CW_HYQ = 4096 + 1280;
constexpr int CW_PROBE = 4096 + 1344;
constexpr int CW_CTXF = 4096 + 1408;
constexpr size_t WS_MOD = 64 * 1024;
constexpr size_t WS_CTXS = 384 * 1024;
constexpr size_t WS_MISC = 4608 * 1024;
constexpr size_t MISC_EXP = 0, MISC_GATE = 272 * 1024, MISC_SLOT = 544 * 1024, MISC_DEST = 816 * 1024, MISC_ROWTOK = 1088 * 1024;
constexpr int ROWTOK_N = 70656;
constexpr size_t WS_WOUT1 = 6 * MiB;
constexpr size_t WS_WE = 22 * MiB;
constexpr size_t WS_WE_DN = WS_WE + 128 * MiB;
constexpr size_t WS_R0 = 214 * MiB;
constexpr size_t WS_WU = WS_R0;
constexpr size_t WS_WGLA = WS_R0 + 16 * MiB;
constexpr size_t WS_WOUT0 = WS_R0 + 25 * MiB;
constexpr size_t WS_W3T = WS_R0 + 33 * MiB;
constexpr size_t WS_HID2 = WS_R0 + 35 * MiB;
constexpr size_t WS_HID2C = WS_R0 + 43 * MiB;
constexpr size_t WS_WSSDIN = WS_R0 + 44 * MiB;
constexpr size_t WS_ACT = 299 * MiB;
constexpr size_t A_HA = 0;
constexpr size_t A_UT = 130 * MiB;
constexpr size_t A_GL = 390 * MiB;
constexpr size_t A_HF = 537 * MiB;
constexpr size_t A_HFC = 665 * MiB;
constexpr size_t A_YT = 667 * MiB;
constexpr size_t A_OF = 732 * MiB;
constexpr size_t A_OB = 797 * MiB;
constexpr size_t A_QK = 862 * MiB;
constexpr size_t A_VTG = 325 * MiB;
constexpr size_t A_EB = 992 * MiB;
constexpr size_t A_HYTMP = 1000 * MiB;
constexpr size_t A_HYS = 0;
constexpr size_t A_YO = 130 * MiB;
constexpr size_t A_AG = 260 * MiB;
constexpr size_t A_HB = 536 * MiB;
constexpr size_t A_YR = 0;
constexpr size_t A_HA1 = 700 * MiB;
constexpr size_t A_Z = 0;
constexpr size_t A_XBC = 260 * MiB;
constexpr size_t A_XT = 407 * MiB;
constexpr size_t A_XC = 667 * MiB;
constexpr size_t A_XTG = 797 * MiB;
constexpr size_t A_DT = 1057 * MiB;
constexpr size_t A_YF = 260 * MiB;
constexpr size_t WS_YB = WS_WE;
constexpr size_t A_YO1 = 260 * MiB;
constexpr size_t A_HA2 = 400 * MiB;
constexpr size_t A_AG1 = 530 * MiB;
constexpr size_t A_HB1 = 806 * MiB;
constexpr size_t A_YR1 = 0;
constexpr size_t A_ROWS = 1075 * MiB;
constexpr int ROWS_CAP = 33280;
constexpr size_t WS_NEED = WS_ACT + 1078 * MiB;
constexpr int XBC_LD = 2304, GL_LD = 2304, GL_G = 1024, GL_GK = 2048;
}

struct Params { const float* in[hk::N_IN]; float* out; unsigned char* ws; int ph_lo, ph_hi; };

__device__ __forceinline__ float bf2f(bf16_t v) { return __uint_as_float(((unsigned)v) << 16); }
__device__ __forceinline__ bf16_t f2bf(float f) { unsigned u = __float_as_uint(f); u += 0x7FFFu + ((u >> 16) & 1u); return (bf16_t)(u >> 16); }
typedef __bf16 hw_bf16x2 __attribute__((ext_vector_type(2)));
typedef float hw_f32x2 __attribute__((ext_vector_type(2)));
__device__ __forceinline__ unsigned pk2(float lo, float hi) { const hw_f32x2 f = {lo, hi}; const hw_bf16x2 v = __builtin_convertvector(f, hw_bf16x2); return __builtin_bit_cast(unsigned, v); }
__device__ __forceinline__ float silu_f(float v) { return v * __builtin_amdgcn_rcpf(1.0f + __expf(-v)); }
__device__ __forceinline__ float wave_sum(float v) {
#pragma unroll
    for (int o = 32; o > 0; o >>= 1) v += __shfl_xor(v, o);
    return v;
}
__device__ __forceinline__ void unpack8(const u32x4 w, float (&f)[8]) {
    f[0] = __uint_as_float(w.x << 16); f[1] = __uint_as_float(w.x & 0xFFFF0000u); f[2] = __uint_as_float(w.y << 16); f[3] = __uint_as_float(w.y & 0xFFFF0000u);
    f[4] = __uint_as_float(w.z << 16); f[5] = __uint_as_float(w.z & 0xFFFF0000u); f[6] = __uint_as_float(w.w << 16); f[7] = __uint_as_float(w.w & 0xFFFF0000u);
}
__device__ __forceinline__ int mod_vec(int r) { return r < hk::TL ? (r >> 14) : 2; }
#define MODP(ws, l, mv, k) ((const float*)((ws) + hk::WS_MOD) + ((size_t)((l) * 3 + (mv)) * 6 + (k)) * 2048)
__device__ __forceinline__ void ph_mod(const Params& p, unsigned char* ldsb) {
    float* svec = (float*)ldsb; float* red = svec + 3 * 2048;
    const int tid = threadIdx.x;
    const float* c = p.in[hk::I_C]; const float* cc = p.in[hk::I_CCTX];
    for (int i = tid; i < 3 * 2048; i += 512) { const float v = i < 4096 ? c[i] : cc[i - 4096]; svec[i] = v / (1.0f + expf(-v)); }
    __syncthreads();
    float* MOD = (float*)(p.ws + hk::WS_MOD);
    for (int slab = blockIdx.x; slab < 768; slab += gridDim.x) {
        const int l = slab / 384, j0 = (slab % 384) * 32;
        const float* W = p.in[hk::I_MODW] + (size_t)l * 2048 * 12288;
        const int cq = tid & 7, rg = tid >> 3;
        float acc[3][4];
#pragma unroll
        for (int v = 0; v < 3; ++v)
#pragma unroll
            for (int j = 0; j < 4; ++j) acc[v][j] = 0.f;
#pragma unroll 4
        for (int i = 0; i < 32; ++i) {
            const int r = rg + 64 * i;
            const f32x4 w = *(const f32x4*)(W + (size_t)r * 12288 + j0 + cq * 4);
#pragma unroll
            for (int v = 0; v < 3; ++v) { const float s = svec[v * 2048 + r];
#pragma unroll
                for (int j = 0; j < 4; ++j) acc[v][j] += s * w[j]; }
        }
#pragma unroll
        for (int v = 0; v < 3; ++v)
#pragma unroll
            for (int j = 0; j < 4; ++j) red[tid * 12 + v * 4 + j] = acc[v][j];
        __syncthreads();
        if (tid < 96) {
            const int v = tid >> 5, col = tid & 31, q = col >> 2, j = col & 3;
            float s = 0.f;
            for (int g = 0; g < 64; ++g) s += red[(g * 8 + q) * 12 + v * 4 + j];
            const int jj = j0 + col;
            MOD[(size_t)(l * 3 + v) * 12288 + jj] = s + p.in[hk::I_MODB][l * 12288 + jj];
        }
        __syncthreads();
    }
}

__device__ __forceinline__ void conv_mat(const float* src, int ld, int K, int ncol0, int nvalid, int npad, bf16_t* dst, int Kd, int mode, unsigned char* ldsb) {
    float* tile = (float*)ldsb;
    const int tid = threadIdx.x, nkt = K / 64, ntile = nkt * (npad / 64);
    for (int t = blockIdx.x; t < ntile; t += gridDim.x) {
        const int kt = t % nkt, nt = t / nkt, k0 = kt * 64, n0 = nt * 64;
#pragma unroll
        for (int it = 0; it < 2; ++it) {
            const int r = (tid >> 4) + 32 * it, c4 = (tid & 15) * 4;
            f32x4 v = (f32x4){0.f, 0.f, 0.f, 0.f};
            if (n0 + c4 < nvalid) v = *(const f32x4*)(src + (size_t)(k0 + r) * ld + ncol0 + n0 + c4);
            tile[r * 65 + c4 + 0] = v[0]; tile[r * 65 + c4 + 1] = v[1]; tile[r * 65 + c4 + 2] = v[2]; tile[r * 65 + c4 + 3] = v[3];
        }
        __syncthreads();
        {
            const int n = tid >> 3, kq = tid & 7;
            float f[8];
#pragma unroll
            for (int j = 0; j < 8; ++j) f[j] = tile[(kq * 8 + j) * 65 + n];
            int drow = n0 + n;
            if (mode != 0) drow = 256 * (n0 >> 7) + (n0 & 127) + n + (mode == 2 ? 128 : 0);
            u32x4 w; w.x = pk2(f[0], f[1]); w.y = pk2(f[2], f[3]); w.z = pk2(f[4], f[5]); w.w = pk2(f[6], f[7]);
            *(u32x4*)(dst + (size_t)drow * Kd + k0 + kq * 8) = w;
        }
        __syncthreads();
    }
}
__device__ __forceinline__ void ph_conv_experts(const Params& p, int layer, unsigned char* ldsb) {
    bf16_t* GU = (bf16_t*)(p.ws + hk::WS_WE); bf16_t* DN = (bf16_t*)(p.ws + hk::WS_WE_DN);
    for (int e = 0; e < 16; ++e) {
        const size_t eo = ((size_t)layer * 16 + e) * 2048 * 1024;
        conv_mat(p.in[hk::I_EG] + eo, 1024, 2048, 0, 1024, 1024, GU + (size_t)e * 2048 * 2048, 2048, 1, ldsb);
        conv_mat(p.in[hk::I_EU] + eo, 1024, 2048, 0, 1024, 1024, GU + (size_t)e * 2048 * 2048, 2048, 2, ldsb);
        conv_mat(p.in[hk::I_ED] + eo, 2048, 1024, 0, 2048, 2048, DN + (size_t)e * 2048 * 1024, 1024, 0, ldsb);
    }
}
__device__ __forceinline__ void ph_conv_weights(const Params& p, unsigned char* ldsb) {
    unsigned char* ws = p.ws;
    conv_mat(p.in[hk::I_ABIN], 6176, 2048, 0, 3072, 3072, (bf16_t*)(ws + hk::WS_WU), 2048, 0, ldsb);
    conv_mat(p.in[hk::I_ABIN], 6176, 2048, 3072 + 1024, 1024, 1024, (bf16_t*)(ws + hk::WS_WU) + (size_t)3072 * 2048, 2048, 0, ldsb);
    conv_mat(p.in[hk::I_ABIN], 6176, 2048, 3072, 1024, 1024, (bf16_t*)(ws + hk::WS_WGLA), 2048, 0, ldsb);
    conv_mat(p.in[hk::I_ABIN], 6176, 2048, 3072 + 2048, 1056, 1280, (bf16_t*)(ws + hk::WS_WGLA) + (size_t)1024 * 2048, 2048, 0, ldsb);
    conv_mat(p.in[hk::I_ABOUT], 2048, 2048, 0, 2048, 2048, (bf16_t*)(ws + hk::WS_WOUT0), 2048, 0, ldsb);
    conv_mat(p.in[hk::I_SWIN], 10368, 2048, 4096, 4096, 4096, (bf16_t*)(ws + hk::WS_WSSDIN), 2048, 0, ldsb);
    conv_mat(p.in[hk::I_SWIN], 10368, 2048, 0, 4096, 4096, (bf16_t*)(ws + hk::WS_WSSDIN) + (size_t)4096 * 2048, 2048, 0, ldsb);
    conv_mat(p.in[hk::I_SWIN], 10368, 2048, 8192, 2176, 2304, (bf16_t*)(ws + hk::WS_WSSDIN) + (size_t)8192 * 2048, 2048, 0, ldsb);
    conv_mat(p.in[hk::I_SWOUT], 2048, 4096, 0, 2048, 2048, (bf16_t*)(ws + hk::WS_WOUT1), 4096, 0, ldsb);
    bf16_t* W3T = (bf16_t*)(ws + hk::WS_W3T); const float* w3 = p.in[hk::I_FW3];
    for (int i = blockIdx.x * 512 + threadIdx.x; i < 4096 * 32; i += gridDim.x * 512) {
        const int col = i >> 5, k8 = (i & 31) * 8;
        u32x4 w = (u32x4){0u, 0u, 0u, 0u};
        if (k8 < 64) { float f[8];
#pragma unroll
            for (int j = 0; j < 8; ++j) f[j] = w3[(size_t)(k8 + j) * 4096 + col];
            w.x = pk2(f[0], f[1]); w.y = pk2(f[2], f[3]); w.z = pk2(f[4], f[5]); w.w = pk2(f[6], f[7]); }
        *(u32x4*)(W3T + (size_t)col * 256 + k8) = w;
    }
}
__device__ __forceinline__ void ph_hid(const Params& p, unsigned char* ldsb) {
    float* w1 = (float*)ldsb; float* b1 = w1 + 33 * 64; float* fr1 = b1 + 64; float* w2 = fr1 + 64; float* b2 = w2 + 64 * 64; float* fr2 = b2 + 64; float* h1 = fr2 + 64;
    const int tid = threadIdx.x;
    for (int i = tid; i < 33 * 64; i += 512) w1[i] = p.in[hk::I_FW1][i];
    for (int i = tid; i < 64 * 64; i += 512) w2[i] = p.in[hk::I_FW2][i];
    if (tid < 64) { b1[tid] = p.in[hk::I_FB1][tid]; fr1[tid] = p.in[hk::I_FFR1][tid]; b2[tid] = p.in[hk::I_FB2][tid]; fr2[tid] = p.in[hk::I_FFR2][tid]; }
    __syncthreads();
    const int j = tid & 63, pl = tid >> 6;
    bf16_t* HID2 = (bf16_t*)(p.ws + hk::WS_HID2); bf16_t* HID2C = (bf16_t*)(p.ws + hk::WS_HID2C);
    for (int pg = blockIdx.x; pg < (16384 + 256) / 8; pg += gridDim.x) {
        const int pid = pg * 8 + pl;
        const bool lat = pid < 16384; const int L = lat ? 16384 : 256, pos = lat ? pid : pid - 16384;
        const float t = (float)pos / (float)(L - 1);
        float s = b1[j] + t * w1[j];
        for (int b = 0; b < 16; ++b) {
            const float band = 1e-4f + (float)b * ((15.0f - 1e-4f) / 15.0f);
            float turns = band * (float)pos / (float)L; turns -= floorf(turns);
            const float ang = 6.283185307179586f * turns;
            s += cosf(ang) * w1[(1 + b) * 64 + j] - sinf(ang) * w1[(17 + b) * 64 + j];
        }
        h1[pl * 64 + j] = sinf(fr1[j] * s);
        __syncthreads();
        float s2 = b2[j];
        for (int i = 0; i < 64; ++i) s2 += h1[pl * 64 + i] * w2[i * 64 + j];
        const float v = sinf(fr2[j] * s2);
        bf16_t* row = (lat ? HID2 : HID2C) + (size_t)pos * 256;
        row[j] = f2bf(v); row[64 + j] = 0; row[128 + j] = 0; row[192 + j] = 0;
        __syncthreads();
    }
}
__device__ __forceinline__ void ph_modulate0(const Params& p, unsigned char* ldsb) {
    const int lane = threadIdx.x & 63, wave = threadIdx.x >> 6;
    bf16_t* HA = (bf16_t*)(p.ws + hk::WS_ACT + hk::A_HA);
    float* Lv = (float*)ldsb;
    { int t0 = threadIdx.x; asm volatile("" : "+v"(t0));
      for (int vct = 0; vct < 6; ++vct) *(f32x4*)(Lv + vct * 2048 + t0 * 4) = *(const f32x4*)(MODP(p.ws, 0, vct % 3, vct / 3) + t0 * 4);
      __syncthreads(); }
    for (int r = blockIdx.x * 8 + wave; r < hk::TA; r += gridDim.x * 8) {
        const int mv = mod_vec(r);
        const float* xin = r < hk::TL ? p.in[hk::I_X] + (size_t)r * 2048 : p.in[hk::I_CTX] + (size_t)(r - hk::TL) * 2048;
        const float* sh = Lv + mv * 2048; const float* sc = Lv + (3 + mv) * 2048;
#pragma unroll
        for (int i = 0; i < 8; ++i) {
            const int j = 4 * (lane + 64 * i);
            const f32x4 x = *(const f32x4*)(xin + j), a = *(const f32x4*)(sc + j), b = *(const f32x4*)(sh + j);
            u32x2 w; w.x = pk2(x[0] * (1.f + a[0]) + b[0], x[1] * (1.f + a[1]) + b[1]); w.y = pk2(x[2] * (1.f + a[2]) + b[2], x[3] * (1.f + a[3]) + b[3]);
            *(u32x2*)(HA + (size_t)r * 2048 + j) = w;
        }
    }
}

__device__ __forceinline__ void ph_ln1_router(const Params& p, int layer, unsigned char* ldsb, const bf16_t* YO, bf16_t* TOK) {
    float* rwT = (float*)ldsb; int* lcnt = (int*)(ldsb + 131072); int* lbase = lcnt + 16;
    const int tid = threadIdx.x, lane = tid & 63, wave = __builtin_amdgcn_readfirstlane(tid >> 6);
    const int T = layer == 0 ? hk::TA : hk::TL;
    for (int i = tid; i < 2048 * 16; i += 512) { const int j = i >> 4, e = i & 15; rwT[e * 2048 + j] = p.in[hk::I_RW][i]; }
    if (tid < 16) lcnt[tid] = 0;
    __syncthreads();
    float* CTXS = (float*)(p.ws + hk::WS_CTXS); int* ROWS = (int*)(p.ws + hk::WS_ACT + hk::A_ROWS);
    int* EXPERT = (int*)(p.ws + hk::WS_MISC + hk::MISC_EXP); float* GATE = (float*)(p.ws + hk::WS_MISC + hk::MISC_GATE); int* SLOT = (int*)(p.ws + hk::WS_MISC + hk::MISC_SLOT);
    const float* lng = p.in[hk::I_LNG] + (size_t)(layer * 2 + 0) * 2048; const float* lnb = p.in[hk::I_LNB] + (size_t)(layer * 2 + 0) * 2048;
    const float* rb = p.in[hk::I_RB];
    const bool deal0 = layer == 0 && gridDim.x == 256;
    const int nrnd = deal0 ? 17 : (T + (int)gridDim.x * 8 - 1) / ((int)gridDim.x * 8);
    auto row_at = [&](int kk) -> int {
        const int b = (int)blockIdx.x;
        if (!deal0) { const int r = b * 8 + wave + kk * (int)gridDim.x * 8; return r < T ? r : -1; }
        if (kk < 16) return (b >= 240 && kk < 4) ? -1 : b * 8 + wave + kk * 2048;
        if (b < 64) return hk::TL + b * 8 + wave;
        if (b < 128) { const int e = (b - 64) * 8 + wave, k4 = e >> 7, rem = e & 127; return (240 + (rem >> 3)) * 8 + (rem & 7) + k4 * 2048; }
        return -1;
    };
    for (int kk = 0; kk < nrnd; ++kk) {
        const int r = row_at(kk); if (r < 0) continue;
        if (deal0 && kk == 16 && blockIdx.x < 64) {
            const unsigned* fl = (const unsigned*)(p.ws + hk::WS_CTL) + hk::CW_CTXF; unsigned sp = 0u;
            while (__hip_atomic_load(fl, __ATOMIC_RELAXED, __HIP_MEMORY_SCOPE_AGENT) < 16u && ++sp < (1u << 22)) __builtin_amdgcn_s_sleep(2);
            __builtin_amdgcn_fence(__ATOMIC_ACQUIRE, "agent");
        }
        const int mv = mod_vec(r);
        const float* xin; float* xout;
        if (r < hk::TL) { xin = (layer == 0 ? p.in[hk::I_X] : p.out) + (size_t)r * 2048; xout = p.out + (size_t)r * 2048; }
        else { xin = (layer == 0 ? p.in[hk::I_CTX] : CTXS) + (size_t)(r - hk::TL) * 2048; xout = CTXS + (size_t)(r - hk::TL) * 2048; }
        const float* g1 = MODP(p.ws, layer, mv, 2); const float* sh2 = MODP(p.ws, layer, mv, 3); const float* sc2 = MODP(p.ws, layer, mv, 4);
        float sum = 0.f, sq = 0.f;
        f32x4 v[8];
#pragma unroll
        for (int hh = 0; hh < 2; ++hh) {   f32x4 xr[4], gr[4]; u32x2 yr[4];
#pragma unroll
            for (int i = 0; i < 4; ++i) { const int j = 4 * (lane + 64 * (4 * hh + i)); xr[i] = *(const f32x4*)(xin + j); yr[i] = *(const u32x2*)(YO + (size_t)r * 2048 + j); gr[i] = *(const f32x4*)(g1 + j); }
#pragma unroll
            for (int i = 0; i < 4; ++i) {
                const float y0 = __uint_as_float(yr[i].x << 16), y1 = __uint_as_float(yr[i].x & 0xFFFF0000u), y2 = __uint_as_float(yr[i].y << 16), y3 = __uint_as_float(yr[i].y & 0xFFFF0000u);
                const f32x4 t = (f32x4){hk::ALPHA * xr[i][0] + gr[i][0] * y0, hk::ALPHA * xr[i][1] + gr[i][1] * y1, hk::ALPHA * xr[i][2] + gr[i][2] * y2, hk::ALPHA * xr[i][3] + gr[i][3] * y3};
                v[4 * hh + i] = t;
                sum += (t[0] + t[1]) + (t[2] + t[3]); sq += (t[0] * t[0] + t[1] * t[1]) + (t[2] * t[2] + t[3] * t[3]);
            }
            asm volatile("" ::: "memory");
        }
        const float mean = wave_sum(sum) * (1.0f / 2048.0f);
        const float var = fmaxf(wave_sum(sq) * (1.0f / 2048.0f) - mean * mean, 0.f);
        const float rstd = rsqrtf(var + hk::LN_EPS);
        float lg[16];
#pragma unroll
        for (int e = 0; e < 16; ++e) lg[e] = 0.f;
        f32x4 ng = *(const f32x4*)(lng + 4 * lane), nb = *(const f32x4*)(lnb + 4 * lane), na2 = *(const f32x4*)(sc2 + 4 * lane), nb2 = *(const f32x4*)(sh2 + 4 * lane);
#pragma unroll
        for (int i = 0; i < 8; ++i) {
            const int j = 4 * (lane + 64 * i);
            const f32x4 g = ng, b = nb, a2 = na2, b2 = nb2;
            if (i < 7) { const int jn = j + 256; ng = *(const f32x4*)(lng + jn); nb = *(const f32x4*)(lnb + jn); na2 = *(const f32x4*)(sc2 + jn); nb2 = *(const f32x4*)(sh2 + jn); }
            asm volatile("" ::: "memory");
            f32x4 xn, tk;
#pragma unroll
            for (int q = 0; q < 4; ++q) { xn[q] = (v[i][q] - mean) * rstd * g[q] + b[q]; tk[q] = xn[q] * (1.f + a2[q]) + b2[q]; }
            *(f32x4*)(xout + j) = xn;
            u32x2 w; w.x = pk2(tk[0], tk[1]); w.y = pk2(tk[2], tk[3]);
            *(u32x2*)(TOK + (size_t)r * 2048 + j) = w;
#pragma unroll
            for (int e = 0; e < 16; ++e) { const f32x4 rw = *(const f32x4*)(rwT + e * 2048 + j); lg[e] += (tk[0] * rw[0] + tk[1] * rw[1]) + (tk[2] * rw[2] + tk[3] * rw[3]); }
            asm volatile("" ::: "memory");
        }
        float a8[8], a4[4], a2[2], tot;
        { const bool u = (lane & 32) != 0;
#pragma unroll
          for (int k = 0; k < 8; ++k) { const float send = u ? lg[k] : lg[8 + k], keep = u ? lg[8 + k] : lg[k]; a8[k] = keep + __shfl_xor(send, 32); } }
        { const bool u = (lane & 16) != 0;
#pragma unroll
          for (int k = 0; k < 4; ++k) { const float send = u ? a8[k] : a8[4 + k], keep = u ? a8[4 + k] : a8[k]; a4[k] = keep + __shfl_xor(send, 16); } }
        { const bool u = (lane & 8) != 0;
#pragma unroll
          for (int k = 0; k < 2; ++k) { const float send = u ? a4[k] : a4[2 + k], keep = u ? a4[2 + k] : a4[k]; a2[k] = keep + __shfl_xor(send, 8); } }
        { const bool u = (lane & 4) != 0; const float send = u ? a2[0] : a2[1], keep = u ? a2[1] : a2[0]; tot = keep + __shfl_xor(send, 4); }
        tot += __shfl_xor(tot, 2); tot += __shfl_xor(tot, 1);
        const float scE = __builtin_amdgcn_rcpf(1.0f + __expf(-tot)), selE = scE + rb[(lane >> 2) & 15];
        const int gl = lane & 48;
        const float s4[4] = {__shfl(selE, gl), __shfl(selE, gl + 4), __shfl(selE, gl + 8), __shfl(selE, gl + 12)};
        const float u4[4] = {__shfl(scE, gl), __shfl(scE, gl + 4), __shfl(scE, gl + 8), __shfl(scE, gl + 12)};
        float m1 = -1e30f, m2 = -1e30f;
#pragma unroll
        for (int q = 0; q < 4; ++q) { const float s = s4[q]; if (s > m1) { m2 = m1; m1 = s; } else if (s > m2) m2 = s; }
        const float gs = m1 + m2;
        int li1 = 0; float b1 = s4[0];
#pragma unroll
        for (int q = 1; q < 4; ++q) if (s4[q] > b1) { b1 = s4[q]; li1 = q; }
        int li2 = -1; float b2v = -1e30f;
#pragma unroll
        for (int q = 0; q < 4; ++q) if (q != li1 && s4[q] > b2v) { b2v = s4[q]; li2 = q; }
        const float lga = li1 == 0 ? u4[0] : li1 == 1 ? u4[1] : li1 == 2 ? u4[2] : u4[3];
        const float lgb = li2 == 0 ? u4[0] : li2 == 1 ? u4[1] : li2 == 2 ? u4[2] : u4[3];
        const float g4[4] = {__shfl(gs, 0), __shfl(gs, 16), __shfl(gs, 32), __shfl(gs, 48)};
        int grp = 0; float best = g4[0];
#pragma unroll
        for (int g = 1; g < 4; ++g) if (g4[g] > best) { best = g4[g]; grp = g; }
        const int i1 = __shfl(li1, 16 * grp), i2 = __shfl(li2, 16 * grp);
        const float ga = __shfl(lga, 16 * grp), gb = __shfl(lgb, 16 * grp);
        const float inv = __builtin_amdgcn_rcpf(ga + gb);
        if (lane == 0) {
            const int e1 = grp * 4 + i1, e2 = grp * 4 + i2;
            const int s1 = atomicAdd(&lcnt[e1], 1), s2 = atomicAdd(&lcnt[e2], 1);
            EXPERT[2 * r] = e1; EXPERT[2 * r + 1] = e2; GATE[2 * r] = ga * inv; GATE[2 * r + 1] = gb * inv; SLOT[2 * r] = s1; SLOT[2 * r + 1] = s2;
        }
    }
    __syncthreads();
    unsigned* gcnt = (unsigned*)(p.ws + hk::WS_CTL) + hk::CW_CNT + layer * 64;
    if (tid < 16) lbase[tid] = (int)atomicAdd(&gcnt[tid], (unsigned)lcnt[tid]);
    __syncthreads();
    for (int kk = 0; kk < nrnd; ++kk) {
        const int r = row_at(kk); if (r < 0) continue;
        if (lane == 0) {
            const int e1 = EXPERT[2 * r], e2 = EXPERT[2 * r + 1], s1 = SLOT[2 * r] + lbase[e1], s2 = SLOT[2 * r + 1] + lbase[e2];
            SLOT[2 * r] = s1; SLOT[2 * r + 1] = s2; ROWS[e1 * hk::ROWS_CAP + s1] = r; ROWS[e2 * hk::ROWS_CAP + s2] = r; }
    }
}

__device__ __forceinline__ void expert_starts(const unsigned* gcnt, int (&pstart)[17]) {
    int acc = 0;
#pragma unroll
    for (int e = 0; e < 16; ++e) { pstart[e] = acc; acc += (int)((__hip_atomic_load(gcnt + e, __ATOMIC_RELAXED, __HIP_MEMORY_SCOPE_AGENT) + 255u) & ~255u); }
    pstart[16] = acc;
}
__device__ __forceinline__ void ph_dispatch(const Params& p, int layer, const bf16_t* TOK, bf16_t* AG) {
    const int tid = threadIdx.x, lane = tid & 63, wave = tid >> 6;
    const int T = layer == 0 ? hk::TA : hk::TL;
    unsigned* ctl = (unsigned*)(p.ws + hk::WS_CTL);
    int pstart[17]; expert_starts(ctl + hk::CW_CNT + layer * 64, pstart);
    if (blockIdx.x == 0) {
        const int nt = pstart[16] >> 8;
        if (tid == 0) ctl[hk::CW_NT + layer * 64] = (unsigned)nt;
        for (int rt = tid; rt < nt; rt += 512) { int e = 0;
#pragma unroll
            for (int q = 1; q < 16; ++q) if (rt * 256 >= pstart[q]) e = q;
            ctl[hk::CW_TILEE + layer * 320 + rt] = (unsigned)e; }
    }
    const int* EXPERT = (const int*)(p.ws + hk::WS_MISC + hk::MISC_EXP); const int* SLOT = (const int*)(p.ws + hk::WS_MISC + hk::MISC_SLOT); int* DEST = (int*)(p.ws + hk::WS_MISC + hk::MISC_DEST); int* ROWTOK = (int*)(p.ws + hk::WS_MISC + hk::MISC_ROWTOK);
    (void)lane; (void)wave; (void)TOK; (void)AG;
    for (int r = blockIdx.x * 512 + tid; r < T; r += gridDim.x * 512) {
#pragma unroll
        for (int k = 0; k < 2; ++k) {
            const int e = EXPERT[2 * r + k], s = SLOT[2 * r + k];
            int ps = 0;
#pragma unroll
            for (int q = 0; q < 16; ++q) ps = (e == q) ? pstart[q] : ps;
            const int d = ps + s;
            DEST[2 * r + k] = d; ROWTOK[d] = r;
        }
    }
}

__device__ __forceinline__ void ph_ln2(const Params& p, int layer, const bf16_t* YR, bf16_t* HNEXT, unsigned char* ldsb) {
    const int lane = threadIdx.x & 63, wave = __builtin_amdgcn_readfirstlane(threadIdx.x >> 6);
    const int T = layer == 0 ? hk::TA : hk::TL;
    if (layer == 0) { int* ROWS = (int*)(p.ws + hk::WS_ACT + hk::A_ROWS);
        for (int i = blockIdx.x * 512 + threadIdx.x; i < 16 * hk::ROWS_CAP; i += gridDim.x * 512) ROWS[i] = 0; }
    int pstart[17]; expert_starts((const unsigned*)(p.ws + hk::WS_CTL) + hk::CW_CNT + layer * 64, pstart);
#pragma unroll
    for (int q = 0; q < 17; ++q) pstart[q] = __builtin_amdgcn_readfirstlane(pstart[q]);
    float* CTXS = (float*)(p.ws + hk::WS_CTXS);
    const int* EXPERT = (const int*)(p.ws + hk::WS_MISC + hk::MISC_EXP); const int* SLOT = (const int*)(p.ws + hk::WS_MISC + hk::MISC_SLOT); const float* GATE = (const float*)(p.ws + hk::WS_MISC + hk::MISC_GATE);
    const float* lng = p.in[hk::I_LNG] + (size_t)(layer * 2 + 1) * 2048; const float* lnb = p.in[hk::I_LNB] + (size_t)(layer * 2 + 1) * 2048;
    float* Lv = (float*)ldsb;
    { const int nvec = layer == 0 ? 11 : 5; int t0 = threadIdx.x; asm volatile("" : "+v"(t0));
      for (int vct = 0; vct < nvec; ++vct) { const int j = t0 * 4;
          const float* src = vct == 0 ? lng : vct == 1 ? lnb : vct < 5 ? MODP(p.ws, layer, vct - 2, 5) : vct < 8 ? MODP(p.ws, 1, vct - 5, 1) : MODP(p.ws, 1, vct - 8, 0);
          *(f32x4*)(Lv + vct * 2048 + j) = *(const f32x4*)(src + j); }
      __syncthreads(); }
    for (int r = blockIdx.x * 8 + wave; r < T; r += gridDim.x * 8) {
        const int mv = mod_vec(r);
        float* xio = r < hk::TL ? p.out + (size_t)r * 2048 : CTXS + (size_t)(r - hk::TL) * 2048;
        const float* g2 = Lv + (2 + mv) * 2048;
        const int ea = __builtin_amdgcn_readfirstlane(EXPERT[2 * r]), eb = __builtin_amdgcn_readfirstlane(EXPERT[2 * r + 1]); int pa = 0, pb = 0;
#pragma unroll
        for (int q = 0; q < 16; ++q) { pa = ea == q ? pstart[q] : pa; pb = eb == q ? pstart[q] : pb; }
        const int d0 = pa + __builtin_amdgcn_readfirstlane(SLOT[2 * r]), d1 = pb + __builtin_amdgcn_readfirstlane(SLOT[2 * r + 1]);
        const float w0 = __int_as_float(__builtin_amdgcn_readfirstlane(__float_as_int(GATE[2 * r]))), w1 = __int_as_float(__builtin_amdgcn_readfirstlane(__float_as_int(GATE[2 * r + 1])));
        float v[32]; float sum = 0.f;
#pragma unroll
        for (int i = 0; i < 8; ++i) {
            const int j = 4 * (lane + 64 * i);
            const f32x4 x = *(const f32x4*)(xio + j), g = *(const f32x4*)(g2 + j);
            const u32x2 ya = *(const u32x2*)(YR + (size_t)d0 * 2048 + j), yb = *(const u32x2*)(YR + (size_t)d1 * 2048 + j);
            float y[4];
            y[0] = w0 * __uint_as_float(ya.x << 16) + w1 * __uint_as_float(yb.x << 16); y[1] = w0 * __uint_as_float(ya.x & 0xFFFF0000u) + w1 * __uint_as_float(yb.x & 0xFFFF0000u);
            y[2] = w0 * __uint_as_float(ya.y << 16) + w1 * __uint_as_float(yb.y << 16); y[3] = w0 * __uint_as_float(ya.y & 0xFFFF0000u) + w1 * __uint_as_float(yb.y & 0xFFFF0000u);
#pragma unroll
            for (int q = 0; q < 4; ++q) { v[4 * i + q] = hk::ALPHA * x[q] + g[q] * y[q]; sum += v[4 * i + q]; }
        }
        const float mean = wave_sum(sum) * (1.0f / 2048.0f);
        float sq = 0.f;
#pragma unroll
        for (int k = 0; k < 32; ++k) { const float d = v[k] - mean; sq += d * d; }
        const float rstd = rsqrtf(wave_sum(sq) * (1.0f / 2048.0f) + hk::LN_EPS);
        const float* sh = Lv + (8 + mv) * 2048; const float* sc = Lv + (5 + mv) * 2048;
#pragma unroll
        for (int i = 0; i < 8; ++i) {
            const int j = 4 * (lane + 64 * i);
            const f32x4 g = *(const f32x4*)(Lv + j), b = *(const f32x4*)(Lv + 2048 + j);
            f32x4 xn;
#pragma unroll
            for (int q = 0; q < 4; ++q) xn[q] = (v[4 * i + q] - mean) * rstd * g[q] + b[q];
#if PROBE_STAMP || defined(PROBE_PHASE)
            if (layer == 1 && r == 0 && i == 0 && lane == 0) { const float fr = ((const float*)(p.ws + hk::WS_CTL))[hk::CW_PROBE]; xn[0] += sqrtf((1e-4f + 8e-4f * fr) * 6.72e7f); }
#endif
            *(f32x4*)(xio + j) = xn;
            if (layer == 0) {
                const f32x4 a = *(const f32x4*)(sc + j), bb = *(const f32x4*)(sh + j);
                u32x2 w; w.x = pk2(xn[0] * (1.f + a[0]) + bb[0], xn[1] * (1.f + a[1]) + bb[1]); w.y = pk2(xn[2] * (1.f + a[2]) + bb[2], xn[3] * (1.f + a[3]) + bb[3]);
                *(u32x2*)(HNEXT + (size_t)r * 2048 + j) = w;
            }
            asm volatile("" ::: "memory");
        }
    }
}
__device__ __forceinline__ void ph_gla_scan_naive(const Params& p, unsigned char* ldsb) {
    float* w2s = (float*)ldsb;
    float* bs = w2s + 16 * 128;
    float* qs = bs + 128;
    float* ks = qs + 32 * 128; float* as = ks + 32 * 128;
    float* vv = as + 32 * 128;
    float* part = vv + 32 * 16;
    const int tid = threadIdx.x, lane = tid & 63, wave = tid >> 6;
    const bf16_t* GL = (const bf16_t*)(p.ws + hk::WS_ACT + hk::A_GL);
    for (int it = blockIdx.x; it < 256; it += gridDim.x) {
        const int b = it >> 7, dir = (it >> 6) & 1, h = (it >> 4) & 3, vs = it & 15;
        bf16_t* OUT = (bf16_t*)(p.ws + hk::WS_ACT + (dir == 0 ? hk::A_OF : hk::A_OB));
        __syncthreads();
        for (int i = tid; i < 16 * 128; i += 512) { const int r = i >> 7, kk = i & 127; w2s[i] = p.in[hk::I_GW2][(size_t)(dir * 16 + r) * 512 + h * 128 + kk]; }
        if (tid < 128) bs[tid] = p.in[hk::I_GB][dir * 512 + h * 128 + tid];
        __syncthreads();
        const int v = tid & 15, kg = tid >> 4;
        float S[4] = {0.f, 0.f, 0.f, 0.f};
        for (int seg = 0; seg < 2; ++seg) {
            const int n = seg == 0 ? hk::CTXL : hk::SEQ, rowbase = seg == 0 ? hk::TL + b * hk::CTXL : b * hk::SEQ;
            for (int t0 = 0; t0 < n; t0 += 32) {
                for (int idx = tid; idx < 32 * 128; idx += 512) {
                    const int s = idx >> 7, kk = idx & 127, tt = t0 + s, t = dir == 0 ? tt : n - 1 - tt;
                    const bf16_t* row = GL + (size_t)(rowbase + t) * hk::GL_LD;
                    qs[idx] = bf2f(row[h * 128 + kk]) * 0.08838834764831845f;
                    ks[idx] = bf2f(row[512 + h * 128 + kk]);
                    float z = bs[kk];
#pragma unroll
                    for (int r = 0; r < 16; ++r) z += bf2f(row[hk::GL_GK + dir * 16 + r]) * w2s[r * 128 + kk];
                    const float ls = z >= 0.f ? -log1pf(expf(-z)) : z - log1pf(expf(z));
                    as[idx] = expf(ls * (1.0f / 16.0f));
                }
                { const int s = tid >> 4, tt = t0 + s, t = dir == 0 ? tt : n - 1 - tt;
                  vv[tid] = bf2f(((const bf16_t*)(p.ws + hk::WS_ACT + hk::A_VTG))[(size_t)(h * 256 + vs * 16 + v) * hk::TA + rowbase + t]); }
                __syncthreads();
#pragma unroll 4
                for (int s = 0; s < 32; ++s) {
                    const f32x4 a4 = *(const f32x4*)(as + s * 128 + kg * 4), k4 = *(const f32x4*)(ks + s * 128 + kg * 4), q4 = *(const f32x4*)(qs + s * 128 + kg * 4);
                    const float vval = vv[s * 16 + v];
                    float o = 0.f;
#pragma unroll
                    for (int i = 0; i < 4; ++i) { S[i] = a4[i] * S[i] + k4[i] * vval; o += q4[i] * S[i]; }
                    o += __shfl_xor(o, 16); o += __shfl_xor(o, 32);
                    if (lane < 16) part[(s * 8 + wave) * 16 + lane] = o;
                }
                __syncthreads();
                { const int s = tid >> 4, tt = t0 + s, t = dir == 0 ? tt : n - 1 - tt;
                  float o = 0.f;
#pragma unroll
                  for (int w = 0; w < 8; ++w) o += part[(s * 8 + w) * 16 + v];
                  OUT[(size_t)(rowbase + t) * 1024 + h * 256 + vs * 16 + v] = f2bf(o); }
                __syncthreads();
            }
        }
    }
}
__device__ __forceinline__ void ph_mix_finish(const Params& p, unsigned char* ldsb) {
    const int tid = threadIdx.x, lane = tid & 63, wave = tid >> 6;
    const bf16_t* OF = (const bf16_t*)(p.ws + hk::WS_ACT + hk::A_OF); const bf16_t* OB = (const bf16_t*)(p.ws + hk::WS_ACT + hk::A_OB);
    const bf16_t* GL = (const bf16_t*)(p.ws + hk::WS_ACT + hk::A_GL);
    bf16_t* MIX = (bf16_t*)(p.ws + hk::WS_ACT + hk::A_HA);
    const float* ng = p.in[hk::I_GNG];
    for (int r = blockIdx.x * 8 + wave; r < hk::TA; r += gridDim.x * 8) {
        float o[16]; float ss = 0.f;
#pragma unroll
        for (int i = 0; i < 2; ++i) {
            float a[8], bq[8]; unpack8(*(const u32x4*)(OF + (size_t)r * 1024 + lane * 16 + 8 * i), a); unpack8(*(const u32x4*)(OB + (size_t)r * 1024 + lane * 16 + 8 * i), bq);
#pragma unroll
            for (int q = 0; q < 8; ++q) { o[8 * i + q] = a[q] + bq[q]; ss += o[8 * i + q] * o[8 * i + q]; }
        }
        ss += __shfl_xor(ss, 1); ss += __shfl_xor(ss, 2); ss += __shfl_xor(ss, 4); ss += __shfl_xor(ss, 8);
        const float rs = rsqrtf(ss * (1.0f / 256.0f) + hk::LN_EPS);
        const u32x4 r0 = *(const u32x4*)(GL + (size_t)r * hk::GL_LD + hk::GL_G + lane * 16), r1 = *(const u32x4*)(GL + (size_t)r * hk::GL_LD + hk::GL_G + lane * 16 + 8);
        float rr[16]; { float t8[8]; unpack8(r0, t8);
#pragma unroll
            for (int q = 0; q < 8; ++q) rr[q] = t8[q]; unpack8(r1, t8);
#pragma unroll
            for (int q = 0; q < 8; ++q) rr[8 + q] = t8[q]; }
        float f[16];
#pragma unroll
        for (int q = 0; q < 16; ++q) f[q] = o[q] * rs * ng[lane * 16 + q] * silu_f(rr[q]);
        u32x4 w0, w1; w0.x = pk2(f[0], f[1]); w0.y = pk2(f[2], f[3]); w0.z = pk2(f[4], f[5]); w0.w = pk2(f[6], f[7]); w1.x = pk2(f[8], f[9]); w1.y = pk2(f[10], f[11]); w1.z = pk2(f[12], f[13]); w1.w = pk2(f[14], f[15]);
        *(u32x4*)(MIX + (size_t)r * 2048 + 1024 + lane * 16) = w0; *(u32x4*)(MIX + (size_t)r * 2048 + 1024 + lane * 16 + 8) = w1;
    }
    const bf16_t* YT = (const bf16_t*)(p.ws + hk::WS_ACT + hk::A_YT);
    bf16_t* tile = (bf16_t*)ldsb;
    __syncthreads();
    for (int t = blockIdx.x; t < 16 * (hk::TA / 64); t += gridDim.x) {
        const int ct = t & 15, tt = t >> 4, c0 = ct * 64, tok0 = tt * 64;
        { const int c = tid >> 3, q = tid & 7;
          const u32x4 w = *(const u32x4*)(YT + (size_t)(c0 + c) * hk::TA + tok0 + q * 8);
          unsigned* dstw = (unsigned*)(tile + c * 66 + q * 8);
          dstw[0] = w.x; dstw[1] = w.y; dstw[2] = w.z; dstw[3] = w.w; }
        __syncthreads();
        { const int tk = tid >> 3, q = tid & 7;
          bf16_t e[8];
#pragma unroll
          for (int j = 0; j < 8; ++j) e[j] = tile[(q * 8 + j) * 66 + tk];
          u32x4 w; w.x = e[0] | ((unsigned)e[1] << 16); w.y = e[2] | ((unsigned)e[3] << 16); w.z = e[4] | ((unsigned)e[5] << 16); w.w = e[6] | ((unsigned)e[7] << 16);
          *(u32x4*)(MIX + (size_t)(tok0 + tk) * 2048 + c0 + q * 8) = w; }
        __syncthreads();
    }
}
namespace hy {
constexpr int PADF = 1024, L = 16384;
__device__ __forceinline__ float sconv(const bf16_t* row, int t, int n, float w0, float w1, float w2, float bias) {
    const float a = t > 0 ? bf2f(row[t - 1]) : 0.f, b = bf2f(row[t]), c = t + 1 < n ? bf2f(row[t + 1]) : 0.f;
    return w0 * a + w1 * b + w2 * c + bias;
}
template <int SGN> __device__ __forceinline__ void lconv8(const float* u, const bf16_t* f, int t0, int trips, float (&acc)[8]) {
    float W[16];
    if (SGN > 0) {
#pragma unroll
        for (int x = 0; x < 8; ++x) W[8 + x] = u[PADF + t0 + x];
        for (int it = 0; it < trips; ++it) {
            const int d0 = it * 8;
            const f32x4 lo0 = *(const f32x4*)(u + PADF + t0 - d0 - 8), lo1 = *(const f32x4*)(u + PADF + t0 - d0 - 4);
            W[0] = lo0[0]; W[1] = lo0[1]; W[2] = lo0[2]; W[3] = lo0[3]; W[4] = lo1[0]; W[5] = lo1[1]; W[6] = lo1[2]; W[7] = lo1[3];
            float fe[8]; unpack8(*(const u32x4*)(f + d0), fe);
#pragma unroll
            for (int e = 0; e < 8; ++e)
#pragma unroll
                for (int i = 0; i < 8; ++i) acc[i] += fe[e] * W[8 + i - e];
#pragma unroll
            for (int x = 0; x < 8; ++x) W[8 + x] = W[x];
        }
    } else {
#pragma unroll
        for (int x = 0; x < 8; ++x) W[x] = u[PADF + t0 + x];
        for (int it = 0; it < trips; ++it) {
            const int d0 = it * 8;
            const f32x4 hi0 = *(const f32x4*)(u + PADF + t0 + d0 + 8), hi1 = *(const f32x4*)(u + PADF + t0 + d0 + 12);
            W[8] = hi0[0]; W[9] = hi0[1]; W[10] = hi0[2]; W[11] = hi0[3]; W[12] = hi1[0]; W[13] = hi1[1]; W[14] = hi1[2]; W[15] = hi1[3];
            float fe[8]; unpack8(*(const u32x4*)(f + d0), fe);
#pragma unroll
            for (int e = 0; e < 8; ++e)
#pragma unroll
                for (int i = 0; i < 8; ++i) acc[i] += fe[e] * W[i + e];
#pragma unroll
            for (int x = 0; x < 8; ++x) W[x] = W[8 + x];
        }
    }
}
}
__device__ __forceinline__ void ph_hyena_naive(const Params& p, unsigned char* ldsb) {
    using namespace hy;
    float* u = (float*)ldsb;
    bf16_t* f = (bf16_t*)(u + (PADF + L + PADF));
    float* tmp = (float*)(p.ws + hk::WS_ACT + hk::A_HYTMP) + (size_t)blockIdx.x * L;
    const int tid = threadIdx.x, wave = tid >> 6;
    const bf16_t* UT = (const bf16_t*)(p.ws + hk::WS_ACT + hk::A_UT);
    const bf16_t* HF = (const bf16_t*)(p.ws + hk::WS_ACT + hk::A_HF); const bf16_t* HFC = (const bf16_t*)(p.ws + hk::WS_ACT + hk::A_HFC);
    bf16_t* YT = (bf16_t*)(p.ws + hk::WS_ACT + hk::A_YT);
    const float* cw = p.in[hk::I_HCW]; const float* cb = p.in[hk::I_HCB]; const float* lb = p.in[hk::I_HLB];
    for (int c = blockIdx.x; c < 1024; c += gridDim.x) {
        const float delta = fabsf(-3.0701134573253945f + (-15.350567286626973f + 3.0701134573253945f) * ((float)c / 1023.0f));
        float wv[3][4];
#pragma unroll
        for (int q = 0; q < 3; ++q) { wv[q][0] = cw[0 * 3072 + q * 1024 + c]; wv[q][1] = cw[1 * 3072 + q * 1024 + c]; wv[q][2] = cw[2 * 3072 + q * 1024 + c]; wv[q][3] = cb[q * 1024 + c]; }
        const bf16_t* rv = UT + (size_t)c * hk::TA; const bf16_t* r1 = UT + (size_t)(1024 + c) * hk::TA; const bf16_t* r2 = UT + (size_t)(2048 + c) * hk::TA;
        for (int b = 0; b < 2; ++b) {
            const int base = b * L;
            __syncthreads();
            for (int i = tid; i < PADF; i += 512) { u[i] = 0.f; u[PADF + L + i] = 0.f; }
            for (int t = tid; t < L; t += 512) u[PADF + t] = sconv(rv + base, t, L, wv[0][0], wv[0][1], wv[0][2], wv[0][3]);
            for (int o = 0; o < 2; ++o) {
                __syncthreads();
                for (int dir = 0; dir < 2; ++dir) {
                    const bf16_t* hrow = HF + (size_t)((o * 2 + dir) * 1024 + c) * L;
                    for (int m = tid; m < L; m += 512) f[dir * L + m] = (dir == 1 && m == 0) ? (bf16_t)0 : f2bf(bf2f(hrow[m]) * expf(-((float)m / (float)(L - 1)) * delta));
                }
                __syncthreads();
                const float d = lb[o * 1024 + c];
#pragma unroll 1
                for (int jj = 0; jj < 4; ++jj) {
                    const int t0 = 8 * (tid + 512 * jj), tw0 = 8 * (wave * 64 + 512 * jj);
                    float acc[8];
#pragma unroll
                    for (int i = 0; i < 8; ++i) acc[i] = 0.f;
                    lconv8<1>(u, f, t0, (tw0 + 8 * 63 + 7) / 8 + 1, acc);
                    lconv8<-1>(u, f + L, t0, (L - tw0 + 7) / 8, acc);
                    float res[8];
#pragma unroll
                    for (int i = 0; i < 8; ++i) {
                        const int t = t0 + i;
                        const float g = o == 0 ? sconv(r1 + base, t, L, wv[1][0], wv[1][1], wv[1][2], wv[1][3]) : sconv(r2 + base, t, L, wv[2][0], wv[2][1], wv[2][2], wv[2][3]);
                        res[i] = g * (acc[i] + d * u[PADF + t]);
                    }
                    if (o == 0) {
                        *(f32x4*)(tmp + t0) = (f32x4){res[0], res[1], res[2], res[3]}; *(f32x4*)(tmp + t0 + 4) = (f32x4){res[4], res[5], res[6], res[7]};
                    } else {
                        u32x4 w; w.x = pk2(res[0], res[1]); w.y = pk2(res[2], res[3]); w.z = pk2(res[4], res[5]); w.w = pk2(res[6], res[7]);
                        *(u32x4*)(YT + (size_t)c * hk::TA + base + t0) = w;
                    }
                }
                if (o == 0) {
                    __syncthreads();
#pragma unroll 1
                    for (int jj = 0; jj < 4; ++jj) {
                        const int t0 = 8 * (tid + 512 * jj);
                        *(f32x4*)(u + PADF + t0) = *(const f32x4*)(tmp + t0); *(f32x4*)(u + PADF + t0 + 4) = *(const f32x4*)(tmp + t0 + 4);
                    }
                }
            }
        }
        {
            __syncthreads();
            float* uc = u;
            float* fc = u + 512;
            const int b = tid >> 8, t = tid & 255, cbase = hk::TL + b * 256;
            uc[tid] = sconv(rv + cbase, t, 256, wv[0][0], wv[0][1], wv[0][2], wv[0][3]);
            for (int i = tid; i < 1024; i += 512) { const int od = i >> 8, m = i & 255; fc[i] = bf2f(HFC[(size_t)(od * 1024 + c) * 256 + m]) * expf(-((float)m / 255.0f) * delta); }
            __syncthreads();
            float y = uc[tid];
            for (int o = 0; o < 2; ++o) {
                float a = 0.f;
                for (int s = 0; s <= t; ++s) a += fc[(o * 2 + 0) * 256 + (t - s)] * uc[b * 256 + s];
                for (int s = t + 1; s < 256; ++s) a += fc[(o * 2 + 1) * 256 + (s - t)] * uc[b * 256 + s];
                const float g = o == 0 ? sconv(r1 + cbase, t, 256, wv[1][0], wv[1][1], wv[1][2], wv[1][3]) : sconv(r2 + cbase, t, 256, wv[2][0], wv[2][1], wv[2][2], wv[2][3]);
                y = g * (a + lb[o * 1024 + c] * y);
                __syncthreads();
                uc[tid] = y;
                __syncthreads();
            }
            YT[(size_t)c * hk::TA + cbase + t] = f2bf(y);
        }
    }
}
#ifndef HY_LO
#define HY_LO 2
#endif
namespace hf {
constexpr int N = 32768, L = 16384, ROWB = 144, PLB = 4624, WBYTES = 32 * PLB;
typedef short bf16x8 __attribute__((ext_vector_type(8)));
typedef float f32x16 __attribute__((ext_vector_type(16)));
__device__ __forceinline__ unsigned waddr(int p, int r, int i) { return (unsigned)(p * PLB + r * ROWB + i * 4); }
struct Dft { bf16x8 re[4], im[4]; };
__device__ __forceinline__ void make_dft(Dft& d, int lane) {
    const int k = lane & 31, g = lane >> 5;
#pragma unroll
    for (int s = 0; s < 4; ++s) {
        unsigned pr[4], pi[4];
#pragma unroll
        for (int jj = 0; jj < 4; ++jj) {
            const int a = 8 * s + 4 * g + jj;
            const float t = (float)((a * k) & 31) * (1.0f / 32.0f);
            const float c = __builtin_amdgcn_cosf(t), sn = __builtin_amdgcn_sinf(t);
            pr[jj] = pk2(c, sn);
            pi[jj] = pk2(-sn, c);
        }
        u32x4 a4 = (u32x4){pr[0], pr[1], pr[2], pr[3]}, b4 = (u32x4){pi[0], pi[1], pi[2], pi[3]};
        d.re[s] = __builtin_bit_cast(bf16x8, a4); d.im[s] = __builtin_bit_cast(bf16x8, b4);
    }
}
enum { EPI_TW0 = 0, EPI_TW1 = 1, EPI_HSTORE = 2, EPI_HMUL = 3, EPI_GATE = 4, EPI_RAW = 5 };
struct EpiArgs { unsigned* hs; const unsigned* xg; unsigned* vg; float d; int store_vg; };
template <bool ROWBLK, bool BFORM, int KS, int EPI>
__device__ __forceinline__ void fft_stage(unsigned char* W, const Dft& dft, int wave, int lane, const EpiArgs& ea) {
    const int k = lane & 31, g = lane >> 5;
    const float twc = __builtin_amdgcn_cosf((float)k * (1.0f / 1024.0f)), tws = __builtin_amdgcn_sinf((float)k * (1.0f / 1024.0f));
#pragma unroll 1
    for (int bi = 0; bi < 4; ++bi) {
        const int l = wave + 8 * bi;
        int kx = k; asm volatile("" : "+v"(kx));
        const unsigned base = ROWBLK ? waddr(kx, l, 0) : waddr(l, kx, 0);
        u32x4 pre0[4], pre1[2];
        if (EPI == EPI_HMUL) {
#pragma unroll
            for (int q = 0; q < 4; ++q) pre0[q] = *(const u32x4*)(ea.hs + ((kx * 32 + l) * 32 + 8 * q + 4 * g));
        }
        if (EPI == EPI_GATE) {
#pragma unroll
            for (int q = 0; q < 2; ++q) { const int gi = (l * 32 + kx) * 16 + 8 * q + 4 * g; pre0[q] = *(const u32x4*)(ea.xg + gi); pre1[q] = *(const u32x4*)(ea.vg + gi); }
        }
        bf16x8 dat[KS];
#pragma unroll
        for (int s = 0; s < KS; ++s) dat[s] = *(const bf16x8*)(W + base + 16 * (2 * s + g));
        f32x16 dre, dim;
#pragma unroll
        for (int i = 0; i < 16; ++i) { dre[i] = 0.f; dim[i] = 0.f; }
#pragma unroll
        for (int s = 0; s < KS; ++s) {
            if (!BFORM) { dre = __builtin_amdgcn_mfma_f32_32x32x16_bf16(dat[s], dft.re[s], dre, 0, 0, 0); dim = __builtin_amdgcn_mfma_f32_32x32x16_bf16(dat[s], dft.im[s], dim, 0, 0, 0); }
            else        { dre = __builtin_amdgcn_mfma_f32_32x32x16_bf16(dft.re[s], dat[s], dre, 0, 0, 0); dim = __builtin_amdgcn_mfma_f32_32x32x16_bf16(dft.im[s], dat[s], dim, 0, 0, 0); }
        }
#pragma unroll
        for (int q = 0; q < 4; ++q) {
            if (EPI == EPI_GATE && q >= 2) continue;
            const int ri0 = 8 * q + 4 * g;
            float orr[4], oii[4];
            if (EPI == EPI_TW0 || EPI == EPI_TW1) {
                const int e = (kx * (32 * ri0 + (EPI == EPI_TW1 ? l : 0))) & (N - 1);
                const float t = (float)e * (1.0f / (float)N);
                float c = __builtin_amdgcn_cosf(t), sn = __builtin_amdgcn_sinf(t);
#pragma unroll
                for (int r = 0; r < 4; ++r) {
                    const float a = dre[4 * q + r], b = dim[4 * q + r];
                    orr[r] = a * c + b * sn; oii[r] = b * c - a * sn;
                    const float c2 = c * twc - sn * tws, s2 = sn * twc + c * tws; c = c2; sn = s2;
                }
            } else if (EPI == EPI_HSTORE || EPI == EPI_RAW) {
#pragma unroll
                for (int r = 0; r < 4; ++r) { orr[r] = dre[4 * q + r]; oii[r] = dim[4 * q + r]; }
            } else if (EPI == EPI_HMUL) {
                const u32x4 h4 = pre0[q];
                const unsigned hw[4] = {h4.x, h4.y, h4.z, h4.w};
#pragma unroll
                for (int r = 0; r < 4; ++r) {
                    const float hr = __uint_as_float(hw[r] << 16), hi = __uint_as_float(hw[r] & 0xFFFF0000u);
                    const float a = dre[4 * q + r], b = dim[4 * q + r];
                    orr[r] = a * hr - b * hi; oii[r] = -(a * hi + b * hr);
                }
            } else {
                const u32x4 x4 = pre0[q & 1], v4 = pre1[q & 1];
                const unsigned xw[4] = {x4.x, x4.y, x4.z, x4.w}, vw[4] = {v4.x, v4.y, v4.z, v4.w};
#pragma unroll
                for (int r = 0; r < 4; ++r) {
                    const float xr = __uint_as_float(xw[r] << 16), xi = __uint_as_float(xw[r] & 0xFFFF0000u), vr = __uint_as_float(vw[r] << 16), vi = __uint_as_float(vw[r] & 0xFFFF0000u);
                    orr[r] = xr * (dre[4 * q + r] + ea.d * vr); oii[r] = xi * (-dim[4 * q + r] + ea.d * vi);
                }
            }
            u32x4 w; w.x = pk2(orr[0], oii[0]); w.y = pk2(orr[1], oii[1]); w.z = pk2(orr[2], oii[2]); w.w = pk2(orr[3], oii[3]);
            if (EPI == EPI_HSTORE) *(u32x4*)(ea.hs + ((kx * 32 + l) * 32 + ri0)) = w;
            else {
                *(u32x4*)(W + base + 4 * ri0) = w;
                if (EPI == EPI_GATE && ea.store_vg) *(u32x4*)(ea.vg + ((l * 32 + kx) * 16 + ri0)) = w;
            }
        }
    }
}

__device__ __forceinline__ void sconv8(const bf16_t* row, int t0, int n, const float (&w)[4], float (&out)[8]) {
    float f[8]; unpack8(*(const u32x4*)(row + t0), f);
    const float lo = t0 > 0 ? bf2f(row[t0 - 1]) : 0.f, hi = t0 + 8 < n ? bf2f(row[t0 + 8]) : 0.f;
#pragma unroll
    for (int i = 0; i < 8; ++i) { const float a = i == 0 ? lo : f[i - 1], c = i == 7 ? hi : f[i + 1]; out[i] = w[0] * a + w[1] * f[i] + w[2] * c + w[3]; }
}
__device__ __forceinline__ void sconv8_pack(const bf16_t* row, int t0, const float (&w)[4], unsigned* dst) {
    float a[8], b[8]; sconv8(row, t0, L, w, a); sconv8(row + L, t0, L, w, b);
    u32x4 p0, p1; p0.x = pk2(a[0], b[0]); p0.y = pk2(a[1], b[1]); p0.z = pk2(a[2], b[2]); p0.w = pk2(a[3], b[3]); p1.x = pk2(a[4], b[4]); p1.y = pk2(a[5], b[5]); p1.z = pk2(a[6], b[6]); p1.w = pk2(a[7], b[7]);
    *(u32x4*)(dst + t0) = p0; *(u32x4*)(dst + t0 + 4) = p1;
}
}

__device__ __forceinline__ void ph_hyena_fft(const Params& p, unsigned char* ldsb) {
    using namespace hf;
    unsigned char* W = ldsb;
    const int tid0 = threadIdx.x;
    const bf16_t* UT = (const bf16_t*)(p.ws + hk::WS_ACT + hk::A_UT);
    const bf16_t* HF = (const bf16_t*)(p.ws + hk::WS_ACT + hk::A_HF); const bf16_t* HFC = (const bf16_t*)(p.ws + hk::WS_ACT + hk::A_HFC);
    bf16_t* YT = (bf16_t*)(p.ws + hk::WS_ACT + hk::A_YT);
    unsigned* scr = (unsigned*)(p.ws + hk::WS_ACT + hk::A_HYS) + (size_t)blockIdx.x * (448 * 1024 / 4);
    unsigned* HS = scr; unsigned* XG1 = scr + 65536; unsigned* XG2 = XG1 + 16384; unsigned* VG = XG2 + 16384;
    const float* cw = p.in[hk::I_HCW]; const float* cb = p.in[hk::I_HCB]; const float* lb = p.in[hk::I_HLB];
    EpiArgs ea{};
    int c_lo, c_hi;
    if (gridDim.x == 256) { const int bx = blockIdx.x; if (bx < 128) { c_lo = bx * HY_LO; c_hi = c_lo + HY_LO; } else { c_lo = 128 * HY_LO + (bx - 128) * (8 - HY_LO); c_hi = c_lo + (8 - HY_LO); } }
    else { const int per = (1024 + gridDim.x - 1) / gridDim.x; c_lo = blockIdx.x * per; c_hi = c_lo + per < 1024 ? c_lo + per : 1024; }
    for (int c = c_lo; c < c_hi; ++c) {
        int tid = tid0; asm volatile("" : "+v"(tid));
        const int wave = __builtin_amdgcn_readfirstlane(tid >> 6), lane = tid & 63;
        const float delta = fabsf(-3.0701134573253945f + (-15.350567286626973f + 3.0701134573253945f) * ((float)c / 1023.0f));
        float wv[3][4];
#pragma unroll
        for (int q = 0; q < 3; ++q) { wv[q][0] = cw[0 * 3072 + q * 1024 + c]; wv[q][1] = cw[1 * 3072 + q * 1024 + c]; wv[q][2] = cw[2 * 3072 + q * 1024 + c]; wv[q][3] = cb[q * 1024 + c]; }
        const bf16_t* rv = UT + (size_t)c * hk::TA; const bf16_t* r1 = UT + (size_t)(1024 + c) * hk::TA; const bf16_t* r2 = UT + (size_t)(2048 + c) * hk::TA;
        { int ln = lane; asm volatile("" : "+v"(ln)); Dft dft; make_dft(dft, ln);
            __syncthreads();
            const bf16_t* hc0 = HF + (size_t)(0 * 1024 + c) * L; const bf16_t* ha0 = HF + (size_t)(1 * 1024 + c) * L;
            const bf16_t* hc1 = HF + (size_t)(2 * 1024 + c) * L; const bf16_t* ha1 = HF + (size_t)(3 * 1024 + c) * L;
            const float dsc = delta / (float)(L - 1);
#pragma unroll 1
            for (int i = 0; i < 4; ++i) {
                const int n0 = 8 * (tid + 512 * i);
                const u32x4 fc0 = *(const u32x4*)(hc0 + n0), fc1 = *(const u32x4*)(hc1 + n0), fa0 = *(const u32x4*)(ha0 + (L - 8 - n0)), fa1 = *(const u32x4*)(ha1 + (L - 8 - n0));
                float f[8], g[8]; unpack8(fc0, f); unpack8(fc1, g);
#pragma unroll
                for (int e = 0; e < 8; ++e) { const int n = n0 + e; const float s = __expf(-(float)n * dsc) * (1.0f / (float)N); *(unsigned*)(W + waddr(n & 31, (n >> 5) & 31, n >> 10)) = pk2(f[e] * s, g[e] * s); }
                unpack8(fa0, f); unpack8(fa1, g);
#pragma unroll
                for (int e = 0; e < 8; ++e) { const int m = L - 8 - n0 + e, n = N - m; const float s = __expf(-(float)m * dsc) * (1.0f / (float)N);
                    if (m != 0) *(unsigned*)(W + waddr(n & 31, (n >> 5) & 31, n >> 10)) = pk2(f[e] * s, g[e] * s); }
            }
            if (tid == 0) *(unsigned*)(W + waddr(L & 31, (L >> 5) & 31, L >> 10)) = 0u;
            __syncthreads();
            fft_stage<false, false, 4, EPI_TW1>(W, dft, wave, lane, ea); __syncthreads();
            fft_stage<true, false, 4, EPI_TW0>(W, dft, wave, lane, ea); __syncthreads();
            fft_stage<true, true, 4, EPI_RAW>(W, dft, wave, lane, ea); __syncthreads();
#pragma unroll 1
            for (int it = 0; it < 16; ++it) {
                const int gi = tid + 512 * it, j = gi & 7, k1 = (gi >> 3) & 31, k2 = gi >> 8;
                if ((k1 | k2) != 0) {
                    const int k1m = (32 - k1) & 31, k2m = k1 == 0 ? 32 - k2 : 31 - k2;
                    const u32x4 z4 = *(const u32x4*)(W + waddr(k2, k1, 4 * j)), m4 = *(const u32x4*)(W + waddr(k2m, k1m, 28 - 4 * j));
                    const unsigned zw[4] = {z4.x, z4.y, z4.z, z4.w}, mw[4] = {m4.w, m4.z, m4.y, m4.x};
                    unsigned h0[4], h1[4];
#pragma unroll
                    for (int r = 0; r < 4; ++r) {
                        const float a = __uint_as_float(zw[r] << 16), b = __uint_as_float(zw[r] & 0xFFFF0000u), cc = __uint_as_float(mw[r] << 16), d = __uint_as_float(mw[r] & 0xFFFF0000u);
                        h0[r] = pk2(0.5f * (a + cc), 0.5f * (b - d)); h1[r] = pk2(0.5f * (b + d), 0.5f * (cc - a));
                    }
                    const int hi = (k2 * 32 + k1) * 32 + 4 * j;
                    *(u32x4*)(HS + hi) = (u32x4){h0[0], h0[1], h0[2], h0[3]}; *(u32x4*)(HS + 32768 + hi) = (u32x4){h1[0], h1[1], h1[2], h1[3]};
                }
            }
            if (tid < 32) {
                const unsigned z = *(const unsigned*)(W + waddr(0, 0, tid)), zm = *(const unsigned*)(W + waddr(0, 0, (32 - tid) & 31));
                const float a = __uint_as_float(z << 16), b = __uint_as_float(z & 0xFFFF0000u), cc = __uint_as_float(zm << 16), d = __uint_as_float(zm & 0xFFFF0000u);
                HS[tid] = pk2(0.5f * (a + cc), 0.5f * (b - d)); HS[32768 + tid] = pk2(0.5f * (b + d), 0.5f * (cc - a));
            }
        }
        __syncthreads();
        {
            unsigned* xs1 = (unsigned*)W; unsigned* xs2 = xs1 + L;
            const int tix = tid;
#pragma unroll 1
            for (int t0 = 8 * tid; t0 < L; t0 += 8 * 512) { sconv8_pack(r1, t0, wv[1], xs1); asm volatile("" ::: "memory"); sconv8_pack(r2, t0, wv[2], xs2); }
            __syncthreads();
#pragma unroll 1
            for (int idx = tix; idx < 4096; idx += 512) {
                const int t3 = idx & 31, cq = (idx >> 5) & 3, t2 = idx >> 7;
                u32x4 a, b;
                a.x = xs1[1024 * (4 * cq + 0) + 32 * t2 + t3]; a.y = xs1[1024 * (4 * cq + 1) + 32 * t2 + t3]; a.z = xs1[1024 * (4 * cq + 2) + 32 * t2 + t3]; a.w = xs1[1024 * (4 * cq + 3) + 32 * t2 + t3];
                b.x = xs2[1024 * (4 * cq + 0) + 32 * t2 + t3]; b.y = xs2[1024 * (4 * cq + 1) + 32 * t2 + t3]; b.z = xs2[1024 * (4 * cq + 2) + 32 * t2 + t3]; b.w = xs2[1024 * (4 * cq + 3) + 32 * t2 + t3];
                *(u32x4*)(XG1 + (t3 * 32 + t2) * 16 + 4 * cq) = a; *(u32x4*)(XG2 + (t3 * 32 + t2) * 16 + 4 * cq) = b;
            }
            __syncthreads();
#pragma unroll 1
            for (int t0 = 8 * tid; t0 < L; t0 += 8 * 512) sconv8_pack(rv, t0, wv[0], xs1);
            __syncthreads();
            u32x4 hold[8];
#pragma unroll
            for (int i = 0; i < 8; ++i) {
                const int idx = tix + 512 * i, t3 = idx & 31, cq = (idx >> 5) & 3, t2 = idx >> 7;
                hold[i].x = xs1[1024 * (4 * cq + 0) + 32 * t2 + t3]; hold[i].y = xs1[1024 * (4 * cq + 1) + 32 * t2 + t3]; hold[i].z = xs1[1024 * (4 * cq + 2) + 32 * t2 + t3]; hold[i].w = xs1[1024 * (4 * cq + 3) + 32 * t2 + t3];
            }
            __syncthreads();
#pragma unroll
            for (int i = 0; i < 8; ++i) {
                const int idx = tix + 512 * i, t3 = idx & 31, cq = (idx >> 5) & 3, t2 = idx >> 7;
                *(u32x4*)(W + waddr(t3, t2, 4 * cq)) = hold[i];
                *(u32x4*)(VG + (t3 * 32 + t2) * 16 + 4 * cq) = hold[i];
            }
            __syncthreads();
        }
        { int ln = lane; asm volatile("" : "+v"(ln)); Dft dft; make_dft(dft, ln);
        for (int o = 0; o < 2; ++o) {
            fft_stage<false, false, 2, EPI_TW1>(W, dft, wave, lane, ea); __syncthreads();
            fft_stage<true, false, 4, EPI_TW0>(W, dft, wave, lane, ea); __syncthreads();
            ea.hs = HS + o * 32768;
            fft_stage<true, true, 4, EPI_HMUL>(W, dft, wave, lane, ea); __syncthreads();
            fft_stage<true, false, 4, EPI_TW1>(W, dft, wave, lane, ea); __syncthreads();
            fft_stage<false, false, 4, EPI_TW0>(W, dft, wave, lane, ea); __syncthreads();
            ea.xg = o == 0 ? XG1 : XG2; ea.vg = VG; ea.d = lb[o * 1024 + c]; ea.store_vg = o == 0 ? 1 : 0;
            fft_stage<false, true, 4, EPI_GATE>(W, dft, wave, lane, ea); __syncthreads();
        } }
        for (int t = tid; t < L; t += 512) {
            const unsigned v = *(const unsigned*)(W + waddr(t & 31, (t >> 5) & 31, t >> 10));
            YT[(size_t)c * hk::TA + t] = (bf16_t)(v & 0xFFFFu); YT[(size_t)c * hk::TA + L + t] = (bf16_t)(v >> 16);
        }
        {
            __syncthreads();
            float* uc = (float*)W;
            float* G = uc + 512;
            const int b = tid >> 8, t = tid & 255, cbase = hk::TL + b * 256;
            uc[tid] = hy::sconv(rv + cbase, t, 256, wv[0][0], wv[0][1], wv[0][2], wv[0][3]);
#pragma unroll 1
            for (int i = tid; i < 2 * 4 * 512; i += 512) {
                const int o = i >> 11, kap = (i >> 9) & 3, j = (i & 511) + kap;
                float val = 0.f;
                if (j <= 510) { const int d = 255 - j, m = d >= 0 ? d : -d; val = bf2f(HFC[(size_t)((o * 2 + (d >= 0 ? 0 : 1)) * 1024 + c) * 256 + m]) * __expf(-((float)m / 255.0f) * delta); }
                G[i] = val;
            }
            __syncthreads();
            float y = uc[tid];
            for (int o = 0; o < 2; ++o) {
                const int off = 255 - t;
                const float* Gp = G + (o * 4 + (off & 3)) * 512 + (off & ~3); const float* up = uc + b * 256;
                float a = 0.f;
#pragma unroll 2
                for (int s4 = 0; s4 < 64; ++s4) { const f32x4 g4 = *(const f32x4*)(Gp + 4 * s4), u4 = *(const f32x4*)(up + 4 * s4); a += (g4[0] * u4[0] + g4[1] * u4[1]) + (g4[2] * u4[2] + g4[3] * u4[3]); }
                const float g = o == 0 ? hy::sconv(r1 + cbase, t, 256, wv[1][0], wv[1][1], wv[1][2], wv[1][3]) : hy::sconv(r2 + cbase, t, 256, wv[2][0], wv[2][1], wv[2][2], wv[2][3]);
                y = g * (a + lb[o * 1024 + c] * y);
                __syncthreads();
                uc[tid] = y;
                __syncthreads();
            }
            YT[(size_t)c * hk::TA + cbase + t] = f2bf(y);
        }
    }
}
__device__ __forceinline__ void ph_ssd_conv(const Params& p, unsigned char* ldsb) {
    const bf16_t* XBC = (const bf16_t*)(p.ws + hk::WS_ACT + hk::A_XBC); bf16_t* XC = (bf16_t*)(p.ws + hk::WS_ACT + hk::A_XC); float* DT = (float*)(p.ws + hk::WS_ACT + hk::A_DT);
    const float* cw = p.in[hk::I_SCW]; const float* cb = p.in[hk::I_SCB];
    bf16_t* XTG = (bf16_t*)(p.ws + hk::WS_ACT + hk::A_XTG);
    const int tid = threadIdx.x;
    {   const bf16_t* XT = (const bf16_t*)(p.ws + hk::WS_ACT + hk::A_XT);
        const int lane = tid & 63, wave = __builtin_amdgcn_readfirstlane(tid >> 6);
        constexpr int NWU = 4096 * 65; const int step = (int)gridDim.x * 8;
        int wu = blockIdx.x * 8 + wave;
        u32x4 R0 = (u32x4){0u, 0u, 0u, 0u}, R1 = R0, R2 = R0;
#define XC_LOAD3(wu_, A0, A1, A2) do { const int c_ = (wu_) / 65, s_ = (wu_) - c_ * 65, t_ = s_ * 512 + lane * 8, y_ = (t_ >> 6) & 255; \
            const bool up_ = s_ < 64 && y_ > 0, dn_ = s_ < 64 && y_ < 255; const bf16_t* row_ = XT + (size_t)c_ * hk::TA + t_; \
            A1 = *(const u32x4*)row_; A0 = *(const u32x4*)(row_ - (up_ ? 64 : 0)); A2 = *(const u32x4*)(row_ + (dn_ ? 64 : 0)); \
            if (!up_) A0 = (u32x4){0u, 0u, 0u, 0u}; if (!dn_) A2 = (u32x4){0u, 0u, 0u, 0u}; } while (0)
        if (wu < NWU) XC_LOAD3(wu, R0, R1, R2);
#pragma unroll 1
        for (; wu < NWU; wu += step) {
            u32x4 N0 = R0, N1 = R1, N2 = R2;
            { const int wn = wu + step; if (wn < NWU) XC_LOAD3(wn, N0, N1, N2); }
            const int c = wu / 65, s = wu - c * 65, t0 = s * 512 + lane * 8;
            const int x0 = s < 64 ? (t0 & 63) : (t0 & 255); const bool lf = x0 > 0, rt = x0 < (s < 64 ? 56 : 248);
            float w[9];
#pragma unroll
            for (int t = 0; t < 9; ++t) w[t] = cw[(size_t)t * 6144 + c];
            const float bias = cb[c];
            float acc[8];
#pragma unroll
            for (int i = 0; i < 8; ++i) acc[i] = bias;
#pragma unroll
            for (int dy = 0; dy < 3; ++dy) {
                const u32x4 R = dy == 0 ? R0 : dy == 1 ? R1 : R2;
                float g8[8]; unpack8(R, g8);
                const unsigned lw = (unsigned)__shfl_up((int)R.w, 1), rw = (unsigned)__shfl_down((int)R.x, 1);
                float f[10]; f[0] = lf ? __uint_as_float(lw & 0xFFFF0000u) : 0.f; f[9] = rt ? __uint_as_float(rw << 16) : 0.f;
#pragma unroll
                for (int i = 0; i < 8; ++i) f[1 + i] = g8[i];
#pragma unroll
                for (int i = 0; i < 8; ++i)
#pragma unroll
                    for (int dx = 0; dx < 3; ++dx) acc[i] += f[i + dx] * w[dy * 3 + dx];
            }
            u32x4 o; o.x = pk2(silu_f(acc[0]), silu_f(acc[1])); o.y = pk2(silu_f(acc[2]), silu_f(acc[3])); o.z = pk2(silu_f(acc[4]), silu_f(acc[5])); o.w = pk2(silu_f(acc[6]), silu_f(acc[7]));
            *(u32x4*)(XTG + (size_t)c * hk::TA + t0) = o;
            R0 = N0; R1 = N1; R2 = N2;
        }
#undef XC_LOAD3
    }
#pragma unroll 1
    for (int tb = blockIdx.x; tb < 4160; tb += gridDim.x) {
        const int c0 = 4096 + 4 * tid;
        int tok0, x0, rowlen; bool up, dn;
        if (tb < 4096) { const int b = tb >> 11, rem = tb & 2047, y = rem >> 3; x0 = 8 * (rem & 7); tok0 = b * hk::SEQ + y * 64 + x0; up = y > 0; dn = y < 255; rowlen = 64; }
        else { const int q = tb - 4096, b = q >> 5; x0 = 8 * (q & 31); tok0 = hk::TL + b * 256 + x0; up = false; dn = false; rowlen = 256; }
        float w[9][4];
#pragma unroll
        for (int t = 0; t < 9; ++t) { const f32x4 wv = *(const f32x4*)(cw + (size_t)t * 6144 + c0); w[t][0] = wv[0]; w[t][1] = wv[1]; w[t][2] = wv[2]; w[t][3] = wv[3]; }
        const f32x4 bias = *(const f32x4*)(cb + c0);
        u32x2 v[3][10];
#pragma unroll
        for (int dy = 0; dy < 3; ++dy) {
            const bool rowok = dy == 1 || (dy == 0 ? up : dn);
#pragma unroll
            for (int dx = 0; dx < 10; ++dx) {
                const int x = x0 - 1 + dx;
                v[dy][dx] = (u32x2){0u, 0u};
                if (rowok && x >= 0 && x < rowlen) v[dy][dx] = *(const u32x2*)(XBC + (size_t)(tok0 + (dy - 1) * 64 - 1 + dx) * hk::XBC_LD + (c0 - 4096));
            }
        }
#pragma unroll
        for (int i = 0; i < 8; ++i) {
            float acc[4] = {bias[0], bias[1], bias[2], bias[3]};
#pragma unroll
            for (int dy = 0; dy < 3; ++dy)
#pragma unroll
                for (int dx = 0; dx < 3; ++dx) { const u32x2 q = v[dy][i + dx]; const int t = dy * 3 + dx;
                    acc[0] += __uint_as_float(q.x << 16) * w[t][0]; acc[1] += __uint_as_float(q.x & 0xFFFF0000u) * w[t][1]; acc[2] += __uint_as_float(q.y << 16) * w[t][2]; acc[3] += __uint_as_float(q.y & 0xFFFF0000u) * w[t][3]; }
            u32x2 o; o.x = pk2(silu_f(acc[0]), silu_f(acc[1])); o.y = pk2(silu_f(acc[2]), silu_f(acc[3])); *(u32x2*)(XC + (size_t)(tok0 + i) * 2048 + (c0 - 4096)) = o;
        }
    }
    for (int idx = blockIdx.x * 512 + tid; idx < hk::TA * 16; idx += gridDim.x * 512) {
        const int r = idx >> 4, q8 = (idx & 15) * 8, dir = q8 >> 6, h0 = q8 & 63;
        float z[8]; unpack8(*(const u32x4*)(XBC + (size_t)r * hk::XBC_LD + 2048 + q8), z);
        const f32x4 b0 = *(const f32x4*)(p.in[hk::I_SDTB] + dir * 64 + h0), b1 = *(const f32x4*)(p.in[hk::I_SDTB] + dir * 64 + h0 + 4);
        f32x4 o0, o1;
#pragma unroll
        for (int j = 0; j < 4; ++j) { const float za = z[j] + b0[j], zb = z[4 + j] + b1[j]; o0[j] = za > 20.f ? za : log1pf(expf(za)); o1[j] = zb > 20.f ? zb : log1pf(expf(zb)); }
        float* d = DT + ((size_t)dir * hk::TA + r) * 64 + h0;
        *(f32x4*)d = o0; *(f32x4*)(d + 4) = o1;
    }
}
__device__ __forceinline__ void ph_ssd_scan_naive(const Params& p, unsigned char* ldsb) {
    float* Bs = (float*)ldsb;
    float* Cs = Bs + 32 * 128;
    float* xs = Cs + 32 * 128;
    float* dts = xs + 32 * 64;
    const int tid = threadIdx.x;
    const bf16_t* XC = (const bf16_t*)(p.ws + hk::WS_ACT + hk::A_XC); const float* DT = (const float*)(p.ws + hk::WS_ACT + hk::A_DT);
    for (int it = blockIdx.x; it < 256; it += gridDim.x) {
        const int b = it >> 7, dir = (it >> 6) & 1, h = it & 63, g = h >> 3;
        bf16_t* Y = (bf16_t*)(dir == 0 ? p.ws + hk::WS_ACT + hk::A_YF : p.ws + hk::WS_YB);
        const float aneg = -expf(p.in[hk::I_SALOG][dir * 64 + h]), dsk = p.in[hk::I_SD][dir * 64 + h];
        const int pp = tid >> 3, ns = tid & 7;
        float S[16];
#pragma unroll
        for (int i = 0; i < 16; ++i) S[i] = 0.f;
        for (int seg = 0; seg < 2; ++seg) {
            const int n = seg == 0 ? hk::CTXL : hk::SEQ, rowbase = seg == 0 ? hk::TL + b * hk::CTXL : b * hk::SEQ;
            for (int t0 = 0; t0 < n; t0 += 32) {
                __syncthreads();
                for (int idx = tid; idx < 32 * 128; idx += 512) {
                    const int s = idx >> 7, nn = idx & 127, tt = t0 + s, t = dir == 0 ? tt : n - 1 - tt;
                    const bf16_t* row = XC + (size_t)(rowbase + t) * 6144;
                    Bs[idx] = bf2f(row[4096 + g * 128 + nn]); Cs[idx] = bf2f(row[5120 + g * 128 + nn]);
                }
                for (int idx = tid; idx < 32 * 64; idx += 512) {
                    const int s = idx >> 6, q = idx & 63, tt = t0 + s, t = dir == 0 ? tt : n - 1 - tt;
                    xs[idx] = bf2f(XC[(size_t)(rowbase + t) * 6144 + h * 64 + q]);
                }
                if (tid < 32) { const int tt = t0 + tid, t = dir == 0 ? tt : n - 1 - tt; dts[tid] = DT[((size_t)dir * hk::TA + rowbase + t) * 64 + h]; }
                __syncthreads();
#pragma unroll 2
                for (int s = 0; s < 32; ++s) {
                    const float dt = dts[s], da = expf(dt * aneg), xv = xs[s * 64 + pp], xd = dt * xv;
                    float y = 0.f;
#pragma unroll
                    for (int q = 0; q < 4; ++q) {
                        const f32x4 b4 = *(const f32x4*)(Bs + s * 128 + ns * 16 + q * 4), c4 = *(const f32x4*)(Cs + s * 128 + ns * 16 + q * 4);
#pragma unroll
                        for (int j = 0; j < 4; ++j) { S[q * 4 + j] = da * S[q * 4 + j] + xd * b4[j]; y += S[q * 4 + j] * c4[j]; }
                    }
                    y += __shfl_xor(y, 1); y += __shfl_xor(y, 2); y += __shfl_xor(y, 4);
                    if (seg == 1 && ns == 0) { const int tt = t0 + s, t = dir == 0 ? tt : n - 1 - tt; Y[(size_t)(rowbase + t) * 4096 + h * 64 + pp] = f2bf(y + dsk * xv); }
                }
            }
        }
    }
}
__device__ __forceinline__ void ph_ssd_finish(const Params& p, unsigned char* ldsb) {
    const int lane = threadIdx.x & 63, wave = threadIdx.x >> 6;
    bf16_t* Z = (bf16_t*)(p.ws + hk::WS_ACT + hk::A_Z);
    const bf16_t* YF = (const bf16_t*)(p.ws + hk::WS_ACT + hk::A_YF); const bf16_t* YB = (const bf16_t*)(p.ws + hk::WS_YB);
    float* ng = (float*)ldsb;
    { int t0 = threadIdx.x; asm volatile("" : "+v"(t0)); *(f32x4*)(ng + t0 * 4) = *(const f32x4*)(p.in[hk::I_SNG] + t0 * 4); *(f32x4*)(ng + 2048 + t0 * 4) = *(const f32x4*)(p.in[hk::I_SNG] + 2048 + t0 * 4);
      __syncthreads(); }
    for (int r = blockIdx.x * 8 + wave; r < hk::TL; r += gridDim.x * 8) {
#pragma unroll 2
        for (int g = 0; g < 8; ++g) {
            const int col = g * 512 + lane * 8;
            float a[8], bq[8], z[8], uu[8];
            unpack8(*(const u32x4*)(YF + (size_t)r * 4096 + col), a); unpack8(*(const u32x4*)(YB + (size_t)r * 4096 + col), bq); unpack8(*(const u32x4*)(Z + (size_t)r * 4096 + col), z);
            float ss = 0.f;
#pragma unroll
            for (int j = 0; j < 8; ++j) { uu[j] = (a[j] + bq[j]) * silu_f(z[j]); ss += uu[j] * uu[j]; }
            const float rs = rsqrtf(wave_sum(ss) * (1.0f / 512.0f) + hk::LN_EPS);
            const f32x4 g0 = *(const f32x4*)(ng + col), g1 = *(const f32x4*)(ng + col + 4);
            u32x4 w; w.x = pk2(uu[0] * rs * g0[0], uu[1] * rs * g0[1]); w.y = pk2(uu[2] * rs * g0[2], uu[3] * rs * g0[3]); w.z = pk2(uu[4] * rs * g1[0], uu[5] * rs * g1[1]); w.w = pk2(uu[6] * rs * g1[2], uu[7] * rs * g1[3]);
            *(u32x4*)(Z + (size_t)r * 4096 + col) = w;
        }
    }
}
namespace sc {
typedef short bf16x8 __attribute__((ext_vector_type(8)));
typedef float f32x16 __attribute__((ext_vector_type(16)));
constexpr int RS = 272, SCN = 1024;
constexpr float LOG2E = 1.4426950408889634f;
constexpr int O_BM = 0, O_CM = 128 * 256, O_XT = O_CM + 128 * RS, O_XW = O_XT + 64 * RS, O_SB = O_XW + 64 * RS, O_SC = O_SB + 64 * RS, O_GI = O_SC + 2 * SCN * 4;
__device__ __forceinline__ unsigned off_b(unsigned row, unsigned ch) { return 256u * row + 16u * (ch ^ (((row & 3u) << 2) | ((row >> 2) & 3u))); }
__device__ __forceinline__ f32x16 zero16() { f32x16 z;
#pragma unroll
    for (int i = 0; i < 16; ++i) z[i] = 0.f; return z; }
__device__ __forceinline__ bf16x8 ldf(const unsigned char* base, int row, int colb) { return *(const bf16x8*)(base + row * RS + colb); }
__device__ __forceinline__ f32x16 chain8_xa(f32x16 acc, const unsigned char* A, int arow, const unsigned char* B, int brow, int g2) {
    const unsigned xr = (((unsigned)arow & 3u) << 2) | (((unsigned)arow >> 2) & 3u);
#pragma unroll
    for (int hh = 0; hh < 2; ++hh) {
        bf16x8 fa[4], fb[4];
#pragma unroll
        for (int k = 0; k < 4; ++k) { fa[k] = *(const bf16x8*)(A + 256 * arow + 16 * ((unsigned)(2 * (4 * hh + k) + g2) ^ xr)); fb[k] = ldf(B, brow, 32 * (4 * hh + k) + 16 * g2); }
        __builtin_amdgcn_sched_barrier(0);
#pragma unroll
        for (int k = 0; k < 4; ++k) acc = __builtin_amdgcn_mfma_f32_32x32x16_bf16(fa[k], fb[k], acc, 0, 0, 0);
        __builtin_amdgcn_sched_barrier(0);
    }
    return acc;
}
__device__ __forceinline__ f32x16 chain8_tr(f32x16 acc, unsigned ta0, unsigned ta1, const unsigned char* B, int brow, int g2) {
    u32x2 l0, l1, l2, l3, h0, h1, h2, h3;
    {
        bf16x8 fb[4];
#pragma unroll
        for (int k = 0; k < 4; ++k) fb[k] = ldf(B, brow, 32 * k + 16 * g2);
        asm volatile("ds_read_b64_tr_b16 %0, %8\n\tds_read_b64_tr_b16 %1, %9\n\tds_read_b64_tr_b16 %2, %8 offset:4096\n\tds_read_b64_tr_b16 %3, %9 offset:4096\n\t"
                     "ds_read_b64_tr_b16 %4, %8 offset:8192\n\tds_read_b64_tr_b16 %5, %9 offset:8192\n\tds_read_b64_tr_b16 %6, %8 offset:12288\n\tds_read_b64_tr_b16 %7, %9 offset:12288\n\ts_waitcnt lgkmcnt(0)"
                     : "=&v"(l0), "=&v"(h0), "=&v"(l1), "=&v"(h1), "=&v"(l2), "=&v"(h2), "=&v"(l3), "=&v"(h3) : "v"(ta0), "v"(ta1) : "memory");
        __builtin_amdgcn_sched_barrier(0);
        acc = __builtin_amdgcn_mfma_f32_32x32x16_bf16(__builtin_bit_cast(bf16x8, (u32x4){l0.x, l0.y, h0.x, h0.y}), fb[0], acc, 0, 0, 0);
        acc = __builtin_amdgcn_mfma_f32_32x32x16_bf16(__builtin_bit_cast(bf16x8, (u32x4){l1.x, l1.y, h1.x, h1.y}), fb[1], acc, 0, 0, 0);
        acc = __builtin_amdgcn_mfma_f32_32x32x16_bf16(__builtin_bit_cast(bf16x8, (u32x4){l2.x, l2.y, h2.x, h2.y}), fb[2], acc, 0, 0, 0);
        acc = __builtin_amdgcn_mfma_f32_32x32x16_bf16(__builtin_bit_cast(bf16x8, (u32x4){l3.x, l3.y, h3.x, h3.y}), fb[3], acc, 0, 0, 0);
        __builtin_amdgcn_sched_barrier(0);
    }
    {
        bf16x8 fb[4];
#pragma unroll
        for (int k = 0; k < 4; ++k) fb[k] = ldf(B, brow, 32 * (4 + k) + 16 * g2);
        asm volatile("ds_read_b64_tr_b16 %0, %8 offset:16384\n\tds_read_b64_tr_b16 %1, %9 offset:16384\n\tds_read_b64_tr_b16 %2, %8 offset:20480\n\tds_read_b64_tr_b16 %3, %9 offset:20480\n\t"
                     "ds_read_b64_tr_b16 %4, %8 offset:24576\n\tds_read_b64_tr_b16 %5, %9 offset:24576\n\tds_read_b64_tr_b16 %6, %8 offset:28672\n\tds_read_b64_tr_b16 %7, %9 offset:28672\n\ts_waitcnt lgkmcnt(0)"
                     : "=&v"(l0), "=&v"(h0), "=&v"(l1), "=&v"(h1), "=&v"(l2), "=&v"(h2), "=&v"(l3), "=&v"(h3) : "v"(ta0), "v"(ta1) : "memory");
        __builtin_amdgcn_sched_barrier(0);
        acc = __builtin_amdgcn_mfma_f32_32x32x16_bf16(__builtin_bit_cast(bf16x8, (u32x4){l0.x, l0.y, h0.x, h0.y}), fb[0], acc, 0, 0, 0);
        acc = __builtin_amdgcn_mfma_f32_32x32x16_bf16(__builtin_bit_cast(bf16x8, (u32x4){l1.x, l1.y, h1.x, h1.y}), fb[1], acc, 0, 0, 0);
        acc = __builtin_amdgcn_mfma_f32_32x32x16_bf16(__builtin_bit_cast(bf16x8, (u32x4){l2.x, l2.y, h2.x, h2.y}), fb[2], acc, 0, 0, 0);
        acc = __builtin_amdgcn_mfma_f32_32x32x16_bf16(__builtin_bit_cast(bf16x8, (u32x4){l3.x, l3.y, h3.x, h3.y}), fb[3], acc, 0, 0, 0);
        __builtin_amdgcn_sched_barrier(0);
    }
    return acc;
}
__device__ __forceinline__ unsigned tr_addr(unsigned img, int lane, int c, int t) {
    const unsigned hh = (unsigned)lane >> 5, blk = ((unsigned)lane >> 4) & 1u, q = ((unsigned)lane & 15u) >> 2, pp = (unsigned)lane & 3u;
    return img + off_b(8u * hh + 4u * (unsigned)t + q, 4u * (unsigned)c + 2u * blk + (pp >> 1)) + 8u * (pp & 1u);
}
template <int N> __device__ __forceinline__ float dpp_shr(float v) { return __int_as_float(__builtin_amdgcn_update_dpp(0, __float_as_int(v), 0x110 + N, 0xF, 0xF, true)); }
__device__ __forceinline__ float rdl(float v, int l) { return __int_as_float(__builtin_amdgcn_readlane(__float_as_int(v), l)); }
__device__ __forceinline__ int row0_of(int ci, int b, int dir) { const int seg = ci < 2 ? 0 : 1, c2 = seg == 0 ? ci : ci - 2, nc = seg == 0 ? 2 : 128, cs = dir == 0 ? c2 : nc - 1 - c2;
    return (seg == 0 ? hk::TL + b * hk::CTXL : b * hk::SEQ) + 128 * cs; }
__device__ __forceinline__ f32x16 chain8(f32x16 acc, const unsigned char* A, int arow, const unsigned char* B, int brow, int g2) {
#pragma unroll
    for (int hh = 0; hh < 2; ++hh) {
        bf16x8 fa[4], fb[4];
#pragma unroll
        for (int k = 0; k < 4; ++k) { fa[k] = ldf(A, arow, 32 * (4 * hh + k) + 16 * g2); fb[k] = ldf(B, brow, 32 * (4 * hh + k) + 16 * g2); }
        __builtin_amdgcn_sched_barrier(0);
#pragma unroll
        for (int k = 0; k < 4; ++k) acc = __builtin_amdgcn_mfma_f32_32x32x16_bf16(fa[k], fb[k], acc, 0, 0, 0);
        __builtin_amdgcn_sched_barrier(0);
    }
    return acc;
}
__device__ __forceinline__ void load8(bf16x8 (&f)[8], const unsigned char* B, int brow, int g2) {
#pragma unroll
    for (int k = 0; k < 8; ++k) f[k] = ldf(B, brow, 32 * k + 16 * g2);
}
__device__ __forceinline__ f32x16 chain8_xa_b(f32x16 acc, const unsigned char* A, int arow, const bf16x8 (&fb)[8], int g2) {
    const unsigned xr = (((unsigned)arow & 3u) << 2) | (((unsigned)arow >> 2) & 3u);
#pragma unroll
    for (int hh = 0; hh < 2; ++hh) {
        bf16x8 fa[4];
#pragma unroll
        for (int k = 0; k < 4; ++k) fa[k] = *(const bf16x8*)(A + 256 * arow + 16 * ((unsigned)(2 * (4 * hh + k) + g2) ^ xr));
        __builtin_amdgcn_sched_barrier(0);
#pragma unroll
        for (int k = 0; k < 4; ++k) acc = __builtin_amdgcn_mfma_f32_32x32x16_bf16(fa[k], fb[4 * hh + k], acc, 0, 0, 0);
        __builtin_amdgcn_sched_barrier(0);
    }
    return acc;
}
__device__ __forceinline__ f32x16 chain8_b(f32x16 acc, const unsigned char* A, int arow, const bf16x8 (&fb)[8], int g2) {
#pragma unroll
    for (int hh = 0; hh < 2; ++hh) {
        bf16x8 fa[4];
#pragma unroll
        for (int k = 0; k < 4; ++k) fa[k] = ldf(A, arow, 32 * (4 * hh + k) + 16 * g2);
        __builtin_amdgcn_sched_barrier(0);
#pragma unroll
        for (int k = 0; k < 4; ++k) acc = __builtin_amdgcn_mfma_f32_32x32x16_bf16(fa[k], fb[4 * hh + k], acc, 0, 0, 0);
        __builtin_amdgcn_sched_barrier(0);
    }
    return acc;
}
__device__ __forceinline__ f32x16 chain2(f32x16 acc, const unsigned char* A, int arow, const unsigned char* B, int brow, int colb) {
    const bf16x8 a0 = ldf(A, arow, colb), b0 = ldf(B, brow, colb), a1 = ldf(A, arow, colb + 32), b1 = ldf(B, brow, colb + 32);
    __builtin_amdgcn_sched_barrier(0);
    acc = __builtin_amdgcn_mfma_f32_32x32x16_bf16(a0, b0, acc, 0, 0, 0); acc = __builtin_amdgcn_mfma_f32_32x32x16_bf16(a1, b1, acc, 0, 0, 0);
    __builtin_amdgcn_sched_barrier(0);
    return acc;
}
}
__device__ __forceinline__ void ph_ssd_scan_chunk(const Params& p, unsigned char* lds) {
    using namespace sc;
    const int tid = threadIdx.x, lane = tid & 63, wave = __builtin_amdgcn_readfirstlane(tid >> 6), l32 = lane & 31, g2 = lane >> 5;
    const bf16_t* XC = (const bf16_t*)(p.ws + hk::WS_ACT + hk::A_XC); const float* DT = (const float*)(p.ws + hk::WS_ACT + hk::A_DT);
    unsigned char* Bm = lds + O_BM; unsigned char* XW = lds + O_XW; unsigned char* Cm = lds + O_CM; unsigned char* XT = lds + O_XT; unsigned char* Sb = lds + O_SB; unsigned char* Gi = lds + O_GI;
    const bf16_t* XTG = (const bf16_t*)(p.ws + hk::WS_ACT + hk::A_XTG);
    float* SC = (float*)(lds + O_SC);
    const unsigned bm_lds = (unsigned)(size_t)(Bm);
    for (int itx = blockIdx.x; itx < 256; itx += gridDim.x) {
        const int it0 = gridDim.x == 256 ? (((itx >> 3) >> 3) << 6) | (8 * (itx & 7) + ((itx >> 3) & 7)) : itx;
        const int b = it0 >> 7, dir = (it0 >> 6) & 1, h = it0 & 63, grp = h >> 3;
        bf16_t* Y = (bf16_t*)(dir == 0 ? p.ws + hk::WS_ACT + hk::A_YF : p.ws + hk::WS_YB);
        const float aneg = -expf(p.in[hk::I_SALOG][dir * 64 + h]) * LOG2E, dsk = p.in[hk::I_SD][dir * 64 + h];
        f32x16 accST = zero16();
        __syncthreads();
        for (int i = tid; i < 64 * RS / 4; i += 512) ((unsigned*)Sb)[i] = 0u;
        u32x4 xq[2], bq[4], cc[4]; float dt0 = 0.f, dt1 = 0.f;
#define SSD_PREFETCH(ci_) do { const int r0_ = sc::row0_of(ci_, b, dir); \
        _Pragma("unroll") for (int k_ = 0; k_ < 2; ++k_) { const int pc = tid + 512 * k_, pr = pc >> 4, ch = pc & 15; xq[k_] = *(const u32x4*)(XTG + (size_t)(h * 64 + pr) * hk::TA + r0_ + 8 * ch); } \
        _Pragma("unroll") for (int k_ = 0; k_ < 4; ++k_) { const int pc = tid + 512 * k_, row = pc >> 4, ch = pc & 15; const bf16_t* s_ = XC + (size_t)(r0_ + row) * 2048 + grp * 128 + 8 * ch; bq[k_] = *(const u32x4*)s_; cc[k_] = *(const u32x4*)(s_ + 1024); } } while (0)
#define SSD_DTLOAD(ci_) do { const int r0_ = sc::row0_of(ci_, b, dir); dt0 = DT[((size_t)dir * hk::TA + r0_ + 2 * lane) * 64 + h]; dt1 = DT[((size_t)dir * hk::TA + r0_ + 2 * lane + 1) * 64 + h]; } while (0)
#define SSD_SCALARS(ci_) do { \
        const float a0 = dt0 * aneg, a1 = dt1 * aneg, s2 = a0 + a1; float P = s2; \
          \
        P += sc::dpp_shr<1>(P); P += sc::dpp_shr<2>(P); P += sc::dpp_shr<4>(P); P += sc::dpp_shr<8>(P); \
        { const float t0_ = sc::rdl(P, 15), t1_ = sc::rdl(P, 31), t2_ = sc::rdl(P, 47); P += lane >= 48 ? t0_ + t1_ + t2_ : lane >= 32 ? t0_ + t1_ : lane >= 16 ? t0_ : 0.f; } \
        const float T_ = sc::rdl(P, 63); \
        float ac0, ac1; if (dir == 0) { ac0 = P - a1; ac1 = P; } else { const float sf = T_ - P + s2; ac0 = sf; ac1 = sf - a0; } \
        float* sc_ = SC + ((ci_) & 1) * SCN; \
          \
        const float R1 = dir == 0 ? sc::rdl(ac1, 15) : sc::rdl(ac0, 16), R2 = dir == 0 ? sc::rdl(ac1, 31) : sc::rdl(ac0, 32), R3 = dir == 0 ? sc::rdl(ac1, 47) : sc::rdl(ac0, 48); \
        const int blk = lane >> 4; const float Rb = dir == 0 ? (blk == 1 ? R1 : blk == 2 ? R2 : R3) : (blk == 0 ? R1 : blk == 1 ? R2 : R3); \
        *(hw_f32x2*)(sc_ + 2 * lane) = (hw_f32x2){ac0, ac1}; *(hw_f32x2*)(sc_ + 128 + 2 * lane) = (hw_f32x2){dt0, dt1}; \
        *(hw_f32x2*)(sc_ + 256 + 2 * lane) = (hw_f32x2){__builtin_amdgcn_exp2f(fminf(ac0 - Rb, 0.f)), __builtin_amdgcn_exp2f(fminf(ac1 - Rb, 0.f))};                                    \
        *(hw_f32x2*)(sc_ + 384 + 2 * lane) = (hw_f32x2){__builtin_amdgcn_exp2f(fminf(R1 - ac0, 0.f)) * dt0, __builtin_amdgcn_exp2f(fminf(R1 - ac1, 0.f)) * dt1};                        \
        *(hw_f32x2*)(sc_ + 512 + 2 * lane) = (hw_f32x2){__builtin_amdgcn_exp2f(fminf(R2 - ac0, 0.f)) * dt0, __builtin_amdgcn_exp2f(fminf(R2 - ac1, 0.f)) * dt1};                        \
        *(hw_f32x2*)(sc_ + 640 + 2 * lane) = (hw_f32x2){__builtin_amdgcn_exp2f(fminf(R3 - ac0, 0.f)) * dt0, __builtin_amdgcn_exp2f(fminf(R3 - ac1, 0.f)) * dt1};                        \
        *(hw_f32x2*)(sc_ + 768 + 2 * lane) = (hw_f32x2){dt0 * __builtin_amdgcn_exp2f(T_ - ac0), dt1 * __builtin_amdgcn_exp2f(T_ - ac1)};                                                \
        if (lane == 0) sc_[896] = __builtin_amdgcn_exp2f(T_); } while (0)
#define SSD_FILL(ci_) do { const float* scn_ = SC + ((ci_) & 1) * SCN; \
        _Pragma("unroll") for (int k_ = 0; k_ < 2; ++k_) { const int pc = tid + 512 * k_, pr = pc >> 4, ch = pc & 15; *(u32x4*)(XT + pr * RS + 16 * ch) = xq[k_]; \
          const f32x4 wa_ = *(const f32x4*)(scn_ + 768 + 8 * ch), wb_ = *(const f32x4*)(scn_ + 768 + 8 * ch + 4); \
          float f_[8]; unpack8(xq[k_], f_); u32x4 o_; o_.x = pk2(wa_[0] * f_[0], wa_[1] * f_[1]); o_.y = pk2(wa_[2] * f_[2], wa_[3] * f_[3]); o_.z = pk2(wb_[0] * f_[4], wb_[1] * f_[5]); o_.w = pk2(wb_[2] * f_[6], wb_[3] * f_[7]); \
          *(u32x4*)(XW + pr * RS + 16 * ch) = o_; } \
        _Pragma("unroll") for (int k_ = 0; k_ < 4; ++k_) { const int pc = tid + 512 * k_, row = pc >> 4, ch = pc & 15; \
          *(u32x4*)(Cm + row * RS + 16 * ch) = cc[k_]; *(u32x4*)(Bm + off_b(row, ch)) = bq[k_]; } } while (0)
        SSD_PREFETCH(0);
        if (wave == 7) { SSD_DTLOAD(0); SSD_SCALARS(0); SSD_DTLOAD(1); }
        __syncthreads();
        SSD_FILL(0);

#if PROBE_STAMP
        long long pst_prev = clock64(), ps_ab = 0, ps_bc = 0, ps_cd = 0, ps_da = 0;
#define PSTAMP(acc_) do { const long long now_ = clock64(); acc_ += now_ - pst_prev; pst_prev = now_; } while (0)
#else
#define PSTAMP(acc_) do { } while (0)
#endif
        for (int ci = 0; ci < 130; ++ci) {
            __syncthreads();
            PSTAMP(ps_da);
            const float* sc = SC + (ci & 1) * SCN; const float dtot = sc[896];
            if (ci + 1 < 130) { SSD_PREFETCH(ci + 1); if (wave == 7) { SSD_SCALARS(ci + 1); if (ci + 2 < 130) SSD_DTLOAD(ci + 2); } }
            const int pt2 = wave >> 2, it2 = wave < 4 ? wave : (dir == 0 ? (wave == 4 ? 0 : 8 - wave) : 3 - (wave == 4 ? 0 : 8 - wave));
            bf16x8 cf[8]; load8(cf, Cm, 32 * it2 + l32, g2);
            int tj[2], ti[2]; const int ntile = (wave == 5 || wave == 6) ? 2 : 1;
            u32x2 gp[2][4];
#define GI_NTL(it_) (dir == 0 ? (it_) + 1 : 4 - (it_))
#define GI_BASE(it_) (dir == 0 ? 32 * (32 * (it_) * ((it_) + 1) + 16 * (it_)) : 32 * (256 * (it_) - 32 * (it_) * ((it_) - 1) + 16 * (it_)))
#define GI_ROW(it_, l_) (Gi + GI_BASE(it_) + (l_) * (64 * GI_NTL(it_) + 16))
#define GI_COL(it_, jt_) (64 * ((jt_) - (dir == 0 ? 0 : (it_))))
#pragma unroll
            for (int s = 0; s < 2; ++s) {
                int a, bq;
                if (wave < 4) { a = wave; bq = wave; }
                else if (wave == 4) { a = 2; bq = 3; }
                else if (wave == 5) { a = s; bq = 3; }
                else if (wave == 6) { a = s; bq = 2; }
                else { a = 0; bq = 1; }
                if (wave < 4) { tj[s] = a; ti[s] = bq; } else { tj[s] = dir == 0 ? a : 3 - a; ti[s] = dir == 0 ? bq : 3 - bq; }
                if (s < ntile) {
                    f32x16 gt = wave == 4 ? chain8_xa(zero16(), Bm, 32 * tj[s] + l32, Cm, 32 * ti[s] + l32, g2) : chain8_xa_b(zero16(), Bm, 32 * tj[s] + l32, cf, g2);
                    const int i = 32 * ti[s] + l32;
                    if (wave < 4) {
                        const float aci = sc[i];
#pragma unroll
                        for (int q = 0; q < 4; ++q) {
                            const int j0 = 32 * tj[s] + 8 * q + 4 * g2;
                            const f32x4 acj = *(const f32x4*)(sc + j0), dtj = *(const f32x4*)(sc + 128 + j0);
                            float v[4];
#pragma unroll
                            for (int r = 0; r < 4; ++r) {
                                const int j = j0 + r; const bool ok = dir == 0 ? (j <= i) : (j >= i);
                                const float e = __builtin_amdgcn_exp2f(fminf(aci - acj[r], 0.f));
                                v[r] = ok ? gt[4 * q + r] * e * dtj[r] + (j == i ? dsk : 0.f) : 0.f;
                            }
                            gp[s][q].x = pk2(v[0], v[1]); gp[s][q].y = pk2(v[2], v[3]);
                        }
                    } else {
                        const float ea = sc[256 + i];
                        const float* eb = sc + 384 + 128 * (dir == 0 ? ti[s] - 1 : ti[s]) + 32 * tj[s] + 4 * g2;
#pragma unroll
                        for (int q = 0; q < 4; ++q) {
                            const f32x4 e4 = *(const f32x4*)(eb + 8 * q);
                            gp[s][q].x = pk2(gt[4 * q] * ea * e4[0], gt[4 * q + 1] * ea * e4[1]); gp[s][q].y = pk2(gt[4 * q + 2] * ea * e4[2], gt[4 * q + 3] * ea * e4[3]);
                        }
                    }
                    { unsigned char* gr_ = GI_ROW(ti[s], l32) + GI_COL(ti[s], tj[s]) + 8 * g2;
#pragma unroll
                      for (int q = 0; q < 4; ++q) *(u32x2*)(gr_ + 16 * q) = gp[s][q]; }
                }
            }
            f32x16 yint = zero16();
            yint = chain8_b(yint, Sb, 32 * pt2 + l32, cf, g2);
            { const float ei = __builtin_amdgcn_exp2f(sc[32 * it2 + l32]);
#pragma unroll
              for (int k = 0; k < 16; ++k) yint[k] *= ei; }
            {
                const int nt = wave & 3, pt = wave >> 2;
#pragma unroll
                for (int i = 0; i < 16; ++i) accST[i] *= dtot;
                accST = chain8_tr(accST, tr_addr(bm_lds, lane, nt, 0), tr_addr(bm_lds, lane, nt, 1), XW, 32 * pt + l32, g2);
            }
            const int jlo = dir == 0 ? 0 : it2, jhi = dir == 0 ? it2 : 3;
            bf16x8 xa[4][2];
#pragma unroll
            for (int jt = 0; jt < 4; ++jt) if (jt >= jlo && jt <= jhi) { xa[jt][0] = ldf(XT, 32 * pt2 + l32, 64 * jt + 16 * g2); xa[jt][1] = ldf(XT, 32 * pt2 + l32, 64 * jt + 16 * g2 + 32); }
            __syncthreads();
            PSTAMP(ps_bc);
            f32x16 yacc = yint;
            {
                const unsigned char* grow = GI_ROW(it2, l32) + 16 * g2;
#pragma unroll
                for (int jt = 0; jt < 4; ++jt) if (jt >= jlo && jt <= jhi) {
                    const bf16x8 b0 = *(const bf16x8*)(grow + GI_COL(it2, jt)), b1 = *(const bf16x8*)(grow + GI_COL(it2, jt) + 32);
                    __builtin_amdgcn_sched_barrier(0);
                    yacc = __builtin_amdgcn_mfma_f32_32x32x16_bf16(xa[jt][0], b0, yacc, 0, 0, 0); yacc = __builtin_amdgcn_mfma_f32_32x32x16_bf16(xa[jt][1], b1, yacc, 0, 0, 0);
                    __builtin_amdgcn_sched_barrier(0);
                }
            }
            if (ci >= 2) {
                const int r0 = sc::row0_of(ci, b, dir), i = 32 * it2 + l32;
                bf16_t* yrow = Y + (size_t)(r0 + i) * 4096 + h * 64 + 32 * pt2 + 4 * g2;
#pragma unroll
                for (int q = 0; q < 4; ++q) { u32x2 w; w.x = pk2(yacc[4 * q], yacc[4 * q + 1]); w.y = pk2(yacc[4 * q + 2], yacc[4 * q + 3]);
                    *(u32x2*)(yrow + 8 * q) = w; }
            }
            {
                const int nt = wave & 3, pt = wave >> 2;
#pragma unroll
                for (int q = 0; q < 4; ++q) { u32x2 w; w.x = pk2(accST[4 * q], accST[4 * q + 1]); w.y = pk2(accST[4 * q + 2], accST[4 * q + 3]);
                    *(u32x2*)(Sb + (32 * pt + l32) * RS + 2 * (32 * nt + 8 * q + 4 * g2)) = w; }
            }
            PSTAMP(ps_cd);
            if (ci + 1 < 130) SSD_FILL(ci + 1);
        }
#if PROBE_STAMP
        if (blockIdx.x == 0 && tid == 0) { const float tot = (float)(ps_ab + ps_bc + ps_cd + ps_da);
            const float sel = PROBE_STAMP == 1 ? (float)ps_ab : PROBE_STAMP == 2 ? (float)ps_bc : PROBE_STAMP == 3 ? (float)ps_cd : (float)ps_da;
            ((float*)(p.ws + hk::WS_CTL))[hk::CW_PROBE] = sel / tot; }
#endif
#undef PSTAMP
#undef GI_NTL
#undef GI_BASE
#undef GI_ROW
#undef GI_COL
#undef SSD_PREFETCH
#undef SSD_FILL
#undef SSD_DTLOAD
#undef SSD_SCALARS
    }
}
namespace gc {
constexpr int NCH = 260;
}
__device__ __forceinline__ void ph_gla_pre(const Params& p, unsigned char* lds) {
    bf16_t* qs = (bf16_t*)lds;
    bf16_t* ks = qs + 128 * 128;
    float* g1s = (float*)(ks + 128 * 128);
    float* w2s = g1s + 128 * 16;
    float* bs = w2s + 16 * 128;
    float* tot = bs + 128;
    const int tid = threadIdx.x;
    const bf16_t* GL = (const bf16_t*)(p.ws + hk::WS_ACT + hk::A_GL);
    for (int itx = blockIdx.x; itx < gc::NCH * 8; itx += gridDim.x) {
        const int item = gridDim.x == 256 ? ((itx >> 4) << 4) | ((itx & 7) << 1) | ((itx >> 3) & 1) : itx;
        const int chunk = item >> 3, h = (item >> 1) & 3, dir = item & 1, r0 = chunk * 128;
        bf16_t* QD = (bf16_t*)(p.ws + hk::WS_ACT + hk::A_QK) + (size_t)(dir * 2 + 0) * hk::TA * 512;
        bf16_t* KD = (bf16_t*)(p.ws + hk::WS_ACT + hk::A_QK) + (size_t)(dir * 2 + 1) * hk::TA * 512;
        float* E = (float*)(p.ws + hk::WS_ACT + hk::A_EB) + ((size_t)(dir * gc::NCH + chunk) * 3) * 512 + h * 128;
        __syncthreads();
        for (int pc = tid; pc < 128 * 16; pc += 512) {
            const int row = pc >> 4, ch = pc & 15;
            *(u32x4*)(qs + row * 128 + 8 * ch) = *(const u32x4*)(GL + (size_t)(r0 + row) * hk::GL_LD + h * 128 + 8 * ch);
            *(u32x4*)(ks + row * 128 + 8 * ch) = *(const u32x4*)(GL + (size_t)(r0 + row) * hk::GL_LD + 512 + h * 128 + 8 * ch);
        }
        for (int i = tid; i < 128 * 16; i += 512) { const int row = i >> 4, r = i & 15; g1s[i] = bf2f(GL[(size_t)(r0 + row) * hk::GL_LD + hk::GL_GK + dir * 16 + r]); }
        for (int i = tid; i < 16 * 128; i += 512) { const int r = i >> 7, kk = i & 127; w2s[i] = p.in[hk::I_GW2][(size_t)(dir * 16 + r) * 512 + h * 128 + kk]; }
        if (tid < 128) bs[tid] = p.in[hk::I_GB][dir * 512 + h * 128 + tid];
        __syncthreads();
        const int kk = tid & 127, tq = tid >> 7;
        float w2r[16];
#pragma unroll
        for (int r = 0; r < 16; ++r) w2r[r] = w2s[r * 128 + kk];
        const float bias = bs[kk];
        float gl[32]; float run = 0.f;
#pragma unroll
        for (int s = 0; s < 32; ++s) {
            const int t = tq * 32 + s;
            float z = bias;
#pragma unroll
            for (int r = 0; r < 16; ++r) z += g1s[t * 16 + r] * w2r[r];
            const float ls = fminf(z, 0.f) - __logf(1.0f + __expf(-fabsf(z)));
            run += ls * (1.0f / 16.0f); gl[s] = run;
        }
        tot[tq * 128 + kk] = run;
        __syncthreads();
        const float t0 = tot[kk], t1 = tot[128 + kk], t2 = tot[256 + kk], t3 = tot[384 + kk];
        const float before = tq == 0 ? 0.f : tq == 1 ? t0 : tq == 2 ? t0 + t1 : t0 + t1 + t2, total = (t0 + t1) + (t2 + t3);
        const float ref = dir == 0 ? t0 + t1 : t2 + t3;
        if (tq == 0) { E[kk] = __expf(total); E[512 + kk] = __expf(total - ref); E[1024 + kk] = __expf(ref); }
        float prev = 0.f;
#pragma unroll
        for (int s = 0; s < 32; ++s) {
            const int t = tq * 32 + s;
            const float pin = before + gl[s];
            const float bt = dir == 0 ? pin : total - (before + prev);
            prev = gl[s];
            const float eq = __expf(bt - ref), ek = __expf(ref - bt);
            qs[t * 128 + kk] = f2bf(bf2f(qs[t * 128 + kk]) * 0.08838834764831845f * eq);
            ks[t * 128 + kk] = f2bf(bf2f(ks[t * 128 + kk]) * ek);
        }
        __syncthreads();
        for (int pc = tid; pc < 128 * 16; pc += 512) {
            const int row = pc >> 4, ch = pc & 15;
            *(u32x4*)(QD + (size_t)(r0 + row) * 512 + h * 128 + 8 * ch) = *(const u32x4*)(qs + row * 128 + 8 * ch);
            *(u32x4*)(KD + (size_t)(r0 + row) * 512 + h * 128 + 8 * ch) = *(const u32x4*)(ks + row * 128 + 8 * ch);
        }
    }
}

__device__ __forceinline__ void ph_gla_scan_chunk(const Params& p, unsigned char* lds) {
    using namespace sc;
    const int tid = threadIdx.x, lane = tid & 63, wave = __builtin_amdgcn_readfirstlane(tid >> 6), l32 = lane & 31, g2 = lane >> 5;
    constexpr int O_KM = 0, O_QM = 128 * RS, O_VT = 2 * 128 * RS, O_SB2 = O_VT + 64 * RS, O_GI = O_SB2 + 32 * RS + 3072;
    unsigned char* Km = lds + O_KM; unsigned char* Qm = lds + O_QM; unsigned char* VT0 = lds + O_VT; unsigned char* Sb = lds + O_SB2; unsigned char* Gi = lds + O_GI;
    const unsigned km_lds = (unsigned)(size_t)Km;
    const bf16_t* VTG = (const bf16_t*)(p.ws + hk::WS_ACT + hk::A_VTG);
    float* Es = (float*)(lds + O_SB2 + 32 * RS);
    const bf16_t* GL = (const bf16_t*)(p.ws + hk::WS_ACT + hk::A_GL);
    if (blockIdx.x < 128) { const int itx = blockIdx.x, it0 = gridDim.x == 256 ? ((2 * (itx & 7) + ((itx >> 3) & 1)) << 3) | (itx >> 4) : itx;
        const int b = it0 >> 6, dir = (it0 >> 5) & 1, h = (it0 >> 3) & 3, vs = it0 & 7;
        const bf16_t* QD = (const bf16_t*)(p.ws + hk::WS_ACT + hk::A_QK) + (size_t)(dir * 2 + 0) * hk::TA * 512;
        const bf16_t* KD = (const bf16_t*)(p.ws + hk::WS_ACT + hk::A_QK) + (size_t)(dir * 2 + 1) * hk::TA * 512;
        const float* EB = (const float*)(p.ws + hk::WS_ACT + hk::A_EB) + (size_t)dir * gc::NCH * 3 * 512 + h * 128;
        bf16_t* OUT = (bf16_t*)(p.ws + hk::WS_ACT + (dir == 0 ? hk::A_OF : hk::A_OB));
        f32x16 accST = zero16();
        __syncthreads();
        for (int i = tid; i < 32 * RS / 4; i += 512) ((unsigned*)Sb)[i] = 0u;
        u32x4 kq[4], qq[4], vq; float ev = 0.f;
#define GLA_PREFETCH(ci_) do { const int r0_ = sc::row0_of(ci_, b, dir); \
        if (tid < 384) ev = EB[(size_t)(r0_ >> 7) * 1536 + (tid >> 7) * 512 + (tid & 127)]; \
        _Pragma("unroll") for (int k_ = 0; k_ < 4; ++k_) { const int pc = tid + 512 * k_, row = pc >> 4, ch = pc & 15; kq[k_] = *(const u32x4*)(KD + (size_t)(r0_ + row) * 512 + h * 128 + 8 * ch); qq[k_] = *(const u32x4*)(QD + (size_t)(r0_ + row) * 512 + h * 128 + 8 * ch); } \
        { const int vr = tid >> 4, ch = tid & 15; vq = *(const u32x4*)(VTG + (size_t)(h * 256 + vs * 32 + vr) * hk::TA + r0_ + 8 * ch); } } while (0)
#define GLA_FILL(VT) do { \
        _Pragma("unroll") for (int k_ = 0; k_ < 4; ++k_) { const int pc = tid + 512 * k_, row = pc >> 4, ch = pc & 15; *(u32x4*)(Km + off_b(row, ch)) = kq[k_]; *(u32x4*)(Qm + row * RS + 16 * ch) = qq[k_]; } \
        { const int vr = tid >> 4, ch = tid & 15; *(u32x4*)(VT + vr * RS + 16 * ch) = vq; } } while (0)
        GLA_PREFETCH(0);
        __syncthreads();
        GLA_FILL(VT0);
        if (tid < 384) Es[tid] = ev;
        GLA_PREFETCH(1);
        for (int ci = 0; ci < 130; ++ci) {
            __syncthreads();
            const float* Ec = Es + (ci & 1) * 384; const float* En = Es + ((ci + 1) & 1) * 384;
            unsigned char* VT = VT0 + (ci & 1) * 32 * RS; unsigned char* VTn = VT0 + ((ci + 1) & 1) * 32 * RS;
            if (ci + 1 < 130 && tid < 384) Es[((ci + 1) & 1) * 384 + tid] = ev;
            bf16x8 cf[8]; if (wave < 4) load8(cf, Qm, 32 * wave + l32, g2);
            int tj[2], ti[2]; const int ntile = (wave == 4 || wave == 5) ? 2 : 1;
            u32x2 gp[2][4];
#pragma unroll
            for (int s = 0; s < 2; ++s) {
                int a, bq;
                if (wave < 4) { a = wave; bq = wave; }
                else if (wave == 4) { a = s == 0 ? 0 : 2; bq = s == 0 ? 1 : 3; }
                else if (wave == 5) { a = s == 0 ? 0 : 1; bq = s == 0 ? 2 : 3; }
                else if (wave == 6) { a = 1; bq = 2; }
                else { a = 0; bq = 3; }
                tj[s] = dir == 0 ? a : bq; ti[s] = dir == 0 ? bq : a;
                if (s < ntile) {
                    const f32x16 gt = wave < 4 ? chain8_xa_b(zero16(), Km, 32 * tj[s] + l32, cf, g2) : chain8_xa(zero16(), Km, 32 * tj[s] + l32, Qm, 32 * ti[s] + l32, g2);
                    if (wave < 4) {
                        const int i = 32 * ti[s] + l32;
#pragma unroll
                        for (int q = 0; q < 4; ++q) {
                            const int j0 = 32 * tj[s] + 8 * q + 4 * g2;
                            float v[4];
#pragma unroll
                            for (int r = 0; r < 4; ++r) { const int j = j0 + r; const bool ok = dir == 0 ? (j <= i) : (j >= i); v[r] = ok ? gt[4 * q + r] : 0.f; }
                            gp[s][q].x = pk2(v[0], v[1]); gp[s][q].y = pk2(v[2], v[3]);
                        }
                    } else {
#pragma unroll
                        for (int q = 0; q < 4; ++q) { gp[s][q].x = pk2(gt[4 * q], gt[4 * q + 1]); gp[s][q].y = pk2(gt[4 * q + 2], gt[4 * q + 3]); }
                    }
#pragma unroll
                    for (int q = 0; q < 4; ++q) *(u32x2*)(Gi + (32 * ti[s] + l32) * RS + 2 * (32 * tj[s] + 8 * q + 4 * g2)) = gp[s][q];
                }
            }
            f32x16 yacc = zero16();
            if (wave < 4) {
                yacc = chain8_b(yacc, Sb, l32, cf, g2);
            } else {
                const int nt = wave - 4;
                f32x16 u = zero16();
                u = chain8_tr(u, tr_addr(km_lds, lane, nt, 0), tr_addr(km_lds, lane, nt, 1), VT, l32, g2);
#pragma unroll
                for (int q = 0; q < 4; ++q) { const int k0 = 32 * nt + 8 * q + 4 * g2; const f32x4 e1 = *(const f32x4*)(Ec + k0), e2 = *(const f32x4*)(Ec + 128 + k0);
#pragma unroll
                    for (int r = 0; r < 4; ++r) accST[4 * q + r] = e1[r] * accST[4 * q + r] + e2[r] * u[4 * q + r]; }
            }
            __syncthreads();
            if (ci + 1 < 130) { GLA_FILL(VTn); if (ci + 2 < 130) GLA_PREFETCH(ci + 2); }
            if (wave < 4) {
                const int it2 = wave, jlo = dir == 0 ? 0 : it2, jhi = dir == 0 ? it2 : 3;
                for (int jt = jlo; jt <= jhi; ++jt) yacc = chain2(yacc, VT, l32, Gi, 32 * it2 + l32, 64 * jt + 16 * g2);
                const int r0 = sc::row0_of(ci, b, dir), i = 32 * it2 + l32;
                bf16_t* orow = OUT + (size_t)(r0 + i) * 1024 + h * 256 + vs * 32 + 4 * g2;
#pragma unroll
                for (int q = 0; q < 4; ++q) { u32x2 w; w.x = pk2(yacc[4 * q], yacc[4 * q + 1]); w.y = pk2(yacc[4 * q + 2], yacc[4 * q + 3]); *(u32x2*)(orow + 8 * q) = w; }
            } else {
                const int nt = wave - 4;
#pragma unroll
                for (int q = 0; q < 4; ++q) { const f32x4 e3 = *(const f32x4*)(En + 256 + 32 * nt + 8 * q + 4 * g2);
                    u32x2 w; w.x = pk2(accST[4 * q] * e3[0], accST[4 * q + 1] * e3[1]); w.y = pk2(accST[4 * q + 2] * e3[2], accST[4 * q + 3] * e3[3]);
                    *(u32x2*)(Sb + l32 * RS + 2 * (32 * nt + 8 * q + 4 * g2)) = w; }
            }
        }
#undef GLA_PREFETCH
#undef GLA_FILL
    }
}
#ifndef ONE_LAUNCH
#define ONE_LAUNCH 0
#endif
#ifndef HY_FFT
#define HY_FFT 1
#endif
#ifndef SSD_CHUNK
#define SSD_CHUNK 1
#endif
#ifndef GLA_CHUNK
#define GLA_CHUNK 1
#endif
#ifndef PROBE_DUP_GEMM
#define PROBE_DUP_GEMM 0
#endif
#ifndef PROBE_STAMP
#define PROBE_STAMP 0
#endif
constexpr int N_PHASES = 22;
constexpr int NO_SPLIT = 1 << 30;

template <class Epi> __device__ __forceinline__ void run_gemm(unsigned char* lds, const bf16_t* A, const bf16_t* Bt, int M, int N, int K, const Epi& E) {
    pg8::Gemm g{A, Bt, M, N, K}; pg8::StaticOrder S; S.init(M, N, (int)gridDim.x, (int)blockIdx.x);
    pg8::gemm_phase<Epi, pg8::StaticOrder, false>((PG8_LAS unsigned char*)lds, g, S, E, nullptr);
#if PROBE_DUP_GEMM
    __syncthreads(); pg8::gemm_phase<Epi, pg8::StaticOrder, false>((PG8_LAS unsigned char*)lds, g, S, E, nullptr);
#endif
}
template <class Epi, bool GATHER = false> __device__ __forceinline__ void run_gemm_grouped(unsigned char* lds, const bf16_t* A, const bf16_t* Bt, int K, const unsigned* ctl, int layer, const Epi& E, const int* rowmap = nullptr) {
    pg8::GroupedOrder S; expert_starts(ctl + hk::CW_CNT + layer * 64, S.ps);
    S.ntiles = S.ps[16] >> 8; S.ncol = 8; S.G = (int)gridDim.x; S.c = (int)blockIdx.x; S.cap = hk::ROWS_CAP;
    pg8::Gemm g{A, Bt, S.ntiles * 256, 16 * 2048, K, rowmap};
    pg8::gemm_phase<Epi, pg8::GroupedOrder, false, GATHER>((PG8_LAS unsigned char*)lds, g, S, E, nullptr);
}

__global__ void __launch_bounds__(512, 2) hybrid_fwd(Params p) {
    extern __shared__ __attribute__((aligned(16))) unsigned char lds[];
    unsigned char* ws = p.ws; unsigned char* act = ws + hk::WS_ACT;
    unsigned* ctl = (unsigned*)(ws + hk::WS_CTL);
#if ONE_LAUNCH
    volatile LAS unsigned* xbw = (volatile LAS unsigned*)(lds + hk::LDS_BYTES - 16);
    if (threadIdx.x == 0) { xbw[0] = 0u; xbw[1] = 0u; xbw[2] = 0u; xbw[3] = 0u; }
    __syncthreads();
    XcdBarrier bar = xcd_barrier_post(ctl + hk::CW_BAR, xbw);
#define SEAM(k) do { if ((k) + 1 < p.ph_hi) xcd_barrier(bar); } while (0)
#else
#define SEAM(k) do { } while (0)
#endif
#ifndef PH_MASK
#define PH_MASK 0xFFFFFFFFu
#endif
#define IN(k) ((((PH_MASK) >> (k)) & 1u) && p.ph_lo <= (k) && (k) < p.ph_hi)
#ifdef PROBE_PHASE
    unsigned long long pp_t0 = __builtin_amdgcn_s_memrealtime(), pp_ta = 0, pp_tb = 0;
#define PP_BEGIN(k) do { if ((k) == PROBE_PHASE) pp_ta = __builtin_amdgcn_s_memrealtime(); if ((k) == 21 && blockIdx.x == 0 && threadIdx.x == 0) { const unsigned long long now_ = __builtin_amdgcn_s_memrealtime(); \
        ((float*)(ws + hk::WS_CTL))[hk::CW_PROBE] = (float)(pp_tb - pp_ta) / (float)(now_ - pp_t0); } } while (0)
#define PP_END(k) do { if ((k) == PROBE_PHASE) pp_tb = __builtin_amdgcn_s_memrealtime(); } while (0)
#else
#define PP_BEGIN(k) do { } while (0)
#define PP_END(k) do { } while (0)
#endif
    bf16_t* HA = (bf16_t*)(act + hk::A_HA);
    if (IN(0)) { PP_BEGIN(0); ph_mod(p, lds); __syncthreads(); ph_conv_weights(p, lds); __syncthreads(); ph_conv_experts(p, 0, lds); __syncthreads(); ph_hid(p, lds); __syncthreads(); SEAM(0); PP_END(0); }
    if (IN(1)) { PP_BEGIN(1); ph_modulate0(p, lds); SEAM(1); PP_END(1); }
    if (IN(2)) { PP_BEGIN(2);
        {
            static_assert(hk::WS_WU % hk::MiB == 0 && hk::WS_WGLA % hk::MiB == 0 && (hk::WS_ACT + hk::A_HA) % hk::MiB == 0, "operand buffers must sit on 1 MiB steps");
            constexpr int T_WU = (int)(hk::WS_WU / hk::MiB), T_WGLA = (int)(hk::WS_WGLA / hk::MiB), T_HA = (int)((hk::WS_ACT + hk::A_HA) / hk::MiB);
            static_assert(T_WU < T_HA && T_WGLA < T_HA, "EpiChain tells the GEMMs apart by pm >= T_HA");
            pg8::Gemm g{(const bf16_t*)ws, (const bf16_t*)ws, 0, 0, 2048};
            pg8::ChainOrder S{16, hk::TA / 256, T_WU, T_HA, hk::TA / 256, 9, T_HA, T_WGLA, (int)gridDim.x, (int)blockIdx.x};
            pg8::EpiChain E{pg8::EpiStore{(bf16_t*)(act + hk::A_UT), hk::TA, NO_SPLIT, nullptr, 0, 0}, pg8::EpiStore{(bf16_t*)(act + hk::A_GL), hk::GL_LD, NO_SPLIT, nullptr, 0, 0}, T_WU, T_HA, T_HA, T_WGLA};
            pg8::gemm_phase<pg8::EpiChain, pg8::ChainOrder, false>((PG8_LAS unsigned char*)lds, g, S, E, nullptr);
        }
        run_gemm(lds, (const bf16_t*)(ws + hk::WS_W3T), (const bf16_t*)(ws + hk::WS_HID2), 4096, 16384, 256, pg8::EpiStore{(bf16_t*)(act + hk::A_HF), 16384, NO_SPLIT, nullptr, 0, 0});
        run_gemm(lds, (const bf16_t*)(ws + hk::WS_W3T), (const bf16_t*)(ws + hk::WS_HID2C), 4096, 256, 256, pg8::EpiStore{(bf16_t*)(act + hk::A_HFC), 256, NO_SPLIT, nullptr, 0, 0});
        SEAM(2);
    }
    if (IN(3)) { PP_BEGIN(3);
#if GLA_CHUNK
        ph_gla_pre(p, lds);
#endif
        SEAM(3); PP_END(3); }
    if (IN(4)) { PP_BEGIN(4);
#if GLA_CHUNK
        ph_gla_scan_chunk(p, lds);
#else
        ph_gla_scan_naive(p, lds);
#endif
        __syncthreads();
#if HY_FFT
        ph_hyena_fft(p, lds);
#else
        ph_hyena_naive(p, lds);
#endif
        SEAM(4); PP_END(4); }
    if (IN(5)) { PP_BEGIN(5); ph_mix_finish(p, lds); SEAM(5); PP_END(5); }
    if (IN(6)) { PP_BEGIN(6); run_gemm(lds, HA, (const bf16_t*)(ws + hk::WS_WOUT0), gridDim.x == 256 ? hk::TL : hk::TA, 2048, 2048, pg8::EpiStore{(bf16_t*)(act + hk::A_YO), 2048, NO_SPLIT, nullptr, 0, 0}); SEAM(6); PP_END(6); }
    if (IN(7)) { PP_BEGIN(7);
        if (gridDim.x == 256 && blockIdx.x >= 240) {
            pg8::Gemm g{HA + (size_t)hk::TL * 2048, (const bf16_t*)(ws + hk::WS_WOUT0), 512, 2048, 2048}; pg8::StaticOrder S; S.init(512, 2048, 16, (int)blockIdx.x - 240);
            pg8::gemm_phase<pg8::EpiStore, pg8::StaticOrder, false>((PG8_LAS unsigned char*)lds, g, S, pg8::EpiStore{(bf16_t*)(act + hk::A_YO) + (size_t)hk::TL * 2048, 2048, NO_SPLIT, nullptr, 0, 0}, nullptr);
            asm volatile("s_waitcnt vmcnt(0)" ::: "memory");
            __syncthreads();
            if (threadIdx.x == 0) { __builtin_amdgcn_fence(__ATOMIC_RELEASE, "agent"); asm volatile("s_waitcnt vmcnt(0)" ::: "memory");
                __hip_atomic_fetch_add(ctl + hk::CW_CTXF, 1u, __ATOMIC_RELAXED, __HIP_MEMORY_SCOPE_AGENT); }
            __syncthreads();
        }
        ph_ln1_router(p, 0, lds, (const bf16_t*)(act + hk::A_YO), HA); SEAM(7); PP_END(7); }
    if (IN(9)) { PP_BEGIN(9); run_gemm_grouped<pg8::EpiSwiGLU, true>(lds, HA, (const bf16_t*)(ws + hk::WS_WE), 2048, ctl, 0, pg8::EpiSwiGLU{(bf16_t*)(act + hk::A_HB), 1024, 8}, (const int*)(act + hk::A_ROWS)); SEAM(9); PP_END(9); }
    if (IN(10)) { PP_BEGIN(10); run_gemm_grouped(lds, (const bf16_t*)(act + hk::A_HB), (const bf16_t*)(ws + hk::WS_WE_DN), 1024, ctl, 0, pg8::EpiStore{(bf16_t*)(act + hk::A_YR), 2048, NO_SPLIT, nullptr, 0, 8}); SEAM(10); PP_END(10); }
    if (IN(11)) { PP_BEGIN(11); ph_ln2(p, 0, (const bf16_t*)(act + hk::A_YR), (bf16_t*)(act + hk::A_HA1), lds); SEAM(11); PP_END(11); }
    if (IN(12)) { PP_BEGIN(12);
        {   static_assert(hk::WS_WSSDIN % hk::MiB == 0 && (hk::WS_ACT + hk::A_HA1) % hk::MiB == 0, "operand buffers must sit on 1 MiB steps");
            constexpr int T_WX = (int)(hk::WS_WSSDIN / hk::MiB), T_H1 = (int)((hk::WS_ACT + hk::A_HA1) / hk::MiB);
            static_assert(T_WX + 41 < T_H1, "EpiChain tells the GEMMs apart by pm >= T_H1");
            pg8::Gemm g{(const bf16_t*)ws, (const bf16_t*)ws, 0, 0, 2048};
            pg8::ChainOrder S{16, hk::TA / 256, T_WX, T_H1, hk::TA / 256, 25, T_H1, T_WX + 16, (int)gridDim.x, (int)blockIdx.x};
            pg8::EpiChain E{pg8::EpiStore{(bf16_t*)(act + hk::A_XT), hk::TA, NO_SPLIT, nullptr, 0, 0}, pg8::EpiStore{(bf16_t*)(act + hk::A_Z), 4096, 16, (bf16_t*)(act + hk::A_XBC), hk::XBC_LD, 0}, T_WX, T_H1, T_H1, T_WX + 16};
            pg8::gemm_phase<pg8::EpiChain, pg8::ChainOrder, false>((PG8_LAS unsigned char*)lds, g, S, E, nullptr);
        }
        SEAM(12); PP_END(12); }
    if (IN(13)) { PP_BEGIN(13); ph_ssd_conv(p, lds); SEAM(13); PP_END(13); }
    if (IN(14)) { PP_BEGIN(14);
#if SSD_CHUNK
        ph_ssd_scan_chunk(p, lds);
#else
        ph_ssd_scan_naive(p, lds);
#endif
        SEAM(14); PP_END(14); }
    if (IN(15)) { PP_BEGIN(15); ph_ssd_finish(p, lds); SEAM(15); PP_END(15); }
    if (IN(16)) { PP_BEGIN(16);
        run_gemm(lds, (const bf16_t*)(act + hk::A_Z), (const bf16_t*)(ws + hk::WS_WOUT1), hk::TL, 2048, 4096, pg8::EpiStore{(bf16_t*)(act + hk::A_YO1), 2048, NO_SPLIT, nullptr, 0, 0});
        __syncthreads(); ph_conv_experts(p, 1, lds); SEAM(16);
    }
    if (IN(17)) { PP_BEGIN(17); ph_ln1_router(p, 1, lds, (const bf16_t*)(act + hk::A_YO1), (bf16_t*)(act + hk::A_HA2)); SEAM(17); PP_END(17); }
    if (IN(19)) { PP_BEGIN(19); run_gemm_grouped<pg8::EpiSwiGLU, true>(lds, (const bf16_t*)(act + hk::A_HA2), (const bf16_t*)(ws + hk::WS_WE), 2048, ctl, 1, pg8::EpiSwiGLU{(bf16_t*)(act + hk::A_HB1), 1024, 8}, (const int*)(act + hk::A_ROWS)); SEAM(19); PP_END(19); }
    if (IN(20)) { PP_BEGIN(20); run_gemm_grouped(lds, (const bf16_t*)(act + hk::A_HB1), (const bf16_t*)(ws + hk::WS_WE_DN), 1024, ctl, 1, pg8::EpiStore{(bf16_t*)(act + hk::A_YR1), 2048, NO_SPLIT, nullptr, 0, 8}); SEAM(20); PP_END(20); }
    if (IN(21)) { PP_BEGIN(21); ph_ln2(p, 1, (const bf16_t*)(act + hk::A_YR1), nullptr, lds); }
#undef IN
#undef SEAM
}

extern "C" void kernel_launch(void* const* d_in, const int* in_sizes, int n_in, void* d_out, int out_size, void* d_ws, size_t ws_size, hipStream_t stream) {
    static int grid = 0;
    if (grid == 0) {
        if (n_in != hk::N_IN || ws_size < hk::WS_NEED) { fprintf(stderr, "kernel_launch: need %d inputs and %zu bytes of workspace; got %d, %zu\n", hk::N_IN, (size_t)hk::WS_NEED, n_in, ws_size); grid = -1; return; }
        int dev = 0, cus = 0, per_cu = 0;
        if (hipGetDevice(&dev) != hipSuccess || hipDeviceGetAttribute(&cus, hipDeviceAttributeMultiprocessorCount, dev) != hipSuccess) { grid = -1; return; }
        if (hipFuncSetAttribute((const void*)hybrid_fwd, hipFuncAttributeMaxDynamicSharedMemorySize, hk::LDS_BYTES) != hipSuccess) { fprintf(stderr, "kernel_launch: hipFuncSetAttribute failed\n"); grid = -1; return; }
        if (hipOccupancyMaxActiveBlocksPerMultiprocessor(&per_cu, (const void*)hybrid_fwd, hk::NTHREADS, hk::LDS_BYTES) != hipSuccess || per_cu < 1) fprintf(stderr, "kernel_launch: occupancy query reports %d\n", per_cu);
        (void)hipGetLastError();
        grid = cus;
    }
    if (grid < 0) return;
    (void)hipMemsetAsync((char*)d_ws + hk::WS_ACT + hk::A_ROWS, 0, (size_t)16 * hk::ROWS_CAP * sizeof(int), stream);
    (void)hipMemsetAsync((char*)d_ws + hk::WS_CTL, 0, 64 * 1024, stream);
    Params prm{};
    for (int i = 0; i < hk::N_IN; ++i) prm.in[i] = (const float*)d_in[i];
    prm.out = (float*)d_out; prm.ws = (unsigned char*)d_ws;
#if ONE_LAUNCH
    prm.ph_lo = 0; prm.ph_hi = N_PHASES;
    hipLaunchKernelGGL(hybrid_fwd, dim3(grid), dim3(hk::NTHREADS), hk::LDS_BYTES, stream, prm);
#else
    for (int k = 0; k < N_PHASES; ++k) { prm.ph_lo = k; prm.ph_hi = k + 1; hipLaunchKernelGGL(hybrid_fwd, dim3(grid), dim3(hk::NTHREADS), hk::LDS_BYTES, stream, prm);
#ifdef PROBE_REP_MASK
        if ((PROBE_REP_MASK >> k) & 1u) hipLaunchKernelGGL(hybrid_fwd, dim3(grid), dim3(hk::NTHREADS), hk::LDS_BYTES, stream, prm);
#endif
    }
#endif
}
```

```cpp
#include <hip/hip_runtime.h>
#include <cstdio>
#include <cstdint>
#define ONE_LAUNCH 1
namespace pg8 {
#define PG8_LAS __attribute__((address_space(3)))
typedef unsigned short bf16_t;
typedef short bf16x8 __attribute__((ext_vector_type(8)));
typedef float f32x4 __attribute__((ext_vector_type(4)));
typedef unsigned u32x4 __attribute__((ext_vector_type(4)));
constexpr int BM = 256, BK = 64, HALF = 128, HTB = HALF * BK * 2  , STAGE_BYTES = 8 * HTB, NXCD = 8, WGM = 8;

__host__ __device__ __forceinline__ int lds_byte(int r, int c) { const int st = (r >> 4) * 2 + (c >> 5), rr = r & 15, cc = c & 31, ob = rr * 64 + cc * 2; return st * 1024 + (ob ^ (((ob >> 9) & 1) << 5)); }
__host__ __device__ __forceinline__ void stage_rc(int b, int& R, int& C) { const int st = b / 1024, sb = b % 1024, swz = sb ^ (((sb >> 9) & 1) << 5); R = (st >> 1) * 16 + swz / 64; C = (st & 1) * 32 + (swz % 64) / 2; }
__host__ __device__ __forceinline__ int perm32(int rho) { const int n = rho >> 4, i = rho & 15; return 8 * (i >> 2) + 4 * n + (i & 3); }

struct Unit { int pm, pn; };
struct Gemm { const bf16_t* A; const bf16_t* Bt; int M, N, K; const int* rowmap = nullptr; };

struct StaticOrder {
    int nM, nN, nwg, G, c;
    __host__ __device__ void init(int M, int N, int G_, int c_) { nM = M / BM; nN = N / BM; nwg = nM * nN; G = G_; c = c_; }
    __host__ __device__ bool next(int i, Unit& u) const {
        const long L = (long)i * G + c; if (L >= nwg) return false;
        int wgid = (int)L; { const int q = nwg / NXCD, r = nwg % NXCD, xcd = wgid % NXCD, off = wgid / NXCD; wgid = (xcd < r ? xcd * (q + 1) : r * (q + 1) + (xcd - r) * q) + off; }
        const int nig = WGM * nN, gid = wgid / nig, fm = gid * WGM, gsz = (nM - fm) < WGM ? (nM - fm) : WGM;
        u.pm = fm + ((wgid % nig) % gsz); u.pn = (wgid % nig) / gsz; return true;
    }
    __device__ __forceinline__ void a_ready(const Unit&) const {}
    __device__ __forceinline__ void done(const Unit&) const {}
};
__device__ __forceinline__ unsigned cvt_pk_bf16(float lo, float hi) { unsigned r; asm volatile("v_cvt_pk_bf16_f32 %0, %1, %2" : "=v"(r) : "v"(lo), "v"(hi)); return r; }
typedef unsigned u32x4 __attribute__((ext_vector_type(4)));
struct EpiStore {
    static constexpr bool PERM = true, AFTER_DRAIN = false;
    bf16_t* O; int ld; int split; bf16_t* O2; int ld2; int pn_mod;
    __device__ __forceinline__ void operator()(const f32x4 (&acc)[2][2][4][2], const Unit& u, int wr, int wc, int fr, int fq) const {
        const int pn = pn_mod > 0 ? (u.pn % pn_mod) : u.pn;
        const int row0 = u.pm * BM + wr * 64 + fr;
        bf16_t* base = O; int ldc = ld, colt = pn * BM;
        if (pn >= split) { base = O2; ldc = ld2; colt = (pn - split) * BM; }
        const int col0 = colt + wc * 32 + 8 * fq;
#pragma unroll
        for (int ai = 0; ai < 2; ++ai)
#pragma unroll
            for (int m = 0; m < 4; ++m) { bf16_t* rowp = base + (size_t)(row0 + ai * HALF + m * 16) * ldc + col0;
#pragma unroll
                for (int bj = 0; bj < 2; ++bj) { const f32x4 v0 = acc[ai][bj][m][0], v1 = acc[ai][bj][m][1];
                    u32x4 w; w.x = cvt_pk_bf16(v0[0], v0[1]); w.y = cvt_pk_bf16(v0[2], v0[3]); w.z = cvt_pk_bf16(v1[0], v1[1]); w.w = cvt_pk_bf16(v1[2], v1[3]);
                    *(u32x4*)(rowp + bj * HALF) = w; } }
    }
};
struct EpiSwiGLU {
    static constexpr bool PERM = true, AFTER_DRAIN = false;
    bf16_t* O; int ld; int pn_mod;
    __device__ __forceinline__ void operator()(const f32x4 (&acc)[2][2][4][2], const Unit& u, int wr, int wc, int fr, int fq) const {
        const int pn = u.pn % pn_mod;
        const int row0 = u.pm * BM + wr * 64 + fr, col0 = pn * HALF + wc * 32 + 8 * fq;
#pragma unroll
        for (int ai = 0; ai < 2; ++ai)
#pragma unroll
            for (int m = 0; m < 4; ++m) { bf16_t* rowp = O + (size_t)(row0 + ai * HALF + m * 16) * ld + col0;
                float h[8];
#pragma unroll
                for (int n = 0; n < 2; ++n)
#pragma unroll
                    for (int j = 0; j < 4; ++j) { const float g = acc[ai][0][m][n][j], uu = acc[ai][1][m][n][j]; h[n * 4 + j] = g * __builtin_amdgcn_rcpf(1.0f + __expf(-g)) * uu; }
                u32x4 w; w.x = cvt_pk_bf16(h[0], h[1]); w.y = cvt_pk_bf16(h[2], h[3]); w.z = cvt_pk_bf16(h[4], h[5]); w.w = cvt_pk_bf16(h[6], h[7]);
                *(u32x4*)rowp = w; }
    }
};
struct GroupedOrder {
    int ps[17];
    int ntiles, ncol, G, c, cap;
    __device__ __forceinline__ int expert_of(int rt) const { int e = 0;
#pragma unroll
        for (int q = 1; q < 16; ++q) e = (rt * BM >= ps[q]) ? q : e;
        return e; }
    __device__ __forceinline__ int tile_rt(int i) const {
        if (G == 256 && ncol == 8) { const int rt = i * 32 + 4 * (c & 7) + (c >> 6); return rt < ntiles ? rt : -1; }
        const long L = (long)i * G + c; return L < (long)ntiles * ncol ? (int)(L / ncol) : -1;
    }
    __device__ __forceinline__ bool next(int i, Unit& u) const {
        const int rt = tile_rt(i); if (rt < 0) return false;
        const int pl = (G == 256 && ncol == 8) ? ((c >> 3) & 7) : (int)(((long)i * G + c) % ncol);
        u.pm = rt; u.pn = expert_of(rt) * ncol + pl; return true;
    }
    __device__ __forceinline__ int peek_pm(int i) const { return tile_rt(i); }
    __device__ __forceinline__ int row_base(int rt) const { const int e = expert_of(rt); int pse = 0;
#pragma unroll
        for (int q = 0; q < 16; ++q) pse = e == q ? ps[q] : pse;
        return e * cap + rt * BM - pse; }
    __device__ __forceinline__ void a_ready(const Unit&) const {}
    __device__ __forceinline__ void done(const Unit&) const {}
};

struct ChainOrder {
    int nM1, nN1, pm1, pn1, nM2, nN2, pm2, pn2, G, c;
    __device__ __forceinline__ static void unit_of(int wgid, int nM, int nN, Unit& u) {
        const int nwg = nM * nN;
        { const int q = nwg / NXCD, r = nwg % NXCD, xcd = wgid % NXCD, off = wgid / NXCD; wgid = (xcd < r ? xcd * (q + 1) : r * (q + 1) + (xcd - r) * q) + off; }
        const int nig = WGM * nN, gid = wgid / nig, fm = gid * WGM, gsz = (nM - fm) < WGM ? (nM - fm) : WGM;
        u.pm = fm + ((wgid % nig) % gsz); u.pn = (wgid % nig) / gsz;
    }
    __device__ __forceinline__ bool next(int i, Unit& u) const {
        long L = (long)i * G + c; const int n1 = nM1 * nN1;
        if (L < n1) { unit_of((int)L, nM1, nN1, u); u.pm += pm1; u.pn += pn1; return true; }
        L -= n1; if (L >= (long)nM2 * nN2) return false;
        unit_of((int)L, nM2, nN2, u); u.pm += pm2; u.pn += pn2; return true;
    }
    __device__ __forceinline__ void a_ready(const Unit&) const {}
    __device__ __forceinline__ void done(const Unit&) const {}
};
struct EpiChain {
    static constexpr bool PERM = true, AFTER_DRAIN = false;
    EpiStore e1, e2; int pm1, pn1, pm2, pn2;
    __device__ __forceinline__ void operator()(const f32x4 (&acc)[2][2][4][2], const Unit& u, int wr, int wc, int fr, int fq) const {
        if (u.pm >= pm2) { const Unit v{u.pm - pm2, u.pn - pn2}; e2(acc, v, wr, wc, fr, fq); }
        else { const Unit v{u.pm - pm1, u.pn - pn1}; e1(acc, v, wr, wc, fr, fq); }
    }
};

template <class Epi, class Sched, bool STAMP = false, bool GATHER = false>
__device__ __forceinline__ void gemm_phase(PG8_LAS unsigned char* lds, const Gemm g, const Sched& S, const Epi& E, unsigned long long* stamps) {
    const int tid = threadIdx.x, wid = __builtin_amdgcn_readfirstlane(tid >> 6), lane = tid & 63, wr = wid >> 2, wc = wid & 3, fr = lane & 15, fq = lane >> 4;
    const int K = g.K, nt = K / BK;
    int ts_lo = 0, ts_hi = 0, nts = 0; const unsigned long long rt_entry = STAMP ? (unsigned long long)wall_clock64() : 0ull;
#define PG8_STAMP() do { if (STAMP && wid == 0 && nts < 64) { const unsigned long long _c = (unsigned long long)clock64(); \
        ts_lo = (lane == nts) ? (int)(unsigned)_c : ts_lo; ts_hi = (lane == nts) ? (int)(unsigned)(_c >> 32) : ts_hi; ++nts; } } while (0)
    PG8_STAMP();
    unsigned voffA[2], voffB[2]; int gR[2]; unsigned gC2[2];
    unsigned gcx[2][2] = {{0u, 0u}, {0u, 0u}}, gnx[2][2] = {{0u, 0u}, {0u, 0u}};
#define PG8_GOFF(dst, pm_) do { _Pragma("unroll") for (int h_ = 0; h_ < 2; ++h_) _Pragma("unroll") for (int i_ = 0; i_ < 2; ++i_) \
        dst[h_][i_] = (unsigned)g.rowmap[S.row_base(pm_) + h_ * HALF + gR[i_]] * (unsigned)(K * 2) + gC2[i_]; } while (0)
#define PG8_STAGE_A(bufoff, base, h, usenext) do { if constexpr (!GATHER) { PG8_STAGE(bufoff, (base) + ((h) ? hstep : (size_t)0), voffA); } \
        else { const unsigned vo_[2] = {(usenext) ? gnx[h][0] : gcx[h][0], (usenext) ? gnx[h][1] : gcx[h][1]}; PG8_STAGE(bufoff, base, vo_); } } while (0)
#pragma unroll
    for (int i = 0; i < 2; ++i) { int R, C; stage_rc(tid * 16 + i * 8192, R, C); const int Rb = Epi::PERM ? ((R & ~31) + perm32(R & 31)) : R;
        voffA[i] = (unsigned)(R * K + C) * 2u; voffB[i] = (unsigned)(Rb * K + C) * 2u; gR[i] = R; gC2[i] = (unsigned)C * 2u; }
    const size_t kstep = (size_t)(BK * 2);
    const size_t hstep = (size_t)HALF * K * 2;
    const size_t tstep = 2 * hstep;
    const unsigned ldsw = (unsigned)wid * 1024u;
    const int aoff = lds_byte(wr * 64 + fr, fq * 8), boff = lds_byte(wc * 32 + fr, fq * 8);
#define PG8_SA(b, h) (((b) * 2 + (h)) * HTB)
#define PG8_SB(b, h) ((4 + (b) * 2 + (h)) * HTB)
#define PG8_STAGE(bufoff, gbase, voff) do { _Pragma("unroll") for (int _i = 0; _i < 2; ++_i) \
        __builtin_amdgcn_global_load_lds((const unsigned*)((const char*)(gbase) + (voff)[_i]), (PG8_LAS unsigned*)(lds + (bufoff) + ldsw + _i * 8192), 16, 0, 0); } while (0)
#define PG8_LDA(dst, b, h) do { _Pragma("unroll") for (int m = 0; m < 4; ++m) _Pragma("unroll") for (int k = 0; k < 2; ++k) dst[m][k] = *(const PG8_LAS bf16x8*)(lds + PG8_SA(b, h) + aoff + m * 2048 + k * 1024); } while (0)
#define PG8_LDB(dst, b, h) do { _Pragma("unroll") for (int n = 0; n < 2; ++n) _Pragma("unroll") for (int k = 0; k < 2; ++k) dst[n][k] = *(const PG8_LAS bf16x8*)(lds + PG8_SB(b, h) + boff + n * 2048 + k * 1024); } while (0)
#define PG8_MMA(ai, bj, At, Bt) do { __builtin_amdgcn_s_setprio(1); _Pragma("unroll") for (int m = 0; m < 4; ++m) _Pragma("unroll") for (int n = 0; n < 2; ++n) _Pragma("unroll") for (int k = 0; k < 2; ++k) \
        acc[ai][bj][m][n] = __builtin_amdgcn_mfma_f32_16x16x32_bf16(Bt[n][k], At[m][k], acc[ai][bj][m][n], 0, 0, 0); __builtin_amdgcn_s_setprio(0); } while (0)
#define PG8_WAIT_V(n) asm volatile("s_waitcnt vmcnt(" #n ")" ::: "memory")
#define PG8_WAIT_L(n) asm volatile("s_waitcnt lgkmcnt(" #n ")" ::: "memory")
#define PG8_BAR __builtin_amdgcn_s_barrier()
#define PG8_SCHED __builtin_amdgcn_sched_barrier(0)
    Unit cur, nxt; int ui = 0;
    if (!S.next(0, cur)) return;
    f32x4 acc[2][2][4][2];
#pragma unroll
    for (int a = 0; a < 2; ++a)
#pragma unroll
        for (int b = 0; b < 2; ++b)
#pragma unroll
            for (int m = 0; m < 4; ++m)
#pragma unroll
                for (int n = 0; n < 2; ++n) acc[a][b][m][n] = (f32x4){0.f, 0.f, 0.f, 0.f};
    bf16x8 At[4][2], B0[2][2], B1[2][2];
    const char* cA = (const char*)g.A + (GATHER ? (size_t)0 : (size_t)cur.pm * tstep); const char* cB = (const char*)g.Bt + (size_t)cur.pn * tstep;
    S.a_ready(cur);
    if constexpr (GATHER) PG8_GOFF(gcx, cur.pm);
    PG8_STAGE(PG8_SB(0, 0), cB, voffB); PG8_STAGE_A(PG8_SA(0, 0), cA, 0, false); PG8_STAGE(PG8_SB(0, 1), cB + hstep, voffB); PG8_STAGE_A(PG8_SA(0, 1), cA, 1, false);
    if (wr == 1) PG8_BAR;
    PG8_WAIT_V(4); PG8_BAR;
    PG8_STAGE(PG8_SB(1, 0), cB + kstep, voffB); PG8_STAGE_A(PG8_SA(1, 0), cA + kstep, 0, false); PG8_STAGE(PG8_SB(1, 1), cB + hstep + kstep, voffB);
    PG8_WAIT_V(6); PG8_BAR;
    PG8_STAMP();
    for (;;) {
        int graw[2][2] = {{0, 0}, {0, 0}};
        if constexpr (GATHER) { const int pmn_ = S.peek_pm(ui + 1);
            if (pmn_ >= 0) { _Pragma("unroll") for (int h_ = 0; h_ < 2; ++h_) _Pragma("unroll") for (int i_ = 0; i_ < 2; ++i_) graw[h_][i_] = g.rowmap[S.row_base(pmn_) + h_ * HALF + gR[i_]]; } }
        const bool has_next = S.next(ui + 1, nxt);
        const char* nA = (has_next && !GATHER) ? (const char*)g.A + (size_t)nxt.pm * tstep : cA; const char* nB = has_next ? (const char*)g.Bt + (size_t)nxt.pn * tstep : cB;
        if constexpr (GATHER) { _Pragma("unroll") for (int h_ = 0; h_ < 2; ++h_) _Pragma("unroll") for (int i_ = 0; i_ < 2; ++i_) gnx[h_][i_] = has_next ? (unsigned)graw[h_][i_] * (unsigned)(K * 2) + gC2[i_] : gcx[h_][i_]; }
        for (int t = 0; t < nt; t += 2) {
            const bool last = (t == nt - 2);
            const char* a1 = cA + (size_t)(t + 1) * kstep;
            const char* a2 = last ? nA : cA + (size_t)(t + 2) * kstep; const char* b2 = last ? nB : cB + (size_t)(t + 2) * kstep;
            const char* a3 = a2 + kstep; const char* b3 = b2 + kstep;
            if (last && has_next) S.a_ready(nxt);
            PG8_LDB(B0, 0, 0); PG8_SCHED; PG8_LDA(At, 0, 0); PG8_STAGE_A(PG8_SA(1, 1), a1, 1, false);
            PG8_WAIT_L(8); PG8_BAR; PG8_WAIT_L(0); PG8_MMA(0, 0, At, B0); PG8_BAR; PG8_SCHED;
            PG8_LDB(B1, 0, 1); PG8_STAGE(PG8_SB(0, 0), b2, voffB);
            PG8_BAR; PG8_WAIT_L(0); PG8_MMA(0, 1, At, B1); PG8_BAR;
            PG8_LDA(At, 0, 1); PG8_STAGE_A(PG8_SA(0, 0), a2, 0, last);
            PG8_BAR; PG8_WAIT_L(0); PG8_MMA(1, 0, At, B0); PG8_BAR; PG8_SCHED;
            PG8_STAGE(PG8_SB(0, 1), b2 + hstep, voffB);
            PG8_WAIT_V(6); PG8_BAR; PG8_MMA(1, 1, At, B1); PG8_BAR;
            PG8_LDB(B0, 1, 0); PG8_SCHED; PG8_LDA(At, 1, 0); PG8_STAGE_A(PG8_SA(0, 1), a2, 1, last);
            PG8_WAIT_L(8); PG8_BAR; PG8_WAIT_L(0); PG8_MMA(0, 0, At, B0); PG8_BAR; PG8_SCHED;
            PG8_LDB(B1, 1, 1); PG8_STAGE(PG8_SB(1, 0), b3, voffB);
            PG8_BAR; PG8_WAIT_L(0); PG8_MMA(0, 1, At, B1); PG8_BAR;
            PG8_LDA(At, 1, 1); PG8_STAGE_A(PG8_SA(1, 0), a3, 0, last);
            PG8_BAR; PG8_WAIT_L(0); PG8_MMA(1, 0, At, B0); PG8_BAR; PG8_SCHED;
            PG8_STAGE(PG8_SB(1, 1), b3 + hstep, voffB);
            PG8_WAIT_V(6); PG8_BAR; PG8_MMA(1, 1, At, B1); PG8_BAR;
        }
        PG8_STAMP();
        if constexpr (!Epi::AFTER_DRAIN) { E(acc, cur, wr, wc, fr, fq); S.done(cur); }
        PG8_STAMP();
        if (!has_next) break;
#pragma unroll
        for (int a = 0; a < 2; ++a)
#pragma unroll
            for (int b = 0; b < 2; ++b)
#pragma unroll
                for (int m = 0; m < 4; ++m)
#pragma unroll
                    for (int n = 0; n < 2; ++n) acc[a][b][m][n] = (f32x4){0.f, 0.f, 0.f, 0.f};
        cur = nxt; cA = nA; cB = nB; ++ui;
        if constexpr (GATHER) { gcx[0][0] = gnx[0][0]; gcx[0][1] = gnx[0][1]; gcx[1][0] = gnx[1][0]; gcx[1][1] = gnx[1][1]; }
    }
    PG8_WAIT_V(0);
    if (wr == 0) PG8_BAR;
    PG8_BAR;
    if constexpr (Epi::AFTER_DRAIN) { E.fused(acc, cur, wr, wc, fr, fq, lds, wid, lane); S.done(cur); }
    PG8_STAMP();
    if (STAMP && wid == 0) { stamps[lane] = lane < nts ? (((unsigned long long)(unsigned)ts_hi << 32) | (unsigned)ts_lo) : 0ull;
        if (lane == 62) stamps[62] = rt_entry; if (lane == 63) stamps[63] = (unsigned long long)wall_clock64(); }
#undef PG8_STAMP
#undef PG8_SA
#undef PG8_SB
#undef PG8_STAGE
#undef PG8_STAGE_A
#undef PG8_GOFF
#undef PG8_LDA
#undef PG8_LDB
#undef PG8_MMA
#undef PG8_WAIT_V
#undef PG8_WAIT_L
#undef PG8_BAR
#undef PG8_SCHED
}
}

#define XB_TMO      128
#define XB_XCNT(j)  (256  + 64 * (j))
#define XB_XSUB(j)  (1280 + 64 * (j))
#define XB_XGEN(j)  (2304 + 64 * (j))
#define XB_TOP      3328
#define XB_TOPGEN   3392
#define XCD_BAR_WORDS 3456
#define XB_SPIN_CAP (1u << 21)
#define LAS __attribute__((address_space(3)))

__device__ __forceinline__ unsigned xb_ld(unsigned* p)              { return __hip_atomic_load(p, __ATOMIC_RELAXED, __HIP_MEMORY_SCOPE_AGENT); }
__device__ __forceinline__ unsigned xb_add(unsigned* p, unsigned v) { return __hip_atomic_fetch_add(p, v, __ATOMIC_RELAXED, __HIP_MEMORY_SCOPE_AGENT); }
__device__ __forceinline__ unsigned xb_xcc_id() { return (unsigned)__builtin_amdgcn_s_getreg((3 << 11) | 20) & 0xFu; }
#define XB_SPIN(cond, bar) do { unsigned _sp = 0; while (cond) { __builtin_amdgcn_s_sleep(1); \
    if ((++_sp & 255u) == 0u) { if (xb_ld(&(bar)[XB_TMO])) break; if (_sp > XB_SPIN_CAP) { atomicAdd(&(bar)[XB_TMO], 1u); break; } } } } while (0)

struct XcdBarrier {
    unsigned* bar; unsigned x;
    volatile LAS unsigned* st;
};

__device__ __forceinline__ XcdBarrier xcd_barrier_post(unsigned* bar, volatile LAS unsigned* st) {
    XcdBarrier b; b.bar = bar; b.x = xb_xcc_id(); b.st = st;
    if (threadIdx.x == 0) (void)xb_add(&bar[XB_XCNT(b.x)], 1u);
    return b;
}
__device__ __forceinline__ void xcd_barrier_complete(unsigned* bar, unsigned x, unsigned& nloc, unsigned& nx) {
    const unsigned G = gridDim.x * gridDim.y * gridDim.z;
    unsigned sum, cnt, mine, sp = 0u;
    for (;;) {
        sum = 0u; cnt = 0u; mine = 0u;
#pragma unroll
        for (unsigned j = 0; j < 16; ++j) { const unsigned c = xb_ld(&bar[XB_XCNT(j)]); sum += c; cnt += (c > 0u) ? 1u : 0u; mine = (j == x) ? c : mine; }
        if (sum == G) break;
        __builtin_amdgcn_s_sleep(1);
        if ((++sp & 255u) == 0u) { if (xb_ld(&bar[XB_TMO])) break; if (sp > XB_SPIN_CAP) { atomicAdd(&bar[XB_TMO], 1u); break; } }
    }
    nloc = mine > 0u ? mine : 1u; nx = cnt > 0u ? cnt : 1u;
}

__device__ __forceinline__ void xcd_barrier(const XcdBarrier& b) {
    asm volatile("s_waitcnt vmcnt(0)" ::: "memory");
    __syncthreads();
    if (threadIdx.x == 0) {
        unsigned* bar = b.bar;
        __builtin_amdgcn_s_waitcnt(0);
        unsigned nloc = b.st[0], nx = b.st[1];
        if (nloc == 0u) { xcd_barrier_complete(bar, b.x, nloc, nx); b.st[0] = nloc; b.st[1] = nx; }
        const unsigned old = xb_add(&bar[XB_XSUB(b.x)], 1u);
        const unsigned gen = old / nloc;
        if (old + 1u == (gen + 1u) * nloc) {
            __builtin_amdgcn_fence(__ATOMIC_RELEASE, "agent");
            asm volatile("s_waitcnt vmcnt(0)" ::: "memory");
            const unsigned og = xb_add(&bar[XB_TOP], 1u);
            const unsigned tg = og / nx;
            if (og + 1u == (tg + 1u) * nx) xb_add(&bar[XB_TOPGEN], 1u);
            else XB_SPIN(xb_ld(&bar[XB_TOPGEN]) == tg, bar);
            __builtin_amdgcn_fence(__ATOMIC_ACQUIRE, "agent");
            xb_add(&bar[XB_XGEN(b.x)], 1u);
            asm volatile("s_waitcnt vmcnt(0)" ::: "memory");
        } else {
            XB_SPIN(xb_ld(&bar[XB_XGEN(b.x)]) == gen, bar);
            __builtin_amdgcn_fence(__ATOMIC_ACQUIRE, "agent");
            asm volatile("s_waitcnt vmcnt(0)" ::: "memory");
        }
    }
    __syncthreads();
}
typedef unsigned short bf16_t;
typedef float f32x4 __attribute__((ext_vector_type(4)));
typedef unsigned u32x4 __attribute__((ext_vector_type(4)));
typedef unsigned u32x2 __attribute__((ext_vector_type(2)));
namespace hk {
constexpr int D = 2048, SEQ = 16384, CTXL = 256, TL = 32768, TC = 512, TA = 33280;
constexpr float ALPHA = 1.41421356237309515f;
constexpr float LN_EPS = 1e-6f;
constexpr int NTHREADS = 512;
constexpr int LDS_BYTES = 156 * 1024;
enum { I_X = 0, I_C, I_CTX, I_CCTX, I_RW, I_RB, I_MODW, I_MODB, I_LNG, I_LNB, I_EG, I_EU, I_ED, I_ABIN, I_ABOUT, I_HCW, I_HCB, I_FW1, I_FB1, I_FFR1, I_FW2, I_FB2, I_FFR2, I_FW3, I_HLB,
       I_GW2, I_GB, I_GNG, I_SWIN, I_SCW, I_SCB, I_SDTB, I_SALOG, I_SD, I_SNG, I_SWOUT, N_IN };
constexpr size_t MiB = 1024 * 1024;
constexpr size_t WS_CTL = 0;
constexpr int CW_BAR = 0;
constexpr int CW_CNT = 4096;
constexpr int CW_NT = 4096 + 256;
constexpr int CW_TILEE = 4096 + 512;
constexpr int CW_HYQ = 4096 + 1280;
constexpr int CW_PROBE = 4096 + 1344;
constexpr int CW_CTXF = 4096 + 1408;
constexpr size_t WS_MOD = 64 * 1024;
constexpr size_t WS_CTXS = 384 * 1024;
constexpr size_t WS_MISC = 4608 * 1024;
constexpr size_t MISC_EXP = 0, MISC_GATE = 272 * 1024, MISC_SLOT = 544 * 1024, MISC_DEST = 816 * 1024, MISC_ROWTOK = 1088 * 1024;
constexpr int ROWTOK_N = 70656;
constexpr size_t WS_WOUT1 = 6 * MiB;
constexpr size_t WS_WE = 22 * MiB;
constexpr size_t WS_WE_DN = WS_WE + 128 * MiB;
constexpr size_t WS_R0 = 214 * MiB;
constexpr size_t WS_WU = WS_R0;
constexpr size_t WS_WGLA = WS_R0 + 16 * MiB;
constexpr size_t WS_WOUT0 = WS_R0 + 25 * MiB;
constexpr size_t WS_W3T = WS_R0 + 33 * MiB;
constexpr size_t WS_HID2 = WS_R0 + 35 * MiB;
constexpr size_t WS_HID2C = WS_R0 + 43 * MiB;
constexpr size_t WS_WSSDIN = WS_R0 + 44 * MiB;
constexpr size_t WS_ACT = 299 * MiB;
constexpr size_t A_HA = 0;
constexpr size_t A_UT = 130 * MiB;
constexpr size_t A_GL = 390 * MiB;
constexpr size_t A_HF = 537 * MiB;
constexpr size_t A_HFC = 665 * MiB;
constexpr size_t A_YT = 667 * MiB;
constexpr size_t A_OF = 732 * MiB;
constexpr size_t A_OB = 797 * MiB;
constexpr size_t A_QK = 862 * MiB;
constexpr size_t A_VTG = 325 * MiB;
constexpr size_t A_EB = 992 * MiB;
constexpr size_t A_HYTMP = 1000 * MiB;
constexpr size_t A_HYS = 0;
constexpr size_t A_YO = 130 * MiB;
constexpr size_t A_AG = 260 * MiB;
constexpr size_t A_HB = 536 * MiB;
constexpr size_t A_YR = 0;
constexpr size_t A_HA1 = 700 * MiB;
constexpr size_t A_Z = 0;
constexpr size_t A_XBC = 260 * MiB;
constexpr size_t A_XT = 407 * MiB;
constexpr size_t A_XC = 667 * MiB;
constexpr size_t A_XTG = 797 * MiB;
constexpr size_t A_DT = 1057 * MiB;
constexpr size_t A_YF = 260 * MiB;
constexpr size_t WS_YB = WS_WE;
constexpr size_t A_YO1 = 260 * MiB;
constexpr size_t A_HA2 = 400 * MiB;
constexpr size_t A_AG1 = 530 * MiB;
constexpr size_t A_HB1 = 806 * MiB;
constexpr size_t A_YR1 = 0;
constexpr size_t A_ROWS = 1075 * MiB;
constexpr int ROWS_CAP = 33280;
constexpr size_t WS_NEED = WS_ACT + 1078 * MiB;
constexpr int XBC_LD = 2304, GL_LD = 2304, GL_G = 1024, GL_GK = 2048;
}

struct Params { const float* in[hk::N_IN]; float* out; unsigned char* ws; int ph_lo, ph_hi; };

__device__ __forceinline__ float bf2f(bf16_t v) { return __uint_as_float(((unsigned)v) << 16); }
__device__ __forceinline__ bf16_t f2bf(float f) { unsigned u = __float_as_uint(f); u += 0x7FFFu + ((u >> 16) & 1u); return (bf16_t)(u >> 16); }
typedef __bf16 hw_bf16x2 __attribute__((ext_vector_type(2)));
typedef float hw_f32x2 __attribute__((ext_vector_type(2)));
__device__ __forceinline__ unsigned pk2(float lo, float hi) { const hw_f32x2 f = {lo, hi}; const hw_bf16x2 v = __builtin_convertvector(f, hw_bf16x2); return __builtin_bit_cast(unsigned, v); }
__device__ __forceinline__ float silu_f(float v) { return v * __builtin_amdgcn_rcpf(1.0f + __expf(-v)); }
__device__ __forceinline__ float wave_sum(float v) {
#pragma unroll
    for (int o = 32; o > 0; o >>= 1) v += __shfl_xor(v, o);
    return v;
}
__device__ __forceinline__ void unpack8(const u32x4 w, float (&f)[8]) {
    f[0] = __uint_as_float(w.x << 16); f[1] = __uint_as_float(w.x & 0xFFFF0000u); f[2] = __uint_as_float(w.y << 16); f[3] = __uint_as_float(w.y & 0xFFFF0000u);
    f[4] = __uint_as_float(w.z << 16); f[5] = __uint_as_float(w.z & 0xFFFF0000u); f[6] = __uint_as_float(w.w << 16); f[7] = __uint_as_float(w.w & 0xFFFF0000u);
}
__device__ __forceinline__ int mod_vec(int r) { return r < hk::TL ? (r >> 14) : 2; }
#define MODP(ws, l, mv, k) ((const float*)((ws) + hk::WS_MOD) + ((size_t)((l) * 3 + (mv)) * 6 + (k)) * 2048)
__device__ __forceinline__ void ph_mod(const Params& p, unsigned char* ldsb) {
    float* svec = (float*)ldsb; float* red = svec + 3 * 2048;
    const int tid = threadIdx.x;
    const float* c = p.in[hk::I_C]; const float* cc = p.in[hk::I_CCTX];
    for (int i = tid; i < 3 * 2048; i += 512) { const float v = i < 4096 ? c[i] : cc[i - 4096]; svec[i] = v / (1.0f + expf(-v)); }
    __syncthreads();
    float* MOD = (float*)(p.ws + hk::WS_MOD);
    for (int slab = blockIdx.x; slab < 768; slab += gridDim.x) {
        const int l = slab / 384, j0 = (slab % 384) * 32;
        const float* W = p.in[hk::I_MODW] + (size_t)l * 2048 * 12288;
        const int cq = tid & 7, rg = tid >> 3;
        float acc[3][4];
#pragma unroll
        for (int v = 0; v < 3; ++v)
#pragma unroll
            for (int j = 0; j < 4; ++j) acc[v][j] = 0.f;
#pragma unroll 4
        for (int i = 0; i < 32; ++i) {
            const int r = rg + 64 * i;
            const f32x4 w = *(const f32x4*)(W + (size_t)r * 12288 + j0 + cq * 4);
#pragma unroll
            for (int v = 0; v < 3; ++v) { const float s = svec[v * 2048 + r];
#pragma unroll
                for (int j = 0; j < 4; ++j) acc[v][j] += s * w[j]; }
        }
#pragma unroll
        for (int v = 0; v < 3; ++v)
#pragma unroll
            for (int j = 0; j < 4; ++j) red[tid * 12 + v * 4 + j] = acc[v][j];
        __syncthreads();
        if (tid < 96) {
            const int v = tid >> 5, col = tid & 31, q = col >> 2, j = col & 3;
            float s = 0.f;
            for (int g = 0; g < 64; ++g) s += red[(g * 8 + q) * 12 + v * 4 + j];
            const int jj = j0 + col;
            MOD[(size_t)(l * 3 + v) * 12288 + jj] = s + p.in[hk::I_MODB][l * 12288 + jj];
        }
        __syncthreads();
    }
}

__device__ __forceinline__ void conv_mat(const float* src, int ld, int K, int ncol0, int nvalid, int npad, bf16_t* dst, int Kd, int mode, unsigned char* ldsb) {
    float* tile = (float*)ldsb;
    const int tid = threadIdx.x, nkt = K / 64, ntile = nkt * (npad / 64);
    for (int t = blockIdx.x; t < ntile; t += gridDim.x) {
        const int kt = t % nkt, nt = t / nkt, k0 = kt * 64, n0 = nt * 64;
#pragma unroll
        for (int it = 0; it < 2; ++it) {
            const int r = (tid >> 4) + 32 * it, c4 = (tid & 15) * 4;
            f32x4 v = (f32x4){0.f, 0.f, 0.f, 0.f};
            if (n0 + c4 < nvalid) v = *(const f32x4*)(src + (size_t)(k0 + r) * ld + ncol0 + n0 + c4);
            tile[r * 65 + c4 + 0] = v[0]; tile[r * 65 + c4 + 1] = v[1]; tile[r * 65 + c4 + 2] = v[2]; tile[r * 65 + c4 + 3] = v[3];
        }
        __syncthreads();
        {
            const int n = tid >> 3, kq = tid & 7;
            float f[8];
#pragma unroll
            for (int j = 0; j < 8; ++j) f[j] = tile[(kq * 8 + j) * 65 + n];
            int drow = n0 + n;
            if (mode != 0) drow = 256 * (n0 >> 7) + (n0 & 127) + n + (mode == 2 ? 128 : 0);
            u32x4 w; w.x = pk2(f[0], f[1]); w.y = pk2(f[2], f[3]); w.z = pk2(f[4], f[5]); w.w = pk2(f[6], f[7]);
            *(u32x4*)(dst + (size_t)drow * Kd + k0 + kq * 8) = w;
        }
        __syncthreads();
    }
}
__device__ __forceinline__ void ph_conv_experts(const Params& p, int layer, unsigned char* ldsb) {
    bf16_t* GU = (bf16_t*)(p.ws + hk::WS_WE); bf16_t* DN = (bf16_t*)(p.ws + hk::WS_WE_DN);
    for (int e = 0; e < 16; ++e) {
        const size_t eo = ((size_t)layer * 16 + e) * 2048 * 1024;
        conv_mat(p.in[hk::I_EG] + eo, 1024, 2048, 0, 1024, 1024, GU + (size_t)e * 2048 * 2048, 2048, 1, ldsb);
        conv_mat(p.in[hk::I_EU] + eo, 1024, 2048, 0, 1024, 1024, GU + (size_t)e * 2048 * 2048, 2048, 2, ldsb);
        conv_mat(p.in[hk::I_ED] + eo, 2048, 1024, 0, 2048, 2048, DN + (size_t)e * 2048 * 1024, 1024, 0, ldsb);
    }
}
__device__ __forceinline__ void ph_conv_weights(const Params& p, unsigned char* ldsb) {
    unsigned char* ws = p.ws;
    conv_mat(p.in[hk::I_ABIN], 6176, 2048, 0, 3072, 3072, (bf16_t*)(ws + hk::WS_WU), 2048, 0, ldsb);
    conv_mat(p.in[hk::I_ABIN], 6176, 2048, 3072 + 1024, 1024, 1024, (bf16_t*)(ws + hk::WS_WU) + (size_t)3072 * 2048, 2048, 0, ldsb);
    conv_mat(p.in[hk::I_ABIN], 6176, 2048, 3072, 1024, 1024, (bf16_t*)(ws + hk::WS_WGLA), 2048, 0, ldsb);
    conv_mat(p.in[hk::I_ABIN], 6176, 2048, 3072 + 2048, 1056, 1280, (bf16_t*)(ws + hk::WS_WGLA) + (size_t)1024 * 2048, 2048, 0, ldsb);
    conv_mat(p.in[hk::I_ABOUT], 2048, 2048, 0, 2048, 2048, (bf16_t*)(ws + hk::WS_WOUT0), 2048, 0, ldsb);
    conv_mat(p.in[hk::I_SWIN], 10368, 2048, 4096, 4096, 4096, (bf16_t*)(ws + hk::WS_WSSDIN), 2048, 0, ldsb);
    conv_mat(p.in[hk::I_SWIN], 10368, 2048, 0, 4096, 4096, (bf16_t*)(ws + hk::WS_WSSDIN) + (size_t)4096 * 2048, 2048, 0, ldsb);
    conv_mat(p.in[hk::I_SWIN], 10368, 2048, 8192, 2176, 2304, (bf16_t*)(ws + hk::WS_WSSDIN) + (size_t)8192 * 2048, 2048, 0, ldsb);
    conv_mat(p.in[hk::I_SWOUT], 2048, 4096, 0, 2048, 2048, (bf16_t*)(ws + hk::WS_WOUT1), 4096, 0, ldsb);
    bf16_t* W3T = (bf16_t*)(ws + hk::WS_W3T); const float* w3 = p.in[hk::I_FW3];
    for (int i = blockIdx.x * 512 + threadIdx.x; i < 4096 * 32; i += gridDim.x * 512) {
        const int col = i >> 5, k8 = (i & 31) * 8;
        u32x4 w = (u32x4){0u, 0u, 0u, 0u};
        if (k8 < 64) { float f[8];
#pragma unroll
            for (int j = 0; j < 8; ++j) f[j] = w3[(size_t)(k8 + j) * 4096 + col];
            w.x = pk2(f[0], f[1]); w.y = pk2(f[2], f[3]); w.z = pk2(f[4], f[5]); w.w = pk2(f[6], f[7]); }
        *(u32x4*)(W3T + (size_t)col * 256 + k8) = w;
    }
}
__device__ __forceinline__ void ph_hid(const Params& p, unsigned char* ldsb) {
    float* w1 = (float*)ldsb; float* b1 = w1 + 33 * 64; float* fr1 = b1 + 64; float* w2 = fr1 + 64; float* b2 = w2 + 64 * 64; float* fr2 = b2 + 64; float* h1 = fr2 + 64;
    const int tid = threadIdx.x;
    for (int i = tid; i < 33 * 64; i += 512) w1[i] = p.in[hk::I_FW1][i];
    for (int i = tid; i < 64 * 64; i += 512) w2[i] = p.in[hk::I_FW2][i];
    if (tid < 64) { b1[tid] = p.in[hk::I_FB1][tid]; fr1[tid] = p.in[hk::I_FFR1][tid]; b2[tid] = p.in[hk::I_FB2][tid]; fr2[tid] = p.in[hk::I_FFR2][tid]; }
    __syncthreads();
    const int j = tid & 63, pl = tid >> 6;
    bf16_t* HID2 = (bf16_t*)(p.ws + hk::WS_HID2); bf16_t* HID2C = (bf16_t*)(p.ws + hk::WS_HID2C);
    for (int pg = blockIdx.x; pg < (16384 + 256) / 8; pg += gridDim.x) {
        const int pid = pg * 8 + pl;
        const bool lat = pid < 16384; const int L = lat ? 16384 : 256, pos = lat ? pid : pid - 16384;
        const float t = (float)pos / (float)(L - 1);
        float s = b1[j] + t * w1[j];
        for (int b = 0; b < 16; ++b) {
            const float band = 1e-4f + (float)b * ((15.0f - 1e-4f) / 15.0f);
            float turns = band * (float)pos / (float)L; turns -= floorf(turns);
            const float ang = 6.283185307179586f * turns;
            s += cosf(ang) * w1[(1 + b) * 64 + j] - sinf(ang) * w1[(17 + b) * 64 + j];
        }
        h1[pl * 64 + j] = sinf(fr1[j] * s);
        __syncthreads();
        float s2 = b2[j];
        for (int i = 0; i < 64; ++i) s2 += h1[pl * 64 + i] * w2[i * 64 + j];
        const float v = sinf(fr2[j] * s2);
        bf16_t* row = (lat ? HID2 : HID2C) + (size_t)pos * 256;
        row[j] = f2bf(v); row[64 + j] = 0; row[128 + j] = 0; row[192 + j] = 0;
        __syncthreads();
    }
}
__device__ __forceinline__ void ph_modulate0(const Params& p) {
    const int lane = threadIdx.x & 63, wave = threadIdx.x >> 6;
    bf16_t* HA = (bf16_t*)(p.ws + hk::WS_ACT + hk::A_HA);
    for (int r = blockIdx.x * 8 + wave; r < hk::TA; r += gridDim.x * 8) {
        const int mv = mod_vec(r);
        const float* xin = r < hk::TL ? p.in[hk::I_X] + (size_t)r * 2048 : p.in[hk::I_CTX] + (size_t)(r - hk::TL) * 2048;
        const float* sh = MODP(p.ws, 0, mv, 0); const float* sc = MODP(p.ws, 0, mv, 1);
#pragma unroll
        for (int i = 0; i < 8; ++i) {
            const int j = 4 * (lane + 64 * i);
            const f32x4 x = *(const f32x4*)(xin + j), a = *(const f32x4*)(sc + j), b = *(const f32x4*)(sh + j);
            u32x2 w; w.x = pk2(x[0] * (1.f + a[0]) + b[0], x[1] * (1.f + a[1]) + b[1]); w.y = pk2(x[2] * (1.f + a[2]) + b[2], x[3] * (1.f + a[3]) + b[3]);
            *(u32x2*)(HA + (size_t)r * 2048 + j) = w;
        }
    }
}

template <bool STAGE>
__device__ __forceinline__ void ph_ln1_router(const Params& p, int layer, unsigned char* ldsb, const bf16_t* YO, bf16_t* TOK) {
    float* rwT = (float*)ldsb; int* lcnt = (int*)(ldsb + 131072); int* lbase = lcnt + 16;
    float* Lmv = (float*)(ldsb + 131072 + 256); constexpr bool stage = STAGE; int mvcur = -1;
    const int tid = threadIdx.x, lane = tid & 63, wave = __builtin_amdgcn_readfirstlane(tid >> 6);
    const int T = layer == 0 ? hk::TA : hk::TL;
    for (int i = tid; i < 2048 * 16; i += 512) { const int j = i >> 4, e = i & 15; rwT[e * 2048 + j] = p.in[hk::I_RW][i]; }
    if (tid < 16) lcnt[tid] = 0;
    __syncthreads();
    float* CTXS = (float*)(p.ws + hk::WS_CTXS); int* ROWS = (int*)(p.ws + hk::WS_ACT + hk::A_ROWS);
    int* EXPERT = (int*)(p.ws + hk::WS_MISC + hk::MISC_EXP); float* GATE = (float*)(p.ws + hk::WS_MISC + hk::MISC_GATE); int* SLOT = (int*)(p.ws + hk::WS_MISC + hk::MISC_SLOT);
    const float* lng = p.in[hk::I_LNG] + (size_t)(layer * 2 + 0) * 2048; const float* lnb = p.in[hk::I_LNB] + (size_t)(layer * 2 + 0) * 2048;
    const float* rb = p.in[hk::I_RB];
    const bool deal0 = layer == 0 && gridDim.x == 256;
    const int nrnd = deal0 ? 17 : (T + (int)gridDim.x * 8 - 1) / ((int)gridDim.x * 8);
    auto row_at = [&](int kk) -> int {
        const int b = (int)blockIdx.x;
        if (!deal0) { const int r = b * 8 + wave + kk * (int)gridDim.x * 8; return r < T ? r : -1; }
        if (kk < 16) return (b >= 240 && kk < 4) ? -1 : b * 8 + wave + kk * 2048;
        if (b < 64) return hk::TL + b * 8 + wave;
        if (b < 128) { const int e = (b - 64) * 8 + wave, k4 = e >> 7, rem = e & 127; return (240 + (rem >> 3)) * 8 + (rem & 7) + k4 * 2048; }
        return -1;
    };
    for (int kk = 0; kk < nrnd; ++kk) {
        if (stage) { const int mvn = kk < 8 ? 0 : kk < 16 ? 1 : (blockIdx.x < 64 ? 2 : 0);
            if (mvn != mvcur) { __syncthreads(); int t0 = tid; asm volatile("" : "+v"(t0));
                for (int v = 0; v < 3; ++v) *(f32x4*)(Lmv + v * 2048 + t0 * 4) = *(const f32x4*)(MODP(p.ws, layer, mvn, 2 + v) + t0 * 4);
                __syncthreads(); mvcur = mvn; } }
        const int r = row_at(kk); if (r < 0) continue;
        if (deal0 && kk == 16 && blockIdx.x < 64) {
            const unsigned* fl = (const unsigned*)(p.ws + hk::WS_CTL) + hk::CW_CTXF; unsigned sp = 0u;
            while (__hip_atomic_load(fl, __ATOMIC_RELAXED, __HIP_MEMORY_SCOPE_AGENT) < 16u && ++sp < (1u << 22)) __builtin_amdgcn_s_sleep(2);
            __builtin_amdgcn_fence(__ATOMIC_ACQUIRE, "agent");
        }
        const int mv = mod_vec(r);
        const float* xin; float* xout;
        if (r < hk::TL) { xin = (layer == 0 ? p.in[hk::I_X] : p.out) + (size_t)r * 2048; xout = p.out + (size_t)r * 2048; }
        else { xin = (layer == 0 ? p.in[hk::I_CTX] : CTXS) + (size_t)(r - hk::TL) * 2048; xout = CTXS + (size_t)(r - hk::TL) * 2048; }
        const float* g1 = MODP(p.ws, layer, mv, 2); const float* sh2 = MODP(p.ws, layer, mv, 3); const float* sc2 = MODP(p.ws, layer, mv, 4);
        float sum = 0.f, sq = 0.f;
        f32x4 v[8];
#pragma unroll
        for (int hh = 0; hh < 2; ++hh) {   f32x4 xr[4], gr[4]; u32x2 yr[4];
#pragma unroll
            for (int i = 0; i < 4; ++i) { const int j = 4 * (lane + 64 * (4 * hh + i)); xr[i] = *(const f32x4*)(xin + j); yr[i] = *(const u32x2*)(YO + (size_t)r * 2048 + j); if (stage) gr[i] = *(const f32x4*)(Lmv + j); else gr[i] = *(const f32x4*)(g1 + j); }
#pragma unroll
            for (int i = 0; i < 4; ++i) {
                const float y0 = __uint_as_float(yr[i].x << 16), y1 = __uint_as_float(yr[i].x & 0xFFFF0000u), y2 = __uint_as_float(yr[i].y << 16), y3 = __uint_as_float(yr[i].y & 0xFFFF0000u);
                const f32x4 t = (f32x4){hk::ALPHA * xr[i][0] + gr[i][0] * y0, hk::ALPHA * xr[i][1] + gr[i][1] * y1, hk::ALPHA * xr[i][2] + gr[i][2] * y2, hk::ALPHA * xr[i][3] + gr[i][3] * y3};
                v[4 * hh + i] = t;
                sum += (t[0] + t[1]) + (t[2] + t[3]); sq += (t[0] * t[0] + t[1] * t[1]) + (t[2] * t[2] + t[3] * t[3]);
            }
            asm volatile("" ::: "memory");
        }
        const float mean = wave_sum(sum) * (1.0f / 2048.0f);
        const float var = fmaxf(wave_sum(sq) * (1.0f / 2048.0f) - mean * mean, 0.f);
        const float rstd = rsqrtf(var + hk::LN_EPS);
        float lg[16];
#pragma unroll
        for (int e = 0; e < 16; ++e) lg[e] = 0.f;
        f32x4 ng = *(const f32x4*)(lng + 4 * lane), nb = *(const f32x4*)(lnb + 4 * lane), na2 = (f32x4){0.f, 0.f, 0.f, 0.f}, nb2 = na2;
        if (!stage) { na2 = *(const f32x4*)(sc2 + 4 * lane); nb2 = *(const f32x4*)(sh2 + 4 * lane); }
#pragma unroll
        for (int i = 0; i < 8; ++i) {
            const int j = 4 * (lane + 64 * i);
            const f32x4 g = ng, b = nb; f32x4 a2 = na2, b2 = nb2;
            if (stage) { a2 = *(const f32x4*)(Lmv + 4096 + j); b2 = *(const f32x4*)(Lmv + 2048 + j); }
            if (i < 7) { const int jn = j + 256; ng = *(const f32x4*)(lng + jn); nb = *(const f32x4*)(lnb + jn); if (!stage) { na2 = *(const f32x4*)(sc2 + jn); nb2 = *(const f32x4*)(sh2 + jn); } }
            asm volatile("" ::: "memory");
            f32x4 xn, tk;
#pragma unroll
            for (int q = 0; q < 4; ++q) { xn[q] = (v[i][q] - mean) * rstd * g[q] + b[q]; tk[q] = xn[q] * (1.f + a2[q]) + b2[q]; }
            *(f32x4*)(xout + j) = xn;
            u32x2 w; w.x = pk2(tk[0], tk[1]); w.y = pk2(tk[2], tk[3]);
            *(u32x2*)(TOK + (size_t)r * 2048 + j) = w;
#pragma unroll
            for (int e = 0; e < 16; ++e) { const f32x4 rw = *(const f32x4*)(rwT + e * 2048 + j); lg[e] += (tk[0] * rw[0] + tk[1] * rw[1]) + (tk[2] * rw[2] + tk[3] * rw[3]); }
            asm volatile("" ::: "memory");
        }
        float a8[8], a4[4], a2[2], tot;
        { const bool u = (lane & 32) != 0;
#pragma unroll
          for (int k = 0; k < 8; ++k) { const float send = u ? lg[k] : lg[8 + k], keep = u ? lg[8 + k] : lg[k]; a8[k] = keep + __shfl_xor(send, 32); } }
        { const bool u = (lane & 16) != 0;
#pragma unroll
          for (int k = 0; k < 4; ++k) { const float send = u ? a8[k] : a8[4 + k], keep = u ? a8[4 + k] : a8[k]; a4[k] = keep + __shfl_xor(send, 16); } }
        { const bool u = (lane & 8) != 0;
#pragma unroll
          for (int k = 0; k < 2; ++k) { const float send = u ? a4[k] : a4[2 + k], keep = u ? a4[2 + k] : a4[k]; a2[k] = keep + __shfl_xor(send, 8); } }
        { const bool u = (lane & 4) != 0; const float send = u ? a2[0] : a2[1], keep = u ? a2[1] : a2[0]; tot = keep + __shfl_xor(send, 4); }
        tot += __shfl_xor(tot, 2); tot += __shfl_xor(tot, 1);
        const float scE = __builtin_amdgcn_rcpf(1.0f + __expf(-tot)), selE = scE + rb[(lane >> 2) & 15];
        const int gl = lane & 48;
        const float s4[4] = {__shfl(selE, gl), __shfl(selE, gl + 4), __shfl(selE, gl + 8), __shfl(selE, gl + 12)};
        const float u4[4] = {__shfl(scE, gl), __shfl(scE, gl + 4), __shfl(scE, gl + 8), __shfl(scE, gl + 12)};
        float m1 = -1e30f, m2 = -1e30f;
#pragma unroll
        for (int q = 0; q < 4; ++q) { const float s = s4[q]; if (s > m1) { m2 = m1; m1 = s; } else if (s > m2) m2 = s; }
        const float gs = m1 + m2;
        int li1 = 0; float b1 = s4[0];
#pragma unroll
        for (int q = 1; q < 4; ++q) if (s4[q] > b1) { b1 = s4[q]; li1 = q; }
        int li2 = -1; float b2v = -1e30f;
#pragma unroll
        for (int q = 0; q < 4; ++q) if (q != li1 && s4[q] > b2v) { b2v = s4[q]; li2 = q; }
        const float lga = li1 == 0 ? u4[0] : li1 == 1 ? u4[1] : li1 == 2 ? u4[2] : u4[3];
        const float lgb = li2 == 0 ? u4[0] : li2 == 1 ? u4[1] : li2 == 2 ? u4[2] : u4[3];
        const float g4[4] = {__shfl(gs, 0), __shfl(gs, 16), __shfl(gs, 32), __shfl(gs, 48)};
        int grp = 0; float best = g4[0];
#pragma unroll
        for (int g = 1; g < 4; ++g) if (g4[g] > best) { best = g4[g]; grp = g; }
        const int i1 = __shfl(li1, 16 * grp), i2 = __shfl(li2, 16 * grp);
        const float ga = __shfl(lga, 16 * grp), gb = __shfl(lgb, 16 * grp);
        const float inv = __builtin_amdgcn_rcpf(ga + gb);
        if (lane == 0) {
            const int e1 = grp * 4 + i1, e2 = grp * 4 + i2;
            const int s1 = atomicAdd(&lcnt[e1], 1), s2 = atomicAdd(&lcnt[e2], 1);
            EXPERT[2 * r] = e1; EXPERT[2 * r + 1] = e2; GATE[2 * r] = ga * inv; GATE[2 * r + 1] = gb * inv; SLOT[2 * r] = s1; SLOT[2 * r + 1] = s2;
        }
    }
    __syncthreads();
    unsigned* gcnt = (unsigned*)(p.ws + hk::WS_CTL) + hk::CW_CNT + layer * 64;
    if (tid < 16) lbase[tid] = (int)atomicAdd(&gcnt[tid], (unsigned)lcnt[tid]);
    __syncthreads();
    for (int kk = 0; kk < nrnd; ++kk) {
        const int r = row_at(kk); if (r < 0) continue;
        if (lane == 0) {
            const int e1 = EXPERT[2 * r], e2 = EXPERT[2 * r + 1], s1 = SLOT[2 * r] + lbase[e1], s2 = SLOT[2 * r + 1] + lbase[e2];
            SLOT[2 * r] = s1; SLOT[2 * r + 1] = s2; ROWS[e1 * hk::ROWS_CAP + s1] = r; ROWS[e2 * hk::ROWS_CAP + s2] = r; }
    }
}

__device__ __forceinline__ void expert_starts(const unsigned* gcnt, int (&pstart)[17]) {
    int acc = 0;
#pragma unroll
    for (int e = 0; e < 16; ++e) { pstart[e] = acc; acc += (int)((__hip_atomic_load(gcnt + e, __ATOMIC_RELAXED, __HIP_MEMORY_SCOPE_AGENT) + 255u) & ~255u); }
    pstart[16] = acc;
}
__device__ __forceinline__ void ph_dispatch(const Params& p, int layer, const bf16_t* TOK, bf16_t* AG) {
    const int tid = threadIdx.x, lane = tid & 63, wave = tid >> 6;
    const int T = layer == 0 ? hk::TA : hk::TL;
    unsigned* ctl = (unsigned*)(p.ws + hk::WS_CTL);
    int pstart[17]; expert_starts(ctl + hk::CW_CNT + layer * 64, pstart);
    if (blockIdx.x == 0) {
        const int nt = pstart[16] >> 8;
        if (tid == 0) ctl[hk::CW_NT + layer * 64] = (unsigned)nt;
        for (int rt = tid; rt < nt; rt += 512) { int e = 0;
#pragma unroll
            for (int q = 1; q < 16; ++q) if (rt * 256 >= pstart[q]) e = q;
            ctl[hk::CW_TILEE + layer * 320 + rt] = (unsigned)e; }
    }
    const int* EXPERT = (const int*)(p.ws + hk::WS_MISC + hk::MISC_EXP); const int* SLOT = (const int*)(p.ws + hk::WS_MISC + hk::MISC_SLOT); int* DEST = (int*)(p.ws + hk::WS_MISC + hk::MISC_DEST); int* ROWTOK = (int*)(p.ws + hk::WS_MISC + hk::MISC_ROWTOK);
    (void)lane; (void)wave; (void)TOK; (void)AG;
    for (int r = blockIdx.x * 512 + tid; r < T; r += gridDim.x * 512) {
#pragma unroll
        for (int k = 0; k < 2; ++k) {
            const int e = EXPERT[2 * r + k], s = SLOT[2 * r + k];
            int ps = 0;
#pragma unroll
            for (int q = 0; q < 16; ++q) ps = (e == q) ? pstart[q] : ps;
            const int d = ps + s;
            DEST[2 * r + k] = d; ROWTOK[d] = r;
        }
    }
}

__device__ __forceinline__ void ph_ln2(const Params& p, int layer, const bf16_t* YR, bf16_t* HNEXT, unsigned char* ldsb) {
    const int lane = threadIdx.x & 63, wave = __builtin_amdgcn_readfirstlane(threadIdx.x >> 6);
    const int T = layer == 0 ? hk::TA : hk::TL;
    if (layer == 0) { int* ROWS = (int*)(p.ws + hk::WS_ACT + hk::A_ROWS);
        for (int i = blockIdx.x * 512 + threadIdx.x; i < 16 * hk::ROWS_CAP; i += gridDim.x * 512) ROWS[i] = 0; }
    int pstart[17]; expert_starts((const unsigned*)(p.ws + hk::WS_CTL) + hk::CW_CNT + layer * 64, pstart);
#pragma unroll
    for (int q = 0; q < 17; ++q) pstart[q] = __builtin_amdgcn_readfirstlane(pstart[q]);
    float* CTXS = (float*)(p.ws + hk::WS_CTXS);
    const int* EXPERT = (const int*)(p.ws + hk::WS_MISC + hk::MISC_EXP); const int* SLOT = (const int*)(p.ws + hk::WS_MISC + hk::MISC_SLOT); const float* GATE = (const float*)(p.ws + hk::WS_MISC + hk::MISC_GATE);
    const float* lng = p.in[hk::I_LNG] + (size_t)(layer * 2 + 1) * 2048; const float* lnb = p.in[hk::I_LNB] + (size_t)(layer * 2 + 1) * 2048;
    float* Lv = (float*)ldsb;
    { const int nvec = layer == 0 ? 11 : 5; int t0 = threadIdx.x; asm volatile("" : "+v"(t0));
      for (int vct = 0; vct < nvec; ++vct) { const int j = t0 * 4;
          const float* src = vct == 0 ? lng : vct == 1 ? lnb : vct < 5 ? MODP(p.ws, layer, vct - 2, 5) : vct < 8 ? MODP(p.ws, 1, vct - 5, 1) : MODP(p.ws, 1, vct - 8, 0);
          *(f32x4*)(Lv + vct * 2048 + j) = *(const f32x4*)(src + j); }
      __syncthreads(); }
    for (int r = blockIdx.x * 8 + wave; r < T; r += gridDim.x * 8) {
        const int mv = mod_vec(r);
        float* xio = r < hk::TL ? p.out + (size_t)r * 2048 : CTXS + (size_t)(r - hk::TL) * 2048;
        const float* g2 = Lv + (2 + mv) * 2048;
        const int ea = __builtin_amdgcn_readfirstlane(EXPERT[2 * r]), eb = __builtin_amdgcn_readfirstlane(EXPERT[2 * r + 1]); int pa = 0, pb = 0;
#pragma unroll
        for (int q = 0; q < 16; ++q) { pa = ea == q ? pstart[q] : pa; pb = eb == q ? pstart[q] : pb; }
        const int d0 = pa + __builtin_amdgcn_readfirstlane(SLOT[2 * r]), d1 = pb + __builtin_amdgcn_readfirstlane(SLOT[2 * r + 1]);
        const float w0 = __int_as_float(__builtin_amdgcn_readfirstlane(__float_as_int(GATE[2 * r]))), w1 = __int_as_float(__builtin_amdgcn_readfirstlane(__float_as_int(GATE[2 * r + 1])));
        float v[32]; float sum = 0.f;
#pragma unroll
        for (int i = 0; i < 8; ++i) {
            const int j = 4 * (lane + 64 * i);
            const f32x4 x = *(const f32x4*)(xio + j), g = *(const f32x4*)(g2 + j);
            const u32x2 ya = *(const u32x2*)(YR + (size_t)d0 * 2048 + j), yb = *(const u32x2*)(YR + (size_t)d1 * 2048 + j);
            float y[4];
            y[0] = w0 * __uint_as_float(ya.x << 16) + w1 * __uint_as_float(yb.x << 16); y[1] = w0 * __uint_as_float(ya.x & 0xFFFF0000u) + w1 * __uint_as_float(yb.x & 0xFFFF0000u);
            y[2] = w0 * __uint_as_float(ya.y << 16) + w1 * __uint_as_float(yb.y << 16); y[3] = w0 * __uint_as_float(ya.y & 0xFFFF0000u) + w1 * __uint_as_float(yb.y & 0xFFFF0000u);
#pragma unroll
            for (int q = 0; q < 4; ++q) { v[4 * i + q] = hk::ALPHA * x[q] + g[q] * y[q]; sum += v[4 * i + q]; }
        }
        const float mean = wave_sum(sum) * (1.0f / 2048.0f);
        float sq = 0.f;
#pragma unroll
        for (int k = 0; k < 32; ++k) { const float d = v[k] - mean; sq += d * d; }
        const float rstd = rsqrtf(wave_sum(sq) * (1.0f / 2048.0f) + hk::LN_EPS);
        const float* sh = Lv + (8 + mv) * 2048; const float* sc = Lv + (5 + mv) * 2048;
#pragma unroll
        for (int i = 0; i < 8; ++i) {
            const int j = 4 * (lane + 64 * i);
            const f32x4 g = *(const f32x4*)(Lv + j), b = *(const f32x4*)(Lv + 2048 + j);
            f32x4 xn;
#pragma unroll
            for (int q = 0; q < 4; ++q) xn[q] = (v[4 * i + q] - mean) * rstd * g[q] + b[q];
#if PROBE_STAMP || defined(PROBE_PHASE)
            if (layer == 1 && r == 0 && i == 0 && lane == 0) { const float fr = ((const float*)(p.ws + hk::WS_CTL))[hk::CW_PROBE]; xn[0] += sqrtf((1e-4f + 8e-4f * fr) * 6.72e7f); }
#endif
            *(f32x4*)(xio + j) = xn;
            if (layer == 0) {
                const f32x4 a = *(const f32x4*)(sc + j), bb = *(const f32x4*)(sh + j);
                u32x2 w; w.x = pk2(xn[0] * (1.f + a[0]) + bb[0], xn[1] * (1.f + a[1]) + bb[1]); w.y = pk2(xn[2] * (1.f + a[2]) + bb[2], xn[3] * (1.f + a[3]) + bb[3]);
                *(u32x2*)(HNEXT + (size_t)r * 2048 + j) = w;
            }
            asm volatile("" ::: "memory");
        }
    }
}
__device__ __forceinline__ void ph_gla_scan_naive(const Params& p, unsigned char* ldsb) {
    float* w2s = (float*)ldsb;
    float* bs = w2s + 16 * 128;
    float* qs = bs + 128;
    float* ks = qs + 32 * 128; float* as = ks + 32 * 128;
    float* vv = as + 32 * 128;
    float* part = vv + 32 * 16;
    const int tid = threadIdx.x, lane = tid & 63, wave = tid >> 6;
    const bf16_t* GL = (const bf16_t*)(p.ws + hk::WS_ACT + hk::A_GL);
    for (int it = blockIdx.x; it < 256; it += gridDim.x) {
        const int b = it >> 7, dir = (it >> 6) & 1, h = (it >> 4) & 3, vs = it & 15;
        bf16_t* OUT = (bf16_t*)(p.ws + hk::WS_ACT + (dir == 0 ? hk::A_OF : hk::A_OB));
        __syncthreads();
        for (int i = tid; i < 16 * 128; i += 512) { const int r = i >> 7, kk = i & 127; w2s[i] = p.in[hk::I_GW2][(size_t)(dir * 16 + r) * 512 + h * 128 + kk]; }
        if (tid < 128) bs[tid] = p.in[hk::I_GB][dir * 512 + h * 128 + tid];
        __syncthreads();
        const int v = tid & 15, kg = tid >> 4;
        float S[4] = {0.f, 0.f, 0.f, 0.f};
        for (int seg = 0; seg < 2; ++seg) {
            const int n = seg == 0 ? hk::CTXL : hk::SEQ, rowbase = seg == 0 ? hk::TL + b * hk::CTXL : b * hk::SEQ;
            for (int t0 = 0; t0 < n; t0 += 32) {
                for (int idx = tid; idx < 32 * 128; idx += 512) {
                    const int s = idx >> 7, kk = idx & 127, tt = t0 + s, t = dir == 0 ? tt : n - 1 - tt;
                    const bf16_t* row = GL + (size_t)(rowbase + t) * hk::GL_LD;
                    qs[idx] = bf2f(row[h * 128 + kk]) * 0.08838834764831845f;
                    ks[idx] = bf2f(row[512 + h * 128 + kk]);
                    float z = bs[kk];
#pragma unroll
                    for (int r = 0; r < 16; ++r) z += bf2f(row[hk::GL_GK + dir * 16 + r]) * w2s[r * 128 + kk];
                    const float ls = z >= 0.f ? -log1pf(expf(-z)) : z - log1pf(expf(z));
                    as[idx] = expf(ls * (1.0f / 16.0f));
                }
                { const int s = tid >> 4, tt = t0 + s, t = dir == 0 ? tt : n - 1 - tt;
                  vv[tid] = bf2f(((const bf16_t*)(p.ws + hk::WS_ACT + hk::A_VTG))[(size_t)(h * 256 + vs * 16 + v) * hk::TA + rowbase + t]); }
                __syncthreads();
#pragma unroll 4
                for (int s = 0; s < 32; ++s) {
                    const f32x4 a4 = *(const f32x4*)(as + s * 128 + kg * 4), k4 = *(const f32x4*)(ks + s * 128 + kg * 4), q4 = *(const f32x4*)(qs + s * 128 + kg * 4);
                    const float vval = vv[s * 16 + v];
                    float o = 0.f;
#pragma unroll
                    for (int i = 0; i < 4; ++i) { S[i] = a4[i] * S[i] + k4[i] * vval; o += q4[i] * S[i]; }
                    o += __shfl_xor(o, 16); o += __shfl_xor(o, 32);
                    if (lane < 16) part[(s * 8 + wave) * 16 + lane] = o;
                }
                __syncthreads();
                { const int s = tid >> 4, tt = t0 + s, t = dir == 0 ? tt : n - 1 - tt;
                  float o = 0.f;
#pragma unroll
                  for (int w = 0; w < 8; ++w) o += part[(s * 8 + w) * 16 + v];
                  OUT[(size_t)(rowbase + t) * 1024 + h * 256 + vs * 16 + v] = f2bf(o); }
                __syncthreads();
            }
        }
    }
}
__device__ __forceinline__ void ph_mix_finish(const Params& p, unsigned char* ldsb) {
    const int tid = threadIdx.x, lane = tid & 63, wave = tid >> 6;
    const bf16_t* OF = (const bf16_t*)(p.ws + hk::WS_ACT + hk::A_OF); const bf16_t* OB = (const bf16_t*)(p.ws + hk::WS_ACT + hk::A_OB);
    const bf16_t* GL = (const bf16_t*)(p.ws + hk::WS_ACT + hk::A_GL);
    bf16_t* MIX = (bf16_t*)(p.ws + hk::WS_ACT + hk::A_HA);
    const float* ng = p.in[hk::I_GNG];
    for (int r = blockIdx.x * 8 + wave; r < hk::TA; r += gridDim.x * 8) {
        float o[16]; float ss = 0.f;
#pragma unroll
        for (int i = 0; i < 2; ++i) {
            float a[8], bq[8]; unpack8(*(const u32x4*)(OF + (size_t)r * 1024 + lane * 16 + 8 * i), a); unpack8(*(const u32x4*)(OB + (size_t)r * 1024 + lane * 16 + 8 * i), bq);
#pragma unroll
            for (int q = 0; q < 8; ++q) { o[8 * i + q] = a[q] + bq[q]; ss += o[8 * i + q] * o[8 * i + q]; }
        }
        ss += __shfl_xor(ss, 1); ss += __shfl_xor(ss, 2); ss += __shfl_xor(ss, 4); ss += __shfl_xor(ss, 8);
        const float rs = rsqrtf(ss * (1.0f / 256.0f) + hk::LN_EPS);
        const u32x4 r0 = *(const u32x4*)(GL + (size_t)r * hk::GL_LD + hk::GL_G + lane * 16), r1 = *(const u32x4*)(GL + (size_t)r * hk::GL_LD + hk::GL_G + lane * 16 + 8);
        float rr[16]; { float t8[8]; unpack8(r0, t8);
#pragma unroll
            for (int q = 0; q < 8; ++q) rr[q] = t8[q]; unpack8(r1, t8);
#pragma unroll
            for (int q = 0; q < 8; ++q) rr[8 + q] = t8[q]; }
        float f[16];
#pragma unroll
        for (int q = 0; q < 16; ++q) f[q] = o[q] * rs * ng[lane * 16 + q] * silu_f(rr[q]);
        u32x4 w0, w1; w0.x = pk2(f[0], f[1]); w0.y = pk2(f[2], f[3]); w0.z = pk2(f[4], f[5]); w0.w = pk2(f[6], f[7]); w1.x = pk2(f[8], f[9]); w1.y = pk2(f[10], f[11]); w1.z = pk2(f[12], f[13]); w1.w = pk2(f[14], f[15]);
        *(u32x4*)(MIX + (size_t)r * 2048 + 1024 + lane * 16) = w0; *(u32x4*)(MIX + (size_t)r * 2048 + 1024 + lane * 16 + 8) = w1;
    }
    const bf16_t* YT = (const bf16_t*)(p.ws + hk::WS_ACT + hk::A_YT);
    bf16_t* tile = (bf16_t*)ldsb;
    __syncthreads();
    for (int t = blockIdx.x; t < 16 * (hk::TA / 64); t += gridDim.x) {
        const int ct = t & 15, tt = t >> 4, c0 = ct * 64, tok0 = tt * 64;
        { const int c = tid >> 3, q = tid & 7;
          const u32x4 w = *(const u32x4*)(YT + (size_t)(c0 + c) * hk::TA + tok0 + q * 8);
          unsigned* dstw = (unsigned*)(tile + c * 66 + q * 8);
          dstw[0] = w.x; dstw[1] = w.y; dstw[2] = w.z; dstw[3] = w.w; }
        __syncthreads();
        { const int tk = tid >> 3, q = tid & 7;
          bf16_t e[8];
#pragma unroll
          for (int j = 0; j < 8; ++j) e[j] = tile[(q * 8 + j) * 66 + tk];
          u32x4 w; w.x = e[0] | ((unsigned)e[1] << 16); w.y = e[2] | ((unsigned)e[3] << 16); w.z = e[4] | ((unsigned)e[5] << 16); w.w = e[6] | ((unsigned)e[7] << 16);
          *(u32x4*)(MIX + (size_t)(tok0 + tk) * 2048 + c0 + q * 8) = w; }
        __syncthreads();
    }
}
namespace hy {
constexpr int PADF = 1024, L = 16384;
__device__ __forceinline__ float sconv(const bf16_t* row, int t, int n, float w0, float w1, float w2, float bias) {
    const float a = t > 0 ? bf2f(row[t - 1]) : 0.f, b = bf2f(row[t]), c = t + 1 < n ? bf2f(row[t + 1]) : 0.f;
    return w0 * a + w1 * b + w2 * c + bias;
}
template <int SGN> __device__ __forceinline__ void lconv8(const float* u, const bf16_t* f, int t0, int trips, float (&acc)[8]) {
    float W[16];
    if (SGN > 0) {
#pragma unroll
        for (int x = 0; x < 8; ++x) W[8 + x] = u[PADF + t0 + x];
        for (int it = 0; it < trips; ++it) {
            const int d0 = it * 8;
            const f32x4 lo0 = *(const f32x4*)(u + PADF + t0 - d0 - 8), lo1 = *(const f32x4*)(u + PADF + t0 - d0 - 4);
            W[0] = lo0[0]; W[1] = lo0[1]; W[2] = lo0[2]; W[3] = lo0[3]; W[4] = lo1[0]; W[5] = lo1[1]; W[6] = lo1[2]; W[7] = lo1[3];
            float fe[8]; unpack8(*(const u32x4*)(f + d0), fe);
#pragma unroll
            for (int e = 0; e < 8; ++e)
#pragma unroll
                for (int i = 0; i < 8; ++i) acc[i] += fe[e] * W[8 + i - e];
#pragma unroll
            for (int x = 0; x < 8; ++x) W[8 + x] = W[x];
        }
    } else {
#pragma unroll
        for (int x = 0; x < 8; ++x) W[x] = u[PADF + t0 + x];
        for (int it = 0; it < trips; ++it) {
            const int d0 = it * 8;
            const f32x4 hi0 = *(const f32x4*)(u + PADF + t0 + d0 + 8), hi1 = *(const f32x4*)(u + PADF + t0 + d0 + 12);
            W[8] = hi0[0]; W[9] = hi0[1]; W[10] = hi0[2]; W[11] = hi0[3]; W[12] = hi1[0]; W[13] = hi1[1]; W[14] = hi1[2]; W[15] = hi1[3];
            float fe[8]; unpack8(*(const u32x4*)(f + d0), fe);
#pragma unroll
            for (int e = 0; e < 8; ++e)
#pragma unroll
                for (int i = 0; i < 8; ++i) acc[i] += fe[e] * W[i + e];
#pragma unroll
            for (int x = 0; x < 8; ++x) W[x] = W[8 + x];
        }
    }
}
}
__device__ __forceinline__ void ph_hyena_naive(const Params& p, unsigned char* ldsb) {
    using namespace hy;
    float* u = (float*)ldsb;
    bf16_t* f = (bf16_t*)(u + (PADF + L + PADF));
    float* tmp = (float*)(p.ws + hk::WS_ACT + hk::A_HYTMP) + (size_t)blockIdx.x * L;
    const int tid = threadIdx.x, wave = tid >> 6;
    const bf16_t* UT = (const bf16_t*)(p.ws + hk::WS_ACT + hk::A_UT);
    const bf16_t* HF = (const bf16_t*)(p.ws + hk::WS_ACT + hk::A_HF); const bf16_t* HFC = (const bf16_t*)(p.ws + hk::WS_ACT + hk::A_HFC);
    bf16_t* YT = (bf16_t*)(p.ws + hk::WS_ACT + hk::A_YT);
    const float* cw = p.in[hk::I_HCW]; const float* cb = p.in[hk::I_HCB]; const float* lb = p.in[hk::I_HLB];
    for (int c = blockIdx.x; c < 1024; c += gridDim.x) {
        const float delta = fabsf(-3.0701134573253945f + (-15.350567286626973f + 3.0701134573253945f) * ((float)c / 1023.0f));
        float wv[3][4];
#pragma unroll
        for (int q = 0; q < 3; ++q) { wv[q][0] = cw[0 * 3072 + q * 1024 + c]; wv[q][1] = cw[1 * 3072 + q * 1024 + c]; wv[q][2] = cw[2 * 3072 + q * 1024 + c]; wv[q][3] = cb[q * 1024 + c]; }
        const bf16_t* rv = UT + (size_t)c * hk::TA; const bf16_t* r1 = UT + (size_t)(1024 + c) * hk::TA; const bf16_t* r2 = UT + (size_t)(2048 + c) * hk::TA;
        for (int b = 0; b < 2; ++b) {
            const int base = b * L;
            __syncthreads();
            for (int i = tid; i < PADF; i += 512) { u[i] = 0.f; u[PADF + L + i] = 0.f; }
            for (int t = tid; t < L; t += 512) u[PADF + t] = sconv(rv + base, t, L, wv[0][0], wv[0][1], wv[0][2], wv[0][3]);
            for (int o = 0; o < 2; ++o) {
                __syncthreads();
                for (int dir = 0; dir < 2; ++dir) {
                    const bf16_t* hrow = HF + (size_t)((o * 2 + dir) * 1024 + c) * L;
                    for (int m = tid; m < L; m += 512) f[dir * L + m] = (dir == 1 && m == 0) ? (bf16_t)0 : f2bf(bf2f(hrow[m]) * expf(-((float)m / (float)(L - 1)) * delta));
                }
                __syncthreads();
                const float d = lb[o * 1024 + c];
#pragma unroll 1
                for (int jj = 0; jj < 4; ++jj) {
                    const int t0 = 8 * (tid + 512 * jj), tw0 = 8 * (wave * 64 + 512 * jj);
                    float acc[8];
#pragma unroll
                    for (int i = 0; i < 8; ++i) acc[i] = 0.f;
                    lconv8<1>(u, f, t0, (tw0 + 8 * 63 + 7) / 8 + 1, acc);
                    lconv8<-1>(u, f + L, t0, (L - tw0 + 7) / 8, acc);
                    float res[8];
#pragma unroll
                    for (int i = 0; i < 8; ++i) {
                        const int t = t0 + i;
                        const float g = o == 0 ? sconv(r1 + base, t, L, wv[1][0], wv[1][1], wv[1][2], wv[1][3]) : sconv(r2 + base, t, L, wv[2][0], wv[2][1], wv[2][2], wv[2][3]);
                        res[i] = g * (acc[i] + d * u[PADF + t]);
                    }
                    if (o == 0) {
                        *(f32x4*)(tmp + t0) = (f32x4){res[0], res[1], res[2], res[3]}; *(f32x4*)(tmp + t0 + 4) = (f32x4){res[4], res[5], res[6], res[7]};
                    } else {
                        u32x4 w; w.x = pk2(res[0], res[1]); w.y = pk2(res[2], res[3]); w.z = pk2(res[4], res[5]); w.w = pk2(res[6], res[7]);
                        *(u32x4*)(YT + (size_t)c * hk::TA + base + t0) = w;
                    }
                }
                if (o == 0) {
                    __syncthreads();
#pragma unroll 1
                    for (int jj = 0; jj < 4; ++jj) {
                        const int t0 = 8 * (tid + 512 * jj);
                        *(f32x4*)(u + PADF + t0) = *(const f32x4*)(tmp + t0); *(f32x4*)(u + PADF + t0 + 4) = *(const f32x4*)(tmp + t0 + 4);
                    }
                }
            }
        }
        {
            __syncthreads();
            float* uc = u;
            float* fc = u + 512;
            const int b = tid >> 8, t = tid & 255, cbase = hk::TL + b * 256;
            uc[tid] = sconv(rv + cbase, t, 256, wv[0][0], wv[0][1], wv[0][2], wv[0][3]);
            for (int i = tid; i < 1024; i += 512) { const int od = i >> 8, m = i & 255; fc[i] = bf2f(HFC[(size_t)(od * 1024 + c) * 256 + m]) * expf(-((float)m / 255.0f) * delta); }
            __syncthreads();
            float y = uc[tid];
            for (int o = 0; o < 2; ++o) {
                float a = 0.f;
                for (int s = 0; s <= t; ++s) a += fc[(o * 2 + 0) * 256 + (t - s)] * uc[b * 256 + s];
                for (int s = t + 1; s < 256; ++s) a += fc[(o * 2 + 1) * 256 + (s - t)] * uc[b * 256 + s];
                const float g = o == 0 ? sconv(r1 + cbase, t, 256, wv[1][0], wv[1][1], wv[1][2], wv[1][3]) : sconv(r2 + cbase, t, 256, wv[2][0], wv[2][1], wv[2][2], wv[2][3]);
                y = g * (a + lb[o * 1024 + c] * y);
                __syncthreads();
                uc[tid] = y;
                __syncthreads();
            }
            YT[(size_t)c * hk::TA + cbase + t] = f2bf(y);
        }
    }
}
#ifndef HY_LO
#define HY_LO 2
#endif
namespace hf {
constexpr int N = 32768, L = 16384, ROWB = 144, PLB = 4624, WBYTES = 32 * PLB;
typedef short bf16x8 __attribute__((ext_vector_type(8)));
typedef float f32x16 __attribute__((ext_vector_type(16)));
__device__ __forceinline__ unsigned waddr(int p, int r, int i) { return (unsigned)(p * PLB + r * ROWB + i * 4); }
struct Dft { bf16x8 re[4], im[4]; };
__device__ __forceinline__ void make_dft(Dft& d, int lane) {
    const int k = lane & 31, g = lane >> 5;
#pragma unroll
    for (int s = 0; s < 4; ++s) {
        unsigned pr[4], pi[4];
#pragma unroll
        for (int jj = 0; jj < 4; ++jj) {
            const int a = 8 * s + 4 * g + jj;
            const float t = (float)((a * k) & 31) * (1.0f / 32.0f);
            const float c = __builtin_amdgcn_cosf(t), sn = __builtin_amdgcn_sinf(t);
            pr[jj] = pk2(c, sn);
            pi[jj] = pk2(-sn, c);
        }
        u32x4 a4 = (u32x4){pr[0], pr[1], pr[2], pr[3]}, b4 = (u32x4){pi[0], pi[1], pi[2], pi[3]};
        d.re[s] = __builtin_bit_cast(bf16x8, a4); d.im[s] = __builtin_bit_cast(bf16x8, b4);
    }
}
enum { EPI_TW0 = 0, EPI_TW1 = 1, EPI_HSTORE = 2, EPI_HMUL = 3, EPI_GATE = 4, EPI_RAW = 5 };
struct EpiArgs { unsigned* hs; const unsigned* xg; unsigned* vg; float d; int store_vg; };
template <bool ROWBLK, bool BFORM, int KS, int EPI>
__device__ __forceinline__ void fft_stage(unsigned char* W, const Dft& dft, int wave, int lane, const EpiArgs& ea) {
    const int k = lane & 31, g = lane >> 5;
    const float twc = __builtin_amdgcn_cosf((float)k * (1.0f / 1024.0f)), tws = __builtin_amdgcn_sinf((float)k * (1.0f / 1024.0f));
#pragma unroll 1
    for (int bi = 0; bi < 4; ++bi) {
        const int l = wave + 8 * bi;
        int kx = k; asm volatile("" : "+v"(kx));
        const unsigned base = ROWBLK ? waddr(kx, l, 0) : waddr(l, kx, 0);
        u32x4 pre0[4], pre1[2];
        if (EPI == EPI_HMUL) {
#pragma unroll
            for (int q = 0; q < 4; ++q) pre0[q] = *(const u32x4*)(ea.hs + ((kx * 32 + l) * 32 + 8 * q + 4 * g));
        }
        if (EPI == EPI_GATE) {
#pragma unroll
            for (int q = 0; q < 2; ++q) { const int gi = (l * 32 + kx) * 16 + 8 * q + 4 * g; pre0[q] = *(const u32x4*)(ea.xg + gi); pre1[q] = *(const u32x4*)(ea.vg + gi); }
        }
        bf16x8 dat[KS];
#pragma unroll
        for (int s = 0; s < KS; ++s) dat[s] = *(const bf16x8*)(W + base + 16 * (2 * s + g));
        f32x16 dre, dim;
#pragma unroll
        for (int i = 0; i < 16; ++i) { dre[i] = 0.f; dim[i] = 0.f; }
#pragma unroll
        for (int s = 0; s < KS; ++s) {
            if (!BFORM) { dre = __builtin_amdgcn_mfma_f32_32x32x16_bf16(dat[s], dft.re[s], dre, 0, 0, 0); dim = __builtin_amdgcn_mfma_f32_32x32x16_bf16(dat[s], dft.im[s], dim, 0, 0, 0); }
            else        { dre = __builtin_amdgcn_mfma_f32_32x32x16_bf16(dft.re[s], dat[s], dre, 0, 0, 0); dim = __builtin_amdgcn_mfma_f32_32x32x16_bf16(dft.im[s], dat[s], dim, 0, 0, 0); }
        }
#pragma unroll
        for (int q = 0; q < 4; ++q) {
            if (EPI == EPI_GATE && q >= 2) continue;
            const int ri0 = 8 * q + 4 * g;
            float orr[4], oii[4];
            if (EPI == EPI_TW0 || EPI == EPI_TW1) {
                const int e = (kx * (32 * ri0 + (EPI == EPI_TW1 ? l : 0))) & (N - 1);
                const float t = (float)e * (1.0f / (float)N);
                float c = __builtin_amdgcn_cosf(t), sn = __builtin_amdgcn_sinf(t);
#pragma unroll
                for (int r = 0; r < 4; ++r) {
                    const float a = dre[4 * q + r], b = dim[4 * q + r];
                    orr[r] = a * c + b * sn; oii[r] = b * c - a * sn;
                    const float c2 = c * twc - sn * tws, s2 = sn * twc + c * tws; c = c2; sn = s2;
                }
            } else if (EPI == EPI_HSTORE || EPI == EPI_RAW) {
#pragma unroll
                for (int r = 0; r < 4; ++r) { orr[r] = dre[4 * q + r]; oii[r] = dim[4 * q + r]; }
            } else if (EPI == EPI_HMUL) {
                const u32x4 h4 = pre0[q];
                const unsigned hw[4] = {h4.x, h4.y, h4.z, h4.w};
#pragma unroll
                for (int r = 0; r < 4; ++r) {
                    const float hr = __uint_as_float(hw[r] << 16), hi = __uint_as_float(hw[r] & 0xFFFF0000u);
                    const float a = dre[4 * q + r], b = dim[4 * q + r];
                    orr[r] = a * hr - b * hi; oii[r] = -(a * hi + b * hr);
                }
            } else {
                const u32x4 x4 = pre0[q & 1], v4 = pre1[q & 1];
                const unsigned xw[4] = {x4.x, x4.y, x4.z, x4.w}, vw[4] = {v4.x, v4.y, v4.z, v4.w};
#pragma unroll
                for (int r = 0; r < 4; ++r) {
                    const float xr = __uint_as_float(xw[r] << 16), xi = __uint_as_float(xw[r] & 0xFFFF0000u), vr = __uint_as_float(vw[r] << 16), vi = __uint_as_float(vw[r] & 0xFFFF0000u);
                    orr[r] = xr * (dre[4 * q + r] + ea.d * vr); oii[r] = xi * (-dim[4 * q + r] + ea.d * vi);
                }
            }
            u32x4 w; w.x = pk2(orr[0], oii[0]); w.y = pk2(orr[1], oii[1]); w.z = pk2(orr[2], oii[2]); w.w = pk2(orr[3], oii[3]);
            if (EPI == EPI_HSTORE) *(u32x4*)(ea.hs + ((kx * 32 + l) * 32 + ri0)) = w;
            else {
                *(u32x4*)(W + base + 4 * ri0) = w;
                if (EPI == EPI_GATE && ea.store_vg) *(u32x4*)(ea.vg + ((l * 32 + kx) * 16 + ri0)) = w;
            }
        }
    }
}

__device__ __forceinline__ void sconv8(const bf16_t* row, int t0, int n, const float (&w)[4], float (&out)[8]) {
    float f[8]; unpack8(*(const u32x4*)(row + t0), f);
    const float lo = t0 > 0 ? bf2f(row[t0 - 1]) : 0.f, hi = t0 + 8 < n ? bf2f(row[t0 + 8]) : 0.f;
#pragma unroll
    for (int i = 0; i < 8; ++i) { const float a = i == 0 ? lo : f[i - 1], c = i == 7 ? hi : f[i + 1]; out[i] = w[0] * a + w[1] * f[i] + w[2] * c + w[3]; }
}
__device__ __forceinline__ void sconv8_pack(const bf16_t* row, int t0, const float (&w)[4], unsigned* dst) {
    float a[8], b[8]; sconv8(row, t0, L, w, a); sconv8(row + L, t0, L, w, b);
    u32x4 p0, p1; p0.x = pk2(a[0], b[0]); p0.y = pk2(a[1], b[1]); p0.z = pk2(a[2], b[2]); p0.w = pk2(a[3], b[3]); p1.x = pk2(a[4], b[4]); p1.y = pk2(a[5], b[5]); p1.z = pk2(a[6], b[6]); p1.w = pk2(a[7], b[7]);
    *(u32x4*)(dst + t0) = p0; *(u32x4*)(dst + t0 + 4) = p1;
}
}

__device__ __forceinline__ void ph_hyena_fft(const Params& p, unsigned char* ldsb) {
    using namespace hf;
    unsigned char* W = ldsb;
    const int tid0 = threadIdx.x;
    const bf16_t* UT = (const bf16_t*)(p.ws + hk::WS_ACT + hk::A_UT);
    const bf16_t* HF = (const bf16_t*)(p.ws + hk::WS_ACT + hk::A_HF); const bf16_t* HFC = (const bf16_t*)(p.ws + hk::WS_ACT + hk::A_HFC);
    bf16_t* YT = (bf16_t*)(p.ws + hk::WS_ACT + hk::A_YT);
    unsigned* scr = (unsigned*)(p.ws + hk::WS_ACT + hk::A_HYS) + (size_t)blockIdx.x * (448 * 1024 / 4);
    unsigned* HS = scr; unsigned* XG1 = scr + 65536; unsigned* XG2 = XG1 + 16384; unsigned* VG = XG2 + 16384;
    const float* cw = p.in[hk::I_HCW]; const float* cb = p.in[hk::I_HCB]; const float* lb = p.in[hk::I_HLB];
    EpiArgs ea{};
    int c_lo, c_hi;
    if (gridDim.x == 256) { const int bx = blockIdx.x; if (bx < 128) { c_lo = bx * HY_LO; c_hi = c_lo + HY_LO; } else { c_lo = 128 * HY_LO + (bx - 128) * (8 - HY_LO); c_hi = c_lo + (8 - HY_LO); } }
    else { const int per = (1024 + gridDim.x - 1) / gridDim.x; c_lo = blockIdx.x * per; c_hi = c_lo + per < 1024 ? c_lo + per : 1024; }
    for (int c = c_lo; c < c_hi; ++c) {
        int tid = tid0; asm volatile("" : "+v"(tid));
        const int wave = __builtin_amdgcn_readfirstlane(tid >> 6), lane = tid & 63;
        const float delta = fabsf(-3.0701134573253945f + (-15.350567286626973f + 3.0701134573253945f) * ((float)c / 1023.0f));
        float wv[3][4];
#pragma unroll
        for (int q = 0; q < 3; ++q) { wv[q][0] = cw[0 * 3072 + q * 1024 + c]; wv[q][1] = cw[1 * 3072 + q * 1024 + c]; wv[q][2] = cw[2 * 3072 + q * 1024 + c]; wv[q][3] = cb[q * 1024 + c]; }
        const bf16_t* rv = UT + (size_t)c * hk::TA; const bf16_t* r1 = UT + (size_t)(1024 + c) * hk::TA; const bf16_t* r2 = UT + (size_t)(2048 + c) * hk::TA;
        { int ln = lane; asm volatile("" : "+v"(ln)); Dft dft; make_dft(dft, ln);
            __syncthreads();
            const bf16_t* hc0 = HF + (size_t)(0 * 1024 + c) * L; const bf16_t* ha0 = HF + (size_t)(1 * 1024 + c) * L;
            const bf16_t* hc1 = HF + (size_t)(2 * 1024 + c) * L; const bf16_t* ha1 = HF + (size_t)(3 * 1024 + c) * L;
            const float dsc = delta / (float)(L - 1);
#pragma unroll 1
            for (int i = 0; i < 4; ++i) {
                const int n0 = 8 * (tid + 512 * i);
                const u32x4 fc0 = *(const u32x4*)(hc0 + n0), fc1 = *(const u32x4*)(hc1 + n0), fa0 = *(const u32x4*)(ha0 + (L - 8 - n0)), fa1 = *(const u32x4*)(ha1 + (L - 8 - n0));
                float f[8], g[8]; unpack8(fc0, f); unpack8(fc1, g);
#pragma unroll
                for (int e = 0; e < 8; ++e) { const int n = n0 + e; const float s = __expf(-(float)n * dsc) * (1.0f / (float)N); *(unsigned*)(W + waddr(n & 31, (n >> 5) & 31, n >> 10)) = pk2(f[e] * s, g[e] * s); }
                unpack8(fa0, f); unpack8(fa1, g);
#pragma unroll
                for (int e = 0; e < 8; ++e) { const int m = L - 8 - n0 + e, n = N - m; const float s = __expf(-(float)m * dsc) * (1.0f / (float)N);
                    if (m != 0) *(unsigned*)(W + waddr(n & 31, (n >> 5) & 31, n >> 10)) = pk2(f[e] * s, g[e] * s); }
            }
            if (tid == 0) *(unsigned*)(W + waddr(L & 31, (L >> 5) & 31, L >> 10)) = 0u;
            __syncthreads();
            fft_stage<false, false, 4, EPI_TW1>(W, dft, wave, lane, ea); __syncthreads();
            fft_stage<true, false, 4, EPI_TW0>(W, dft, wave, lane, ea); __syncthreads();
            fft_stage<true, true, 4, EPI_RAW>(W, dft, wave, lane, ea); __syncthreads();
#pragma unroll 1
            for (int it = 0; it < 16; ++it) {
                const int gi = tid + 512 * it, j = gi & 7, k1 = (gi >> 3) & 31, k2 = gi >> 8;
                if ((k1 | k2) != 0) {
                    const int k1m = (32 - k1) & 31, k2m = k1 == 0 ? 32 - k2 : 31 - k2;
                    const u32x4 z4 = *(const u32x4*)(W + waddr(k2, k1, 4 * j)), m4 = *(const u32x4*)(W + waddr(k2m, k1m, 28 - 4 * j));
                    const unsigned zw[4] = {z4.x, z4.y, z4.z, z4.w}, mw[4] = {m4.w, m4.z, m4.y, m4.x};
                    unsigned h0[4], h1[4];
#pragma unroll
                    for (int r = 0; r < 4; ++r) {
                        const float a = __uint_as_float(zw[r] << 16), b = __uint_as_float(zw[r] & 0xFFFF0000u), cc = __uint_as_float(mw[r] << 16), d = __uint_as_float(mw[r] & 0xFFFF0000u);
                        h0[r] = pk2(0.5f * (a + cc), 0.5f * (b - d)); h1[r] = pk2(0.5f * (b + d), 0.5f * (cc - a));
                    }
                    const int hi = (k2 * 32 + k1) * 32 + 4 * j;
                    *(u32x4*)(HS + hi) = (u32x4){h0[0], h0[1], h0[2], h0[3]}; *(u32x4*)(HS + 32768 + hi) = (u32x4){h1[0], h1[1], h1[2], h1[3]};
                }
            }
            if (tid < 32) {
                const unsigned z = *(const unsigned*)(W + waddr(0, 0, tid)), zm = *(const unsigned*)(W + waddr(0, 0, (32 - tid) & 31));
                const float a = __uint_as_float(z << 16), b = __uint_as_float(z & 0xFFFF0000u), cc = __uint_as_float(zm << 16), d = __uint_as_float(zm & 0xFFFF0000u);
                HS[tid] = pk2(0.5f * (a + cc), 0.5f * (b - d)); HS[32768 + tid] = pk2(0.5f * (b + d), 0.5f * (cc - a));
            }
        }
        __syncthreads();
        {
            unsigned* xs1 = (unsigned*)W; unsigned* xs2 = xs1 + L;
            const int tix = tid;
#pragma unroll 1
            for (int t0 = 8 * tid; t0 < L; t0 += 8 * 512) { sconv8_pack(r1, t0, wv[1], xs1); asm volatile("" ::: "memory"); sconv8_pack(r2, t0, wv[2], xs2); }
            __syncthreads();
#pragma unroll 1
            for (int idx = tix; idx < 4096; idx += 512) {
                const int t3 = idx & 31, cq = (idx >> 5) & 3, t2 = idx >> 7;
                u32x4 a, b;
                a.x = xs1[1024 * (4 * cq + 0) + 32 * t2 + t3]; a.y = xs1[1024 * (4 * cq + 1) + 32 * t2 + t3]; a.z = xs1[1024 * (4 * cq + 2) + 32 * t2 + t3]; a.w = xs1[1024 * (4 * cq + 3) + 32 * t2 + t3];
                b.x = xs2[1024 * (4 * cq + 0) + 32 * t2 + t3]; b.y = xs2[1024 * (4 * cq + 1) + 32 * t2 + t3]; b.z = xs2[1024 * (4 * cq + 2) + 32 * t2 + t3]; b.w = xs2[1024 * (4 * cq + 3) + 32 * t2 + t3];
                *(u32x4*)(XG1 + (t3 * 32 + t2) * 16 + 4 * cq) = a; *(u32x4*)(XG2 + (t3 * 32 + t2) * 16 + 4 * cq) = b;
            }
            __syncthreads();
#pragma unroll 1
            for (int t0 = 8 * tid; t0 < L; t0 += 8 * 512) sconv8_pack(rv, t0, wv[0], xs1);
            __syncthreads();
            u32x4 hold[8];
#pragma unroll
            for (int i = 0; i < 8; ++i) {
                const int idx = tix + 512 * i, t3 = idx & 31, cq = (idx >> 5) & 3, t2 = idx >> 7;
                hold[i].x = xs1[1024 * (4 * cq + 0) + 32 * t2 + t3]; hold[i].y = xs1[1024 * (4 * cq + 1) + 32 * t2 + t3]; hold[i].z = xs1[1024 * (4 * cq + 2) + 32 * t2 + t3]; hold[i].w = xs1[1024 * (4 * cq + 3) + 32 * t2 + t3];
            }
            __syncthreads();
#pragma unroll
            for (int i = 0; i < 8; ++i) {
                const int idx = tix + 512 * i, t3 = idx & 31, cq = (idx >> 5) & 3, t2 = idx >> 7;
                *(u32x4*)(W + waddr(t3, t2, 4 * cq)) = hold[i];
                *(u32x4*)(VG + (t3 * 32 + t2) * 16 + 4 * cq) = hold[i];
            }
            __syncthreads();
        }
        { int ln = lane; asm volatile("" : "+v"(ln)); Dft dft; make_dft(dft, ln);
        for (int o = 0; o < 2; ++o) {
            fft_stage<false, false, 2, EPI_TW1>(W, dft, wave, lane, ea); __syncthreads();
            fft_stage<true, false, 4, EPI_TW0>(W, dft, wave, lane, ea); __syncthreads();
            ea.hs = HS + o * 32768;
            fft_stage<true, true, 4, EPI_HMUL>(W, dft, wave, lane, ea); __syncthreads();
            fft_stage<true, false, 4, EPI_TW1>(W, dft, wave, lane, ea); __syncthreads();
            fft_stage<false, false, 4, EPI_TW0>(W, dft, wave, lane, ea); __syncthreads();
            ea.xg = o == 0 ? XG1 : XG2; ea.vg = VG; ea.d = lb[o * 1024 + c]; ea.store_vg = o == 0 ? 1 : 0;
            fft_stage<false, true, 4, EPI_GATE>(W, dft, wave, lane, ea); __syncthreads();
        } }
        for (int t = tid; t < L; t += 512) {
            const unsigned v = *(const unsigned*)(W + waddr(t & 31, (t >> 5) & 31, t >> 10));
            YT[(size_t)c * hk::TA + t] = (bf16_t)(v & 0xFFFFu); YT[(size_t)c * hk::TA + L + t] = (bf16_t)(v >> 16);
        }
        {
            __syncthreads();
            float* uc = (float*)W;
            float* G = uc + 512;
            const int b = tid >> 8, t = tid & 255, cbase = hk::TL + b * 256;
            uc[tid] = hy::sconv(rv + cbase, t, 256, wv[0][0], wv[0][1], wv[0][2], wv[0][3]);
#pragma unroll 1
            for (int i = tid; i < 2 * 4 * 512; i += 512) {
                const int o = i >> 11, kap = (i >> 9) & 3, j = (i & 511) + kap;
                float val = 0.f;
                if (j <= 510) { const int d = 255 - j, m = d >= 0 ? d : -d; val = bf2f(HFC[(size_t)((o * 2 + (d >= 0 ? 0 : 1)) * 1024 + c) * 256 + m]) * __expf(-((float)m / 255.0f) * delta); }
                G[i] = val;
            }
            __syncthreads();
            float y = uc[tid];
            for (int o = 0; o < 2; ++o) {
                const int off = 255 - t;
                const float* Gp = G + (o * 4 + (off & 3)) * 512 + (off & ~3); const float* up = uc + b * 256;
                float a = 0.f;
#pragma unroll 2
                for (int s4 = 0; s4 < 64; ++s4) { const f32x4 g4 = *(const f32x4*)(Gp + 4 * s4), u4 = *(const f32x4*)(up + 4 * s4); a += (g4[0] * u4[0] + g4[1] * u4[1]) + (g4[2] * u4[2] + g4[3] * u4[3]); }
                const float g = o == 0 ? hy::sconv(r1 + cbase, t, 256, wv[1][0], wv[1][1], wv[1][2], wv[1][3]) : hy::sconv(r2 + cbase, t, 256, wv[2][0], wv[2][1], wv[2][2], wv[2][3]);
                y = g * (a + lb[o * 1024 + c] * y);
                __syncthreads();
                uc[tid] = y;
                __syncthreads();
            }
            YT[(size_t)c * hk::TA + cbase + t] = f2bf(y);
        }
    }
}
__device__ __forceinline__ void ph_ssd_conv(const Params& p, unsigned char* ldsb) {
    const bf16_t* XBC = (const bf16_t*)(p.ws + hk::WS_ACT + hk::A_XBC); bf16_t* XC = (bf16_t*)(p.ws + hk::WS_ACT + hk::A_XC); float* DT = (float*)(p.ws + hk::WS_ACT + hk::A_DT);
    const float* cw = p.in[hk::I_SCW]; const float* cb = p.in[hk::I_SCB];
    bf16_t* XTG = (bf16_t*)(p.ws + hk::WS_ACT + hk::A_XTG);
    const int tid = threadIdx.x;
    {   const bf16_t* XT = (const bf16_t*)(p.ws + hk::WS_ACT + hk::A_XT);
        const int lane = tid & 63, wave = __builtin_amdgcn_readfirstlane(tid >> 6);
        constexpr int NWU = 4096 * 65; const int step = (int)gridDim.x * 8;
        int wu = blockIdx.x * 8 + wave;
        u32x4 R0 = (u32x4){0u, 0u, 0u, 0u}, R1 = R0, R2 = R0;
#define XC_LOAD3(wu_, A0, A1, A2) do { const int c_ = (wu_) / 65, s_ = (wu_) - c_ * 65, t_ = s_ * 512 + lane * 8, y_ = (t_ >> 6) & 255; \
            const bool up_ = s_ < 64 && y_ > 0, dn_ = s_ < 64 && y_ < 255; const bf16_t* row_ = XT + (size_t)c_ * hk::TA + t_; \
            A1 = *(const u32x4*)row_; A0 = *(const u32x4*)(row_ - (up_ ? 64 : 0)); A2 = *(const u32x4*)(row_ + (dn_ ? 64 : 0)); \
            if (!up_) A0 = (u32x4){0u, 0u, 0u, 0u}; if (!dn_) A2 = (u32x4){0u, 0u, 0u, 0u}; } while (0)
        if (wu < NWU) XC_LOAD3(wu, R0, R1, R2);
#pragma unroll 1
        for (; wu < NWU; wu += step) {
            u32x4 N0 = R0, N1 = R1, N2 = R2;
            { const int wn = wu + step; if (wn < NWU) XC_LOAD3(wn, N0, N1, N2); }
            const int c = wu / 65, s = wu - c * 65, t0 = s * 512 + lane * 8;
            const int x0 = s < 64 ? (t0 & 63) : (t0 & 255); const bool lf = x0 > 0, rt = x0 < (s < 64 ? 56 : 248);
            float w[9];
#pragma unroll
            for (int t = 0; t < 9; ++t) w[t] = cw[(size_t)t * 6144 + c];
            const float bias = cb[c];
            float acc[8];
#pragma unroll
            for (int i = 0; i < 8; ++i) acc[i] = bias;
#pragma unroll
            for (int dy = 0; dy < 3; ++dy) {
                const u32x4 R = dy == 0 ? R0 : dy == 1 ? R1 : R2;
                float g8[8]; unpack8(R, g8);
                const unsigned lw = (unsigned)__shfl_up((int)R.w, 1), rw = (unsigned)__shfl_down((int)R.x, 1);
                float f[10]; f[0] = lf ? __uint_as_float(lw & 0xFFFF0000u) : 0.f; f[9] = rt ? __uint_as_float(rw << 16) : 0.f;
#pragma unroll
                for (int i = 0; i < 8; ++i) f[1 + i] = g8[i];
#pragma unroll
                for (int i = 0; i < 8; ++i)
#pragma unroll
                    for (int dx = 0; dx < 3; ++dx) acc[i] += f[i + dx] * w[dy * 3 + dx];
            }
            u32x4 o; o.x = pk2(silu_f(acc[0]), silu_f(acc[1])); o.y = pk2(silu_f(acc[2]), silu_f(acc[3])); o.z = pk2(silu_f(acc[4]), silu_f(acc[5])); o.w = pk2(silu_f(acc[6]), silu_f(acc[7]));
            *(u32x4*)(XTG + (size_t)c * hk::TA + t0) = o;
            R0 = N0; R1 = N1; R2 = N2;
        }
#undef XC_LOAD3
    }
#pragma unroll 1
    for (int tb = blockIdx.x; tb < 4160; tb += gridDim.x) {
        const int c0 = 4096 + 4 * tid;
        int tok0, x0, rowlen; bool up, dn;
        if (tb < 4096) { const int b = tb >> 11, rem = tb & 2047, y = rem >> 3; x0 = 8 * (rem & 7); tok0 = b * hk::SEQ + y * 64 + x0; up = y > 0; dn = y < 255; rowlen = 64; }
        else { const int q = tb - 4096, b = q >> 5; x0 = 8 * (q & 31); tok0 = hk::TL + b * 256 + x0; up = false; dn = false; rowlen = 256; }
        float w[9][4];
#pragma unroll
        for (int t = 0; t < 9; ++t) { const f32x4 wv = *(const f32x4*)(cw + (size_t)t * 6144 + c0); w[t][0] = wv[0]; w[t][1] = wv[1]; w[t][2] = wv[2]; w[t][3] = wv[3]; }
        const f32x4 bias = *(const f32x4*)(cb + c0);
        u32x2 v[3][10];
#pragma unroll
        for (int dy = 0; dy < 3; ++dy) {
            const bool rowok = dy == 1 || (dy == 0 ? up : dn);
#pragma unroll
            for (int dx = 0; dx < 10; ++dx) {
                const int x = x0 - 1 + dx;
                v[dy][dx] = (u32x2){0u, 0u};
                if (rowok && x >= 0 && x < rowlen) v[dy][dx] = *(const u32x2*)(XBC + (size_t)(tok0 + (dy - 1) * 64 - 1 + dx) * hk::XBC_LD + (c0 - 4096));
            }
        }
#pragma unroll
        for (int i = 0; i < 8; ++i) {
            float acc[4] = {bias[0], bias[1], bias[2], bias[3]};
#pragma unroll
            for (int dy = 0; dy < 3; ++dy)
#pragma unroll
                for (int dx = 0; dx < 3; ++dx) { const u32x2 q = v[dy][i + dx]; const int t = dy * 3 + dx;
                    acc[0] += __uint_as_float(q.x << 16) * w[t][0]; acc[1] += __uint_as_float(q.x & 0xFFFF0000u) * w[t][1]; acc[2] += __uint_as_float(q.y << 16) * w[t][2]; acc[3] += __uint_as_float(q.y & 0xFFFF0000u) * w[t][3]; }
            u32x2 o; o.x = pk2(silu_f(acc[0]), silu_f(acc[1])); o.y = pk2(silu_f(acc[2]), silu_f(acc[3])); *(u32x2*)(XC + (size_t)(tok0 + i) * 2048 + (c0 - 4096)) = o;
        }
    }
    for (int idx = blockIdx.x * 512 + tid; idx < hk::TA * 16; idx += gridDim.x * 512) {
        const int r = idx >> 4, q8 = (idx & 15) * 8, dir = q8 >> 6, h0 = q8 & 63;
        float z[8]; unpack8(*(const u32x4*)(XBC + (size_t)r * hk::XBC_LD + 2048 + q8), z);
        const f32x4 b0 = *(const f32x4*)(p.in[hk::I_SDTB] + dir * 64 + h0), b1 = *(const f32x4*)(p.in[hk::I_SDTB] + dir * 64 + h0 + 4);
        f32x4 o0, o1;
#pragma unroll
        for (int j = 0; j < 4; ++j) { const float za = z[j] + b0[j], zb = z[4 + j] + b1[j]; o0[j] = za > 20.f ? za : log1pf(expf(za)); o1[j] = zb > 20.f ? zb : log1pf(expf(zb)); }
        float* d = DT + ((size_t)dir * hk::TA + r) * 64 + h0;
        *(f32x4*)d = o0; *(f32x4*)(d + 4) = o1;
    }
}
__device__ __forceinline__ void ph_ssd_scan_naive(const Params& p, unsigned char* ldsb) {
    float* Bs = (float*)ldsb;
    float* Cs = Bs + 32 * 128;
    float* xs = Cs + 32 * 128;
    float* dts = xs + 32 * 64;
    const int tid = threadIdx.x;
    const bf16_t* XC = (const bf16_t*)(p.ws + hk::WS_ACT + hk::A_XC); const float* DT = (const float*)(p.ws + hk::WS_ACT + hk::A_DT);
    for (int it = blockIdx.x; it < 256; it += gridDim.x) {
        const int b = it >> 7, dir = (it >> 6) & 1, h = it & 63, g = h >> 3;
        bf16_t* Y = (bf16_t*)(dir == 0 ? p.ws + hk::WS_ACT + hk::A_YF : p.ws + hk::WS_YB);
        const float aneg = -expf(p.in[hk::I_SALOG][dir * 64 + h]), dsk = p.in[hk::I_SD][dir * 64 + h];
        const int pp = tid >> 3, ns = tid & 7;
        float S[16];
#pragma unroll
        for (int i = 0; i < 16; ++i) S[i] = 0.f;
        for (int seg = 0; seg < 2; ++seg) {
            const int n = seg == 0 ? hk::CTXL : hk::SEQ, rowbase = seg == 0 ? hk::TL + b * hk::CTXL : b * hk::SEQ;
            for (int t0 = 0; t0 < n; t0 += 32) {
                __syncthreads();
                for (int idx = tid; idx < 32 * 128; idx += 512) {
                    const int s = idx >> 7, nn = idx & 127, tt = t0 + s, t = dir == 0 ? tt : n - 1 - tt;
                    const bf16_t* row = XC + (size_t)(rowbase + t) * 6144;
                    Bs[idx] = bf2f(row[4096 + g * 128 + nn]); Cs[idx] = bf2f(row[5120 + g * 128 + nn]);
                }
                for (int idx = tid; idx < 32 * 64; idx += 512) {
                    const int s = idx >> 6, q = idx & 63, tt = t0 + s, t = dir == 0 ? tt : n - 1 - tt;
                    xs[idx] = bf2f(XC[(size_t)(rowbase + t) * 6144 + h * 64 + q]);
                }
                if (tid < 32) { const int tt = t0 + tid, t = dir == 0 ? tt : n - 1 - tt; dts[tid] = DT[((size_t)dir * hk::TA + rowbase + t) * 64 + h]; }
                __syncthreads();
#pragma unroll 2
                for (int s = 0; s < 32; ++s) {
                    const float dt = dts[s], da = expf(dt * aneg), xv = xs[s * 64 + pp], xd = dt * xv;
                    float y = 0.f;
#pragma unroll
                    for (int q = 0; q < 4; ++q) {
                        const f32x4 b4 = *(const f32x4*)(Bs + s * 128 + ns * 16 + q * 4), c4 = *(const f32x4*)(Cs + s * 128 + ns * 16 + q * 4);
#pragma unroll
                        for (int j = 0; j < 4; ++j) { S[q * 4 + j] = da * S[q * 4 + j] + xd * b4[j]; y += S[q * 4 + j] * c4[j]; }
                    }
                    y += __shfl_xor(y, 1); y += __shfl_xor(y, 2); y += __shfl_xor(y, 4);
                    if (seg == 1 && ns == 0) { const int tt = t0 + s, t = dir == 0 ? tt : n - 1 - tt; Y[(size_t)(rowbase + t) * 4096 + h * 64 + pp] = f2bf(y + dsk * xv); }
                }
            }
        }
    }
}
__device__ __forceinline__ void ph_ssd_finish(const Params& p) {
    const int lane = threadIdx.x & 63, wave = threadIdx.x >> 6;
    bf16_t* Z = (bf16_t*)(p.ws + hk::WS_ACT + hk::A_Z);
    const bf16_t* YF = (const bf16_t*)(p.ws + hk::WS_ACT + hk::A_YF); const bf16_t* YB = (const bf16_t*)(p.ws + hk::WS_YB);
    const float* ng = p.in[hk::I_SNG];
    for (int r = blockIdx.x * 8 + wave; r < hk::TL; r += gridDim.x * 8) {
#pragma unroll 2
        for (int g = 0; g < 8; ++g) {
            const int col = g * 512 + lane * 8;
            float a[8], bq[8], z[8], uu[8];
            unpack8(*(const u32x4*)(YF + (size_t)r * 4096 + col), a); unpack8(*(const u32x4*)(YB + (size_t)r * 4096 + col), bq); unpack8(*(const u32x4*)(Z + (size_t)r * 4096 + col), z);
            float ss = 0.f;
#pragma unroll
            for (int j = 0; j < 8; ++j) { uu[j] = (a[j] + bq[j]) * silu_f(z[j]); ss += uu[j] * uu[j]; }
            const float rs = rsqrtf(wave_sum(ss) * (1.0f / 512.0f) + hk::LN_EPS);
            const f32x4 g0 = *(const f32x4*)(ng + col), g1 = *(const f32x4*)(ng + col + 4);
            u32x4 w; w.x = pk2(uu[0] * rs * g0[0], uu[1] * rs * g0[1]); w.y = pk2(uu[2] * rs * g0[2], uu[3] * rs * g0[3]); w.z = pk2(uu[4] * rs * g1[0], uu[5] * rs * g1[1]); w.w = pk2(uu[6] * rs * g1[2], uu[7] * rs * g1[3]);
            *(u32x4*)(Z + (size_t)r * 4096 + col) = w;
        }
    }
}
namespace sc {
typedef short bf16x8 __attribute__((ext_vector_type(8)));
typedef float f32x16 __attribute__((ext_vector_type(16)));
constexpr int RS = 272, SCN = 1024;
constexpr float LOG2E = 1.4426950408889634f;
constexpr int O_BM = 0, O_CM = 128 * 256, O_XT = O_CM + 128 * RS, O_XW = O_XT + 64 * RS, O_SB = O_XW + 64 * RS, O_SC = O_SB + 64 * RS, O_GI = O_SC + 2 * SCN * 4;
__device__ __forceinline__ unsigned off_b(unsigned row, unsigned ch) { return 256u * row + 16u * (ch ^ (((row & 3u) << 2) | ((row >> 2) & 3u))); }
__device__ __forceinline__ f32x16 zero16() { f32x16 z;
#pragma unroll
    for (int i = 0; i < 16; ++i) z[i] = 0.f; return z; }
__device__ __forceinline__ bf16x8 ldf(const unsigned char* base, int row, int colb) { return *(const bf16x8*)(base + row * RS + colb); }
__device__ __forceinline__ f32x16 chain8_xa(f32x16 acc, const unsigned char* A, int arow, const unsigned char* B, int brow, int g2) {
    const unsigned xr = (((unsigned)arow & 3u) << 2) | (((unsigned)arow >> 2) & 3u);
#pragma unroll
    for (int hh = 0; hh < 2; ++hh) {
        bf16x8 fa[4], fb[4];
#pragma unroll
        for (int k = 0; k < 4; ++k) { fa[k] = *(const bf16x8*)(A + 256 * arow + 16 * ((unsigned)(2 * (4 * hh + k) + g2) ^ xr)); fb[k] = ldf(B, brow, 32 * (4 * hh + k) + 16 * g2); }
        __builtin_amdgcn_sched_barrier(0);
#pragma unroll
        for (int k = 0; k < 4; ++k) acc = __builtin_amdgcn_mfma_f32_32x32x16_bf16(fa[k], fb[k], acc, 0, 0, 0);
        __builtin_amdgcn_sched_barrier(0);
    }
    return acc;
}
__device__ __forceinline__ f32x16 chain8_tr(f32x16 acc, unsigned ta0, unsigned ta1, const unsigned char* B, int brow, int g2) {
    u32x2 l0, l1, l2, l3, h0, h1, h2, h3;
    {
        bf16x8 fb[4];
#pragma unroll
        for (int k = 0; k < 4; ++k) fb[k] = ldf(B, brow, 32 * k + 16 * g2);
        asm volatile("ds_read_b64_tr_b16 %0, %8\n\tds_read_b64_tr_b16 %1, %9\n\tds_read_b64_tr_b16 %2, %8 offset:4096\n\tds_read_b64_tr_b16 %3, %9 offset:4096\n\t"
                     "ds_read_b64_tr_b16 %4, %8 offset:8192\n\tds_read_b64_tr_b16 %5, %9 offset:8192\n\tds_read_b64_tr_b16 %6, %8 offset:12288\n\tds_read_b64_tr_b16 %7, %9 offset:12288\n\ts_waitcnt lgkmcnt(0)"
                     : "=&v"(l0), "=&v"(h0), "=&v"(l1), "=&v"(h1), "=&v"(l2), "=&v"(h2), "=&v"(l3), "=&v"(h3) : "v"(ta0), "v"(ta1) : "memory");
        __builtin_amdgcn_sched_barrier(0);
        acc = __builtin_amdgcn_mfma_f32_32x32x16_bf16(__builtin_bit_cast(bf16x8, (u32x4){l0.x, l0.y, h0.x, h0.y}), fb[0], acc, 0, 0, 0);
        acc = __builtin_amdgcn_mfma_f32_32x32x16_bf16(__builtin_bit_cast(bf16x8, (u32x4){l1.x, l1.y, h1.x, h1.y}), fb[1], acc, 0, 0, 0);
        acc = __builtin_amdgcn_mfma_f32_32x32x16_bf16(__builtin_bit_cast(bf16x8, (u32x4){l2.x, l2.y, h2.x, h2.y}), fb[2], acc, 0, 0, 0);
        acc = __builtin_amdgcn_mfma_f32_32x32x16_bf16(__builtin_bit_cast(bf16x8, (u32x4){l3.x, l3.y, h3.x, h3.y}), fb[3], acc, 0, 0, 0);
        __builtin_amdgcn_sched_barrier(0);
    }
    {
        bf16x8 fb[4];
#pragma unroll
        for (int k = 0; k < 4; ++k) fb[k] = ldf(B, brow, 32 * (4 + k) + 16 * g2);
        asm volatile("ds_read_b64_tr_b16 %0, %8 offset:16384\n\tds_read_b64_tr_b16 %1, %9 offset:16384\n\tds_read_b64_tr_b16 %2, %8 offset:20480\n\tds_read_b64_tr_b16 %3, %9 offset:20480\n\t"
                     "ds_read_b64_tr_b16 %4, %8 offset:24576\n\tds_read_b64_tr_b16 %5, %9 offset:24576\n\tds_read_b64_tr_b16 %6, %8 offset:28672\n\tds_read_b64_tr_b16 %7, %9 offset:28672\n\ts_waitcnt lgkmcnt(0)"
                     : "=&v"(l0), "=&v"(h0), "=&v"(l1), "=&v"(h1), "=&v"(l2), "=&v"(h2), "=&v"(l3), "=&v"(h3) : "v"(ta0), "v"(ta1) : "memory");
        __builtin_amdgcn_sched_barrier(0);
        acc = __builtin_amdgcn_mfma_f32_32x32x16_bf16(__builtin_bit_cast(bf16x8, (u32x4){l0.x, l0.y, h0.x, h0.y}), fb[0], acc, 0, 0, 0);
        acc = __builtin_amdgcn_mfma_f32_32x32x16_bf16(__builtin_bit_cast(bf16x8, (u32x4){l1.x, l1.y, h1.x, h1.y}), fb[1], acc, 0, 0, 0);
        acc = __builtin_amdgcn_mfma_f32_32x32x16_bf16(__builtin_bit_cast(bf16x8, (u32x4){l2.x, l2.y, h2.x, h2.y}), fb[2], acc, 0, 0, 0);
        acc = __builtin_amdgcn_mfma_f32_32x32x16_bf16(__builtin_bit_cast(bf16x8, (u32x4){l3.x, l3.y, h3.x, h3.y}), fb[3], acc, 0, 0, 0);
        __builtin_amdgcn_sched_barrier(0);
    }
    return acc;
}
__device__ __forceinline__ unsigned tr_addr(unsigned img, int lane, int c, int t) {
    const unsigned hh = (unsigned)lane >> 5, blk = ((unsigned)lane >> 4) & 1u, q = ((unsigned)lane & 15u) >> 2, pp = (unsigned)lane & 3u;
    return img + off_b(8u * hh + 4u * (unsigned)t + q, 4u * (unsigned)c + 2u * blk + (pp >> 1)) + 8u * (pp & 1u);
}
template <int N> __device__ __forceinline__ float dpp_shr(float v) { return __int_as_float(__builtin_amdgcn_update_dpp(0, __float_as_int(v), 0x110 + N, 0xF, 0xF, true)); }
__device__ __forceinline__ float rdl(float v, int l) { return __int_as_float(__builtin_amdgcn_readlane(__float_as_int(v), l)); }
__device__ __forceinline__ int row0_of(int ci, int b, int dir) { const int seg = ci < 2 ? 0 : 1, c2 = seg == 0 ? ci : ci - 2, nc = seg == 0 ? 2 : 128, cs = dir == 0 ? c2 : nc - 1 - c2;
    return (seg == 0 ? hk::TL + b * hk::CTXL : b * hk::SEQ) + 128 * cs; }
__device__ __forceinline__ f32x16 chain8(f32x16 acc, const unsigned char* A, int arow, const unsigned char* B, int brow, int g2) {
#pragma unroll
    for (int hh = 0; hh < 2; ++hh) {
        bf16x8 fa[4], fb[4];
#pragma unroll
        for (int k = 0; k < 4; ++k) { fa[k] = ldf(A, arow, 32 * (4 * hh + k) + 16 * g2); fb[k] = ldf(B, brow, 32 * (4 * hh + k) + 16 * g2); }
        __builtin_amdgcn_sched_barrier(0);
#pragma unroll
        for (int k = 0; k < 4; ++k) acc = __builtin_amdgcn_mfma_f32_32x32x16_bf16(fa[k], fb[k], acc, 0, 0, 0);
        __builtin_amdgcn_sched_barrier(0);
    }
    return acc;
}
__device__ __forceinline__ void load8(bf16x8 (&f)[8], const unsigned char* B, int brow, int g2) {
#pragma unroll
    for (int k = 0; k < 8; ++k) f[k] = ldf(B, brow, 32 * k + 16 * g2);
}
__device__ __forceinline__ f32x16 chain8_xa_b(f32x16 acc, const unsigned char* A, int arow, const bf16x8 (&fb)[8], int g2) {
    const unsigned xr = (((unsigned)arow & 3u) << 2) | (((unsigned)arow >> 2) & 3u);
#pragma unroll
    for (int hh = 0; hh < 2; ++hh) {
        bf16x8 fa[4];
#pragma unroll
        for (int k = 0; k < 4; ++k) fa[k] = *(const bf16x8*)(A + 256 * arow + 16 * ((unsigned)(2 * (4 * hh + k) + g2) ^ xr));
        __builtin_amdgcn_sched_barrier(0);
#pragma unroll
        for (int k = 0; k < 4; ++k) acc = __builtin_amdgcn_mfma_f32_32x32x16_bf16(fa[k], fb[4 * hh + k], acc, 0, 0, 0);
        __builtin_amdgcn_sched_barrier(0);
    }
    return acc;
}
__device__ __forceinline__ f32x16 chain8_b(f32x16 acc, const unsigned char* A, int arow, const bf16x8 (&fb)[8], int g2) {
#pragma unroll
    for (int hh = 0; hh < 2; ++hh) {
        bf16x8 fa[4];
#pragma unroll
        for (int k = 0; k < 4; ++k) fa[k] = ldf(A, arow, 32 * (4 * hh + k) + 16 * g2);
        __builtin_amdgcn_sched_barrier(0);
#pragma unroll
        for (int k = 0; k < 4; ++k) acc = __builtin_amdgcn_mfma_f32_32x32x16_bf16(fa[k], fb[4 * hh + k], acc, 0, 0, 0);
        __builtin_amdgcn_sched_barrier(0);
    }
    return acc;
}
__device__ __forceinline__ f32x16 chain2(f32x16 acc, const unsigned char* A, int arow, const unsigned char* B, int brow, int colb) {
    const bf16x8 a0 = ldf(A, arow, colb), b0 = ldf(B, brow, colb), a1 = ldf(A, arow, colb + 32), b1 = ldf(B, brow, colb + 32);
    __builtin_amdgcn_sched_barrier(0);
    acc = __builtin_amdgcn_mfma_f32_32x32x16_bf16(a0, b0, acc, 0, 0, 0); acc = __builtin_amdgcn_mfma_f32_32x32x16_bf16(a1, b1, acc, 0, 0, 0);
    __builtin_amdgcn_sched_barrier(0);
    return acc;
}
}
__device__ __forceinline__ void ph_ssd_scan_chunk(const Params& p, unsigned char* lds) {
    using namespace sc;
    const int tid = threadIdx.x, lane = tid & 63, wave = __builtin_amdgcn_readfirstlane(tid >> 6), l32 = lane & 31, g2 = lane >> 5;
    const bf16_t* XC = (const bf16_t*)(p.ws + hk::WS_ACT + hk::A_XC); const float* DT = (const float*)(p.ws + hk::WS_ACT + hk::A_DT);
    unsigned char* Bm = lds + O_BM; unsigned char* XW = lds + O_XW; unsigned char* Cm = lds + O_CM; unsigned char* XT = lds + O_XT; unsigned char* Sb = lds + O_SB; unsigned char* Gi = lds + O_GI;
    const bf16_t* XTG = (const bf16_t*)(p.ws + hk::WS_ACT + hk::A_XTG);
    float* SC = (float*)(lds + O_SC);
    const unsigned bm_lds = (unsigned)(size_t)(Bm);
    for (int itx = blockIdx.x; itx < 256; itx += gridDim.x) {
        const int it0 = gridDim.x == 256 ? (((itx >> 3) >> 3) << 6) | (8 * (itx & 7) + ((itx >> 3) & 7)) : itx;
        const int b = it0 >> 7, dir = (it0 >> 6) & 1, h = it0 & 63, grp = h >> 3;
        bf16_t* Y = (bf16_t*)(dir == 0 ? p.ws + hk::WS_ACT + hk::A_YF : p.ws + hk::WS_YB);
        const float aneg = -expf(p.in[hk::I_SALOG][dir * 64 + h]) * LOG2E, dsk = p.in[hk::I_SD][dir * 64 + h];
        f32x16 accST = zero16();
        __syncthreads();
        for (int i = tid; i < 64 * RS / 4; i += 512) ((unsigned*)Sb)[i] = 0u;
        u32x4 xq[2], bq[4], cc[4]; float dt0 = 0.f, dt1 = 0.f;
#define SSD_PREFETCH(ci_) do { const int r0_ = sc::row0_of(ci_, b, dir); \
        _Pragma("unroll") for (int k_ = 0; k_ < 2; ++k_) { const int pc = tid + 512 * k_, pr = pc >> 4, ch = pc & 15; xq[k_] = *(const u32x4*)(XTG + (size_t)(h * 64 + pr) * hk::TA + r0_ + 8 * ch); } \
        _Pragma("unroll") for (int k_ = 0; k_ < 4; ++k_) { const int pc = tid + 512 * k_, row = pc >> 4, ch = pc & 15; const bf16_t* s_ = XC + (size_t)(r0_ + row) * 2048 + grp * 128 + 8 * ch; bq[k_] = *(const u32x4*)s_; cc[k_] = *(const u32x4*)(s_ + 1024); } } while (0)
#define SSD_DTLOAD(ci_) do { const int r0_ = sc::row0_of(ci_, b, dir); dt0 = DT[((size_t)dir * hk::TA + r0_ + 2 * lane) * 64 + h]; dt1 = DT[((size_t)dir * hk::TA + r0_ + 2 * lane + 1) * 64 + h]; } while (0)
#define SSD_SCALARS(ci_) do { \
        const float a0 = dt0 * aneg, a1 = dt1 * aneg, s2 = a0 + a1; float P = s2; \
          \
        P += sc::dpp_shr<1>(P); P += sc::dpp_shr<2>(P); P += sc::dpp_shr<4>(P); P += sc::dpp_shr<8>(P); \
        { const float t0_ = sc::rdl(P, 15), t1_ = sc::rdl(P, 31), t2_ = sc::rdl(P, 47); P += lane >= 48 ? t0_ + t1_ + t2_ : lane >= 32 ? t0_ + t1_ : lane >= 16 ? t0_ : 0.f; } \
        const float T_ = sc::rdl(P, 63); \
        float ac0, ac1; if (dir == 0) { ac0 = P - a1; ac1 = P; } else { const float sf = T_ - P + s2; ac0 = sf; ac1 = sf - a0; } \
        float* sc_ = SC + ((ci_) & 1) * SCN; \
          \
        const float R1 = dir == 0 ? sc::rdl(ac1, 15) : sc::rdl(ac0, 16), R2 = dir == 0 ? sc::rdl(ac1, 31) : sc::rdl(ac0, 32), R3 = dir == 0 ? sc::rdl(ac1, 47) : sc::rdl(ac0, 48); \
        const int blk = lane >> 4; const float Rb = dir == 0 ? (blk == 1 ? R1 : blk == 2 ? R2 : R3) : (blk == 0 ? R1 : blk == 1 ? R2 : R3); \
        *(hw_f32x2*)(sc_ + 2 * lane) = (hw_f32x2){ac0, ac1}; *(hw_f32x2*)(sc_ + 128 + 2 * lane) = (hw_f32x2){dt0, dt1}; \
        *(hw_f32x2*)(sc_ + 256 + 2 * lane) = (hw_f32x2){__builtin_amdgcn_exp2f(fminf(ac0 - Rb, 0.f)), __builtin_amdgcn_exp2f(fminf(ac1 - Rb, 0.f))};                                    \
        *(hw_f32x2*)(sc_ + 384 + 2 * lane) = (hw_f32x2){__builtin_amdgcn_exp2f(fminf(R1 - ac0, 0.f)) * dt0, __builtin_amdgcn_exp2f(fminf(R1 - ac1, 0.f)) * dt1};                        \
        *(hw_f32x2*)(sc_ + 512 + 2 * lane) = (hw_f32x2){__builtin_amdgcn_exp2f(fminf(R2 - ac0, 0.f)) * dt0, __builtin_amdgcn_exp2f(fminf(R2 - ac1, 0.f)) * dt1};                        \
        *(hw_f32x2*)(sc_ + 640 + 2 * lane) = (hw_f32x2){__builtin_amdgcn_exp2f(fminf(R3 - ac0, 0.f)) * dt0, __builtin_amdgcn_exp2f(fminf(R3 - ac1, 0.f)) * dt1};                        \
        *(hw_f32x2*)(sc_ + 768 + 2 * lane) = (hw_f32x2){dt0 * __builtin_amdgcn_exp2f(T_ - ac0), dt1 * __builtin_amdgcn_exp2f(T_ - ac1)};                                                \
        if (lane == 0) sc_[896] = __builtin_amdgcn_exp2f(T_); } while (0)
#define SSD_FILL(ci_) do { const float* scn_ = SC + ((ci_) & 1) * SCN; \
        _Pragma("unroll") for (int k_ = 0; k_ < 2; ++k_) { const int pc = tid + 512 * k_, pr = pc >> 4, ch = pc & 15; *(u32x4*)(XT + pr * RS + 16 * ch) = xq[k_]; \
          const f32x4 wa_ = *(const f32x4*)(scn_ + 768 + 8 * ch), wb_ = *(const f32x4*)(scn_ + 768 + 8 * ch + 4); \
          float f_[8]; unpack8(xq[k_], f_); u32x4 o_; o_.x = pk2(wa_[0] * f_[0], wa_[1] * f_[1]); o_.y = pk2(wa_[2] * f_[2], wa_[3] * f_[3]); o_.z = pk2(wb_[0] * f_[4], wb_[1] * f_[5]); o_.w = pk2(wb_[2] * f_[6], wb_[3] * f_[7]); \
          *(u32x4*)(XW + pr * RS + 16 * ch) = o_; } \
        _Pragma("unroll") for (int k_ = 0; k_ < 4; ++k_) { const int pc = tid + 512 * k_, row = pc >> 4, ch = pc & 15; \
          *(u32x4*)(Cm + row * RS + 16 * ch) = cc[k_]; *(u32x4*)(Bm + off_b(row, ch)) = bq[k_]; } } while (0)
        SSD_PREFETCH(0);
        if (wave == 7) { SSD_DTLOAD(0); SSD_SCALARS(0); SSD_DTLOAD(1); }
        __syncthreads();
        SSD_FILL(0);

#if PROBE_STAMP
        long long pst_prev = clock64(), ps_ab = 0, ps_bc = 0, ps_cd = 0, ps_da = 0;
#define PSTAMP(acc_) do { const long long now_ = clock64(); acc_ += now_ - pst_prev; pst_prev = now_; } while (0)
#else
#define PSTAMP(acc_) do { } while (0)
#endif
        for (int ci = 0; ci < 130; ++ci) {
            __syncthreads();
            PSTAMP(ps_da);
            const float* sc = SC + (ci & 1) * SCN; const float dtot = sc[896];
            if (ci + 1 < 130) { SSD_PREFETCH(ci + 1); if (wave == 7) { SSD_SCALARS(ci + 1); if (ci + 2 < 130) SSD_DTLOAD(ci + 2); } }
            const int pt2 = wave >> 2, it2 = wave < 4 ? wave : (dir == 0 ? (wave == 4 ? 0 : 8 - wave) : 3 - (wave == 4 ? 0 : 8 - wave));
            bf16x8 cf[8]; load8(cf, Cm, 32 * it2 + l32, g2);
            int tj[2], ti[2]; const int ntile = (wave == 5 || wave == 6) ? 2 : 1;
            u32x2 gp[2][4];
#define GI_NTL(it_) (dir == 0 ? (it_) + 1 : 4 - (it_))
#define GI_BASE(it_) (dir == 0 ? 32 * (32 * (it_) * ((it_) + 1) + 16 * (it_)) : 32 * (256 * (it_) - 32 * (it_) * ((it_) - 1) + 16 * (it_)))
#define GI_ROW(it_, l_) (Gi + GI_BASE(it_) + (l_) * (64 * GI_NTL(it_) + 16))
#define GI_COL(it_, jt_) (64 * ((jt_) - (dir == 0 ? 0 : (it_))))
#pragma unroll
            for (int s = 0; s < 2; ++s) {
                int a, bq;
                if (wave < 4) { a = wave; bq = wave; }
                else if (wave == 4) { a = 2; bq = 3; }
                else if (wave == 5) { a = s; bq = 3; }
                else if (wave == 6) { a = s; bq = 2; }
                else { a = 0; bq = 1; }
                if (wave < 4) { tj[s] = a; ti[s] = bq; } else { tj[s] = dir == 0 ? a : 3 - a; ti[s] = dir == 0 ? bq : 3 - bq; }
                if (s < ntile) {
                    f32x16 gt = wave == 4 ? chain8_xa(zero16(), Bm, 32 * tj[s] + l32, Cm, 32 * ti[s] + l32, g2) : chain8_xa_b(zero16(), Bm, 32 * tj[s] + l32, cf, g2);
                    const int i = 32 * ti[s] + l32;
                    if (wave < 4) {
                        const float aci = sc[i];
#pragma unroll
                        for (int q = 0; q < 4; ++q) {
                            const int j0 = 32 * tj[s] + 8 * q + 4 * g2;
                            const f32x4 acj = *(const f32x4*)(sc + j0), dtj = *(const f32x4*)(sc + 128 + j0);
                            float v[4];
#pragma unroll
                            for (int r = 0; r < 4; ++r) {
                                const int j = j0 + r; const bool ok = dir == 0 ? (j <= i) : (j >= i);
                                const float e = __builtin_amdgcn_exp2f(fminf(aci - acj[r], 0.f));
                                v[r] = ok ? gt[4 * q + r] * e * dtj[r] + (j == i ? dsk : 0.f) : 0.f;
                            }
                            gp[s][q].x = pk2(v[0], v[1]); gp[s][q].y = pk2(v[2], v[3]);
                        }
                    } else {
                        const float ea = sc[256 + i];
                        const float* eb = sc + 384 + 128 * (dir == 0 ? ti[s] - 1 : ti[s]) + 32 * tj[s] + 4 * g2;
#pragma unroll
                        for (int q = 0; q < 4; ++q) {
                            const f32x4 e4 = *(const f32x4*)(eb + 8 * q);
                            gp[s][q].x = pk2(gt[4 * q] * ea * e4[0], gt[4 * q + 1] * ea * e4[1]); gp[s][q].y = pk2(gt[4 * q + 2] * ea * e4[2], gt[4 * q + 3] * ea * e4[3]);
                        }
                    }
                    { unsigned char* gr_ = GI_ROW(ti[s], l32) + GI_COL(ti[s], tj[s]) + 8 * g2;
#pragma unroll
                      for (int q = 0; q < 4; ++q) *(u32x2*)(gr_ + 16 * q) = gp[s][q]; }
                }
            }
            f32x16 yint = zero16();
            yint = chain8_b(yint, Sb, 32 * pt2 + l32, cf, g2);
            { const float ei = __builtin_amdgcn_exp2f(sc[32 * it2 + l32]);
#pragma unroll
              for (int k = 0; k < 16; ++k) yint[k] *= ei; }
            {
                const int nt = wave & 3, pt = wave >> 2;
#pragma unroll
                for (int i = 0; i < 16; ++i) accST[i] *= dtot;
                accST = chain8_tr(accST, tr_addr(bm_lds, lane, nt, 0), tr_addr(bm_lds, lane, nt, 1), XW, 32 * pt + l32, g2);
            }
            const int jlo = dir == 0 ? 0 : it2, jhi = dir == 0 ? it2 : 3;
            bf16x8 xa[4][2];
#pragma unroll
            for (int jt = 0; jt < 4; ++jt) if (jt >= jlo && jt <= jhi) { xa[jt][0] = ldf(XT, 32 * pt2 + l32, 64 * jt + 16 * g2); xa[jt][1] = ldf(XT, 32 * pt2 + l32, 64 * jt + 16 * g2 + 32); }
            __syncthreads();
            PSTAMP(ps_bc);
            f32x16 yacc = yint;
            {
                const unsigned char* grow = GI_ROW(it2, l32) + 16 * g2;
#pragma unroll
                for (int jt = 0; jt < 4; ++jt) if (jt >= jlo && jt <= jhi) {
                    const bf16x8 b0 = *(const bf16x8*)(grow + GI_COL(it2, jt)), b1 = *(const bf16x8*)(grow + GI_COL(it2, jt) + 32);
                    __builtin_amdgcn_sched_barrier(0);
                    yacc = __builtin_amdgcn_mfma_f32_32x32x16_bf16(xa[jt][0], b0, yacc, 0, 0, 0); yacc = __builtin_amdgcn_mfma_f32_32x32x16_bf16(xa[jt][1], b1, yacc, 0, 0, 0);
                    __builtin_amdgcn_sched_barrier(0);
                }
            }
            if (ci >= 2) {
                const int r0 = sc::row0_of(ci, b, dir), i = 32 * it2 + l32;
                bf16_t* yrow = Y + (size_t)(r0 + i) * 4096 + h * 64 + 32 * pt2 + 4 * g2;
#pragma unroll
                for (int q = 0; q < 4; ++q) { u32x2 w; w.x = pk2(yacc[4 * q], yacc[4 * q + 1]); w.y = pk2(yacc[4 * q + 2], yacc[4 * q + 3]);
                    *(u32x2*)(yrow + 8 * q) = w; }
            }
            {
                const int nt = wave & 3, pt = wave >> 2;
#pragma unroll
                for (int q = 0; q < 4; ++q) { u32x2 w; w.x = pk2(accST[4 * q], accST[4 * q + 1]); w.y = pk2(accST[4 * q + 2], accST[4 * q + 3]);
                    *(u32x2*)(Sb + (32 * pt + l32) * RS + 2 * (32 * nt + 8 * q + 4 * g2)) = w; }
            }
            PSTAMP(ps_cd);
            if (ci + 1 < 130) SSD_FILL(ci + 1);
        }
#if PROBE_STAMP
        if (blockIdx.x == 0 && tid == 0) { const float tot = (float)(ps_ab + ps_bc + ps_cd + ps_da);
            const float sel = PROBE_STAMP == 1 ? (float)ps_ab : PROBE_STAMP == 2 ? (float)ps_bc : PROBE_STAMP == 3 ? (float)ps_cd : (float)ps_da;
            ((float*)(p.ws + hk::WS_CTL))[hk::CW_PROBE] = sel / tot; }
#endif
#undef PSTAMP
#undef GI_NTL
#undef GI_BASE
#undef GI_ROW
#undef GI_COL
#undef SSD_PREFETCH
#undef SSD_FILL
#undef SSD_DTLOAD
#undef SSD_SCALARS
    }
}
namespace gc {
constexpr int NCH = 260;
}
__device__ __forceinline__ void ph_gla_pre(const Params& p, unsigned char* lds) {
    bf16_t* qs = (bf16_t*)lds;
    bf16_t* ks = qs + 128 * 128;
    float* g1s = (float*)(ks + 128 * 128);
    float* w2s = g1s + 128 * 16;
    float* bs = w2s + 16 * 128;
    float* tot = bs + 128;
    const int tid = threadIdx.x;
    const bf16_t* GL = (const bf16_t*)(p.ws + hk::WS_ACT + hk::A_GL);
    for (int itx = blockIdx.x; itx < gc::NCH * 8; itx += gridDim.x) {
        const int item = gridDim.x == 256 ? ((itx >> 4) << 4) | ((itx & 7) << 1) | ((itx >> 3) & 1) : itx;
        const int chunk = item >> 3, h = (item >> 1) & 3, dir = item & 1, r0 = chunk * 128;
        bf16_t* QD = (bf16_t*)(p.ws + hk::WS_ACT + hk::A_QK) + (size_t)(dir * 2 + 0) * hk::TA * 512;
        bf16_t* KD = (bf16_t*)(p.ws + hk::WS_ACT + hk::A_QK) + (size_t)(dir * 2 + 1) * hk::TA * 512;
        float* E = (float*)(p.ws + hk::WS_ACT + hk::A_EB) + ((size_t)(dir * gc::NCH + chunk) * 3) * 512 + h * 128;
        __syncthreads();
        for (int pc = tid; pc < 128 * 16; pc += 512) {
            const int row = pc >> 4, ch = pc & 15;
            *(u32x4*)(qs + row * 128 + 8 * ch) = *(const u32x4*)(GL + (size_t)(r0 + row) * hk::GL_LD + h * 128 + 8 * ch);
            *(u32x4*)(ks + row * 128 + 8 * ch) = *(const u32x4*)(GL + (size_t)(r0 + row) * hk::GL_LD + 512 + h * 128 + 8 * ch);
        }
        for (int i = tid; i < 128 * 16; i += 512) { const int row = i >> 4, r = i & 15; g1s[i] = bf2f(GL[(size_t)(r0 + row) * hk::GL_LD + hk::GL_GK + dir * 16 + r]); }
        for (int i = tid; i < 16 * 128; i += 512) { const int r = i >> 7, kk = i & 127; w2s[i] = p.in[hk::I_GW2][(size_t)(dir * 16 + r) * 512 + h * 128 + kk]; }
        if (tid < 128) bs[tid] = p.in[hk::I_GB][dir * 512 + h * 128 + tid];
        __syncthreads();
        const int kk = tid & 127, tq = tid >> 7;
        float w2r[16];
#pragma unroll
        for (int r = 0; r < 16; ++r) w2r[r] = w2s[r * 128 + kk];
        const float bias = bs[kk];
        float gl[32]; float run = 0.f;
#pragma unroll
        for (int s = 0; s < 32; ++s) {
            const int t = tq * 32 + s;
            float z = bias;
#pragma unroll
            for (int r = 0; r < 16; ++r) z += g1s[t * 16 + r] * w2r[r];
            const float ls = fminf(z, 0.f) - __logf(1.0f + __expf(-fabsf(z)));
            run += ls * (1.0f / 16.0f); gl[s] = run;
        }
        tot[tq * 128 + kk] = run;
        __syncthreads();
        const float t0 = tot[kk], t1 = tot[128 + kk], t2 = tot[256 + kk], t3 = tot[384 + kk];
        const float before = tq == 0 ? 0.f : tq == 1 ? t0 : tq == 2 ? t0 + t1 : t0 + t1 + t2, total = (t0 + t1) + (t2 + t3);
        const float ref = dir == 0 ? t0 + t1 : t2 + t3;
        if (tq == 0) { E[kk] = __expf(total); E[512 + kk] = __expf(total - ref); E[1024 + kk] = __expf(ref); }
        float prev = 0.f;
#pragma unroll
        for (int s = 0; s < 32; ++s) {
            const int t = tq * 32 + s;
            const float pin = before + gl[s];
            const float bt = dir == 0 ? pin : total - (before + prev);
            prev = gl[s];
            const float eq = __expf(bt - ref), ek = __expf(ref - bt);
            qs[t * 128 + kk] = f2bf(bf2f(qs[t * 128 + kk]) * 0.08838834764831845f * eq);
            ks[t * 128 + kk] = f2bf(bf2f(ks[t * 128 + kk]) * ek);
        }
        __syncthreads();
        for (int pc = tid; pc < 128 * 16; pc += 512) {
            const int row = pc >> 4, ch = pc & 15;
            *(u32x4*)(QD + (size_t)(r0 + row) * 512 + h * 128 + 8 * ch) = *(const u32x4*)(qs + row * 128 + 8 * ch);
            *(u32x4*)(KD + (size_t)(r0 + row) * 512 + h * 128 + 8 * ch) = *(const u32x4*)(ks + row * 128 + 8 * ch);
        }
    }
}

__device__ __forceinline__ void ph_gla_scan_chunk(const Params& p, unsigned char* lds) {
    using namespace sc;
    const int tid = threadIdx.x, lane = tid & 63, wave = __builtin_amdgcn_readfirstlane(tid >> 6), l32 = lane & 31, g2 = lane >> 5;
    constexpr int O_KM = 0, O_QM = 128 * RS, O_VT = 2 * 128 * RS, O_SB2 = O_VT + 64 * RS, O_GI = O_SB2 + 32 * RS + 3072;
    unsigned char* Km = lds + O_KM; unsigned char* Qm = lds + O_QM; unsigned char* VT0 = lds + O_VT; unsigned char* Sb = lds + O_SB2; unsigned char* Gi = lds + O_GI;
    const unsigned km_lds = (unsigned)(size_t)Km;
    const bf16_t* VTG = (const bf16_t*)(p.ws + hk::WS_ACT + hk::A_VTG);
    float* Es = (float*)(lds + O_SB2 + 32 * RS);
    const bf16_t* GL = (const bf16_t*)(p.ws + hk::WS_ACT + hk::A_GL);
    if (blockIdx.x < 128) { const int itx = blockIdx.x, it0 = gridDim.x == 256 ? ((2 * (itx & 7) + ((itx >> 3) & 1)) << 3) | (itx >> 4) : itx;
        const int b = it0 >> 6, dir = (it0 >> 5) & 1, h = (it0 >> 3) & 3, vs = it0 & 7;
        const bf16_t* QD = (const bf16_t*)(p.ws + hk::WS_ACT + hk::A_QK) + (size_t)(dir * 2 + 0) * hk::TA * 512;
        const bf16_t* KD = (const bf16_t*)(p.ws + hk::WS_ACT + hk::A_QK) + (size_t)(dir * 2 + 1) * hk::TA * 512;
        const float* EB = (const float*)(p.ws + hk::WS_ACT + hk::A_EB) + (size_t)dir * gc::NCH * 3 * 512 + h * 128;
        bf16_t* OUT = (bf16_t*)(p.ws + hk::WS_ACT + (dir == 0 ? hk::A_OF : hk::A_OB));
        f32x16 accST = zero16();
        __syncthreads();
        for (int i = tid; i < 32 * RS / 4; i += 512) ((unsigned*)Sb)[i] = 0u;
        u32x4 kq[4], qq[4], vq; float ev = 0.f;
#define GLA_PREFETCH(ci_) do { const int r0_ = sc::row0_of(ci_, b, dir); \
        if (tid < 384) ev = EB[(size_t)(r0_ >> 7) * 1536 + (tid >> 7) * 512 + (tid & 127)]; \
        _Pragma("unroll") for (int k_ = 0; k_ < 4; ++k_) { const int pc = tid + 512 * k_, row = pc >> 4, ch = pc & 15; kq[k_] = *(const u32x4*)(KD + (size_t)(r0_ + row) * 512 + h * 128 + 8 * ch); qq[k_] = *(const u32x4*)(QD + (size_t)(r0_ + row) * 512 + h * 128 + 8 * ch); } \
        { const int vr = tid >> 4, ch = tid & 15; vq = *(const u32x4*)(VTG + (size_t)(h * 256 + vs * 32 + vr) * hk::TA + r0_ + 8 * ch); } } while (0)
#define GLA_FILL(VT) do { \
        _Pragma("unroll") for (int k_ = 0; k_ < 4; ++k_) { const int pc = tid + 512 * k_, row = pc >> 4, ch = pc & 15; *(u32x4*)(Km + off_b(row, ch)) = kq[k_]; *(u32x4*)(Qm + row * RS + 16 * ch) = qq[k_]; } \
        { const int vr = tid >> 4, ch = tid & 15; *(u32x4*)(VT + vr * RS + 16 * ch) = vq; } } while (0)
        GLA_PREFETCH(0);
        __syncthreads();
        GLA_FILL(VT0);
        if (tid < 384) Es[tid] = ev;
        GLA_PREFETCH(1);
        for (int ci = 0; ci < 130; ++ci) {
            __syncthreads();
            const float* Ec = Es + (ci & 1) * 384; const float* En = Es + ((ci + 1) & 1) * 384;
            unsigned char* VT = VT0 + (ci & 1) * 32 * RS; unsigned char* VTn = VT0 + ((ci + 1) & 1) * 32 * RS;
            if (ci + 1 < 130 && tid < 384) Es[((ci + 1) & 1) * 384 + tid] = ev;
            bf16x8 cf[8]; if (wave < 4) load8(cf, Qm, 32 * wave + l32, g2);
            int tj[2], ti[2]; const int ntile = (wave == 4 || wave == 5) ? 2 : 1;
            u32x2 gp[2][4];
#pragma unroll
            for (int s = 0; s < 2; ++s) {
                int a, bq;
                if (wave < 4) { a = wave; bq = wave; }
                else if (wave == 4) { a = s == 0 ? 0 : 2; bq = s == 0 ? 1 : 3; }
                else if (wave == 5) { a = s == 0 ? 0 : 1; bq = s == 0 ? 2 : 3; }
                else if (wave == 6) { a = 1; bq = 2; }
                else { a = 0; bq = 3; }
                tj[s] = dir == 0 ? a : bq; ti[s] = dir == 0 ? bq : a;
                if (s < ntile) {
                    const f32x16 gt = wave < 4 ? chain8_xa_b(zero16(), Km, 32 * tj[s] + l32, cf, g2) : chain8_xa(zero16(), Km, 32 * tj[s] + l32, Qm, 32 * ti[s] + l32, g2);
                    if (wave < 4) {
                        const int i = 32 * ti[s] + l32;
#pragma unroll
                        for (int q = 0; q < 4; ++q) {
                            const int j0 = 32 * tj[s] + 8 * q + 4 * g2;
                            float v[4];
#pragma unroll
                            for (int r = 0; r < 4; ++r) { const int j = j0 + r; const bool ok = dir == 0 ? (j <= i) : (j >= i); v[r] = ok ? gt[4 * q + r] : 0.f; }
                            gp[s][q].x = pk2(v[0], v[1]); gp[s][q].y = pk2(v[2], v[3]);
                        }
                    } else {
#pragma unroll
                        for (int q = 0; q < 4; ++q) { gp[s][q].x = pk2(gt[4 * q], gt[4 * q + 1]); gp[s][q].y = pk2(gt[4 * q + 2], gt[4 * q + 3]); }
                    }
#pragma unroll
                    for (int q = 0; q < 4; ++q) *(u32x2*)(Gi + (32 * ti[s] + l32) * RS + 2 * (32 * tj[s] + 8 * q + 4 * g2)) = gp[s][q];
                }
            }
            f32x16 yacc = zero16();
            if (wave < 4) {
                yacc = chain8_b(yacc, Sb, l32, cf, g2);
            } else {
                const int nt = wave - 4;
                f32x16 u = zero16();
                u = chain8_tr(u, tr_addr(km_lds, lane, nt, 0), tr_addr(km_lds, lane, nt, 1), VT, l32, g2);
#pragma unroll
                for (int q = 0; q < 4; ++q) { const int k0 = 32 * nt + 8 * q + 4 * g2; const f32x4 e1 = *(const f32x4*)(Ec + k0), e2 = *(const f32x4*)(Ec + 128 + k0);
#pragma unroll
                    for (int r = 0; r < 4; ++r) accST[4 * q + r] = e1[r] * accST[4 * q + r] + e2[r] * u[4 * q + r]; }
            }
            __syncthreads();
            if (ci + 1 < 130) { GLA_FILL(VTn); if (ci + 2 < 130) GLA_PREFETCH(ci + 2); }
            if (wave < 4) {
                const int it2 = wave, jlo = dir == 0 ? 0 : it2, jhi = dir == 0 ? it2 : 3;
                for (int jt = jlo; jt <= jhi; ++jt) yacc = chain2(yacc, VT, l32, Gi, 32 * it2 + l32, 64 * jt + 16 * g2);
                const int r0 = sc::row0_of(ci, b, dir), i = 32 * it2 + l32;
                bf16_t* orow = OUT + (size_t)(r0 + i) * 1024 + h * 256 + vs * 32 + 4 * g2;
#pragma unroll
                for (int q = 0; q < 4; ++q) { u32x2 w; w.x = pk2(yacc[4 * q], yacc[4 * q + 1]); w.y = pk2(yacc[4 * q + 2], yacc[4 * q + 3]); *(u32x2*)(orow + 8 * q) = w; }
            } else {
                const int nt = wave - 4;
#pragma unroll
                for (int q = 0; q < 4; ++q) { const f32x4 e3 = *(const f32x4*)(En + 256 + 32 * nt + 8 * q + 4 * g2);
                    u32x2 w; w.x = pk2(accST[4 * q] * e3[0], accST[4 * q + 1] * e3[1]); w.y = pk2(accST[4 * q + 2] * e3[2], accST[4 * q + 3] * e3[3]);
                    *(u32x2*)(Sb + l32 * RS + 2 * (32 * nt + 8 * q + 4 * g2)) = w; }
            }
        }
#undef GLA_PREFETCH
#undef GLA_FILL
    }
}
#ifndef ONE_LAUNCH
#define ONE_LAUNCH 0
#endif
#ifndef HY_FFT
#define HY_FFT 1
#endif
#ifndef SSD_CHUNK
#define SSD_CHUNK 1
#endif
#ifndef GLA_CHUNK
#define GLA_CHUNK 1
#endif
#ifndef PROBE_DUP_GEMM
#define PROBE_DUP_GEMM 0
#endif
#ifndef PROBE_STAMP
#define PROBE_STAMP 0
#endif
constexpr int N_PHASES = 22;
constexpr int NO_SPLIT = 1 << 30;

template <class Epi> __device__ __forceinline__ void run_gemm(unsigned char* lds, const bf16_t* A, const bf16_t* Bt, int M, int N, int K, const Epi& E) {
    pg8::Gemm g{A, Bt, M, N, K}; pg8::StaticOrder S; S.init(M, N, (int)gridDim.x, (int)blockIdx.x);
    pg8::gemm_phase<Epi, pg8::StaticOrder, false>((PG8_LAS unsigned char*)lds, g, S, E, nullptr);
#if PROBE_DUP_GEMM
    __syncthreads(); pg8::gemm_phase<Epi, pg8::StaticOrder, false>((PG8_LAS unsigned char*)lds, g, S, E, nullptr);
#endif
}
template <class Epi, bool GATHER = false> __device__ __forceinline__ void run_gemm_grouped(unsigned char* lds, const bf16_t* A, const bf16_t* Bt, int K, const unsigned* ctl, int layer, const Epi& E, const int* rowmap = nullptr) {
    pg8::GroupedOrder S; expert_starts(ctl + hk::CW_CNT + layer * 64, S.ps);
    S.ntiles = S.ps[16] >> 8; S.ncol = 8; S.G = (int)gridDim.x; S.c = (int)blockIdx.x; S.cap = hk::ROWS_CAP;
    pg8::Gemm g{A, Bt, S.ntiles * 256, 16 * 2048, K, rowmap};
    pg8::gemm_phase<Epi, pg8::GroupedOrder, false, GATHER>((PG8_LAS unsigned char*)lds, g, S, E, nullptr);
}

__global__ void __launch_bounds__(512, 2) hybrid_fwd(Params p) {
    extern __shared__ __attribute__((aligned(16))) unsigned char lds[];
    unsigned char* ws = p.ws; unsigned char* act = ws + hk::WS_ACT;
    unsigned* ctl = (unsigned*)(ws + hk::WS_CTL);
#if ONE_LAUNCH
    volatile LAS unsigned* xbw = (volatile LAS unsigned*)(lds + hk::LDS_BYTES - 16);
    if (threadIdx.x == 0) { xbw[0] = 0u; xbw[1] = 0u; xbw[2] = 0u; xbw[3] = 0u; }
    __syncthreads();
    XcdBarrier bar = xcd_barrier_post(ctl + hk::CW_BAR, xbw);
#define SEAM(k) do { if ((k) + 1 < p.ph_hi) xcd_barrier(bar); } while (0)
#else
#define SEAM(k) do { } while (0)
#endif
#ifndef PH_MASK
#define PH_MASK 0xFFFFFFFFu
#endif
#define IN(k) ((((PH_MASK) >> (k)) & 1u) && p.ph_lo <= (k) && (k) < p.ph_hi)
#ifdef PROBE_PHASE
    unsigned long long pp_t0 = __builtin_amdgcn_s_memrealtime(), pp_ta = 0, pp_tb = 0;
#define PP_BEGIN(k) do { if ((k) == PROBE_PHASE) pp_ta = __builtin_amdgcn_s_memrealtime(); if ((k) == 21 && blockIdx.x == 0 && threadIdx.x == 0) { const unsigned long long now_ = __builtin_amdgcn_s_memrealtime(); \
        ((float*)(ws + hk::WS_CTL))[hk::CW_PROBE] = (float)(pp_tb - pp_ta) / (float)(now_ - pp_t0); } } while (0)
#define PP_END(k) do { if ((k) == PROBE_PHASE) pp_tb = __builtin_amdgcn_s_memrealtime(); } while (0)
#else
#define PP_BEGIN(k) do { } while (0)
#define PP_END(k) do { } while (0)
#endif
    bf16_t* HA = (bf16_t*)(act + hk::A_HA);
    if (IN(0)) { PP_BEGIN(0); ph_mod(p, lds); __syncthreads(); ph_conv_weights(p, lds); __syncthreads(); ph_conv_experts(p, 0, lds); __syncthreads(); ph_hid(p, lds); __syncthreads(); SEAM(0); PP_END(0); }
    if (IN(1)) { PP_BEGIN(1); ph_modulate0(p); SEAM(1); PP_END(1); }
    if (IN(2)) { PP_BEGIN(2);
        {
            static_assert(hk::WS_WU % hk::MiB == 0 && hk::WS_WGLA % hk::MiB == 0 && (hk::WS_ACT + hk::A_HA) % hk::MiB == 0, "operand buffers must sit on 1 MiB steps");
            constexpr int T_WU = (int)(hk::WS_WU / hk::MiB), T_WGLA = (int)(hk::WS_WGLA / hk::MiB), T_HA = (int)((hk::WS_ACT + hk::A_HA) / hk::MiB);
            static_assert(T_WU < T_HA && T_WGLA < T_HA, "EpiChain tells the GEMMs apart by pm >= T_HA");
            pg8::Gemm g{(const bf16_t*)ws, (const bf16_t*)ws, 0, 0, 2048};
            pg8::ChainOrder S{16, hk::TA / 256, T_WU, T_HA, hk::TA / 256, 9, T_HA, T_WGLA, (int)gridDim.x, (int)blockIdx.x};
            pg8::EpiChain E{pg8::EpiStore{(bf16_t*)(act + hk::A_UT), hk::TA, NO_SPLIT, nullptr, 0, 0}, pg8::EpiStore{(bf16_t*)(act + hk::A_GL), hk::GL_LD, NO_SPLIT, nullptr, 0, 0}, T_WU, T_HA, T_HA, T_WGLA};
            pg8::gemm_phase<pg8::EpiChain, pg8::ChainOrder, false>((PG8_LAS unsigned char*)lds, g, S, E, nullptr);
        }
        run_gemm(lds, (const bf16_t*)(ws + hk::WS_W3T), (const bf16_t*)(ws + hk::WS_HID2), 4096, 16384, 256, pg8::EpiStore{(bf16_t*)(act + hk::A_HF), 16384, NO_SPLIT, nullptr, 0, 0});
        run_gemm(lds, (const bf16_t*)(ws + hk::WS_W3T), (const bf16_t*)(ws + hk::WS_HID2C), 4096, 256, 256, pg8::EpiStore{(bf16_t*)(act + hk::A_HFC), 256, NO_SPLIT, nullptr, 0, 0});
        SEAM(2);
    }
    if (IN(3)) { PP_BEGIN(3);
#if GLA_CHUNK
        ph_gla_pre(p, lds);
#endif
        SEAM(3); PP_END(3); }
    if (IN(4)) { PP_BEGIN(4);
#if GLA_CHUNK
        ph_gla_scan_chunk(p, lds);
#else
        ph_gla_scan_naive(p, lds);
#endif
        __syncthreads();
#if HY_FFT
        ph_hyena_fft(p, lds);
#else
        ph_hyena_naive(p, lds);
#endif
        SEAM(4); PP_END(4); }
    if (IN(5)) { PP_BEGIN(5); ph_mix_finish(p, lds); SEAM(5); PP_END(5); }
    if (IN(6)) { PP_BEGIN(6); run_gemm(lds, HA, (const bf16_t*)(ws + hk::WS_WOUT0), gridDim.x == 256 ? hk::TL : hk::TA, 2048, 2048, pg8::EpiStore{(bf16_t*)(act + hk::A_YO), 2048, NO_SPLIT, nullptr, 0, 0}); SEAM(6); PP_END(6); }
    if (IN(7)) { PP_BEGIN(7);
        if (gridDim.x == 256 && blockIdx.x >= 240) {
            pg8::Gemm g{HA + (size_t)hk::TL * 2048, (const bf16_t*)(ws + hk::WS_WOUT0), 512, 2048, 2048}; pg8::StaticOrder S; S.init(512, 2048, 16, (int)blockIdx.x - 240);
            pg8::gemm_phase<pg8::EpiStore, pg8::StaticOrder, false>((PG8_LAS unsigned char*)lds, g, S, pg8::EpiStore{(bf16_t*)(act + hk::A_YO) + (size_t)hk::TL * 2048, 2048, NO_SPLIT, nullptr, 0, 0}, nullptr);
            asm volatile("s_waitcnt vmcnt(0)" ::: "memory");
            __syncthreads();
            if (threadIdx.x == 0) { __builtin_amdgcn_fence(__ATOMIC_RELEASE, "agent"); asm volatile("s_waitcnt vmcnt(0)" ::: "memory");
                __hip_atomic_fetch_add(ctl + hk::CW_CTXF, 1u, __ATOMIC_RELAXED, __HIP_MEMORY_SCOPE_AGENT); }
            __syncthreads();
        }
        if (gridDim.x == 256) ph_ln1_router<true>(p, 0, lds, (const bf16_t*)(act + hk::A_YO), HA); else ph_ln1_router<false>(p, 0, lds, (const bf16_t*)(act + hk::A_YO), HA); SEAM(7); PP_END(7); }
    if (IN(9)) { PP_BEGIN(9); run_gemm_grouped<pg8::EpiSwiGLU, true>(lds, HA, (const bf16_t*)(ws + hk::WS_WE), 2048, ctl, 0, pg8::EpiSwiGLU{(bf16_t*)(act + hk::A_HB), 1024, 8}, (const int*)(act + hk::A_ROWS)); SEAM(9); PP_END(9); }
    if (IN(10)) { PP_BEGIN(10); run_gemm_grouped(lds, (const bf16_t*)(act + hk::A_HB), (const bf16_t*)(ws + hk::WS_WE_DN), 1024, ctl, 0, pg8::EpiStore{(bf16_t*)(act + hk::A_YR), 2048, NO_SPLIT, nullptr, 0, 8}); SEAM(10); PP_END(10); }
    if (IN(11)) { PP_BEGIN(11); ph_ln2(p, 0, (const bf16_t*)(act + hk::A_YR), (bf16_t*)(act + hk::A_HA1), lds); SEAM(11); PP_END(11); }
    if (IN(12)) { PP_BEGIN(12);
        {   static_assert(hk::WS_WSSDIN % hk::MiB == 0 && (hk::WS_ACT + hk::A_HA1) % hk::MiB == 0, "operand buffers must sit on 1 MiB steps");
            constexpr int T_WX = (int)(hk::WS_WSSDIN / hk::MiB), T_H1 = (int)((hk::WS_ACT + hk::A_HA1) / hk::MiB);
            static_assert(T_WX + 41 < T_H1, "EpiChain tells the GEMMs apart by pm >= T_H1");
            pg8::Gemm g{(const bf16_t*)ws, (const bf16_t*)ws, 0, 0, 2048};
            pg8::ChainOrder S{16, hk::TA / 256, T_WX, T_H1, hk::TA / 256, 25, T_H1, T_WX + 16, (int)gridDim.x, (int)blockIdx.x};
            pg8::EpiChain E{pg8::EpiStore{(bf16_t*)(act + hk::A_XT), hk::TA, NO_SPLIT, nullptr, 0, 0}, pg8::EpiStore{(bf16_t*)(act + hk::A_Z), 4096, 16, (bf16_t*)(act + hk::A_XBC), hk::XBC_LD, 0}, T_WX, T_H1, T_H1, T_WX + 16};
            pg8::gemm_phase<pg8::EpiChain, pg8::ChainOrder, false>((PG8_LAS unsigned char*)lds, g, S, E, nullptr);
        }
        SEAM(12); PP_END(12); }
    if (IN(13)) { PP_BEGIN(13); ph_ssd_conv(p, lds); SEAM(13); PP_END(13); }
    if (IN(14)) { PP_BEGIN(14);
#if SSD_CHUNK
        ph_ssd_scan_chunk(p, lds);
#else
        ph_ssd_scan_naive(p, lds);
#endif
        SEAM(14); PP_END(14); }
    if (IN(15)) { PP_BEGIN(15); ph_ssd_finish(p); SEAM(15); PP_END(15); }
    if (IN(16)) { PP_BEGIN(16);
        run_gemm(lds, (const bf16_t*)(act + hk::A_Z), (const bf16_t*)(ws + hk::WS_WOUT1), hk::TL, 2048, 4096, pg8::EpiStore{(bf16_t*)(act + hk::A_YO1), 2048, NO_SPLIT, nullptr, 0, 0});
        __syncthreads(); ph_conv_experts(p, 1, lds); SEAM(16);
    }
    if (IN(17)) { PP_BEGIN(17); if (gridDim.x == 256) ph_ln1_router<true>(p, 1, lds, (const bf16_t*)(act + hk::A_YO1), (bf16_t*)(act + hk::A_HA2)); else ph_ln1_router<false>(p, 1, lds, (const bf16_t*)(act + hk::A_YO1), (bf16_t*)(act + hk::A_HA2)); SEAM(17); PP_END(17); }
    if (IN(19)) { PP_BEGIN(19); run_gemm_grouped<pg8::EpiSwiGLU, true>(lds, (const bf16_t*)(act + hk::A_HA2), (const bf16_t*)(ws + hk::WS_WE), 2048, ctl, 1, pg8::EpiSwiGLU{(bf16_t*)(act + hk::A_HB1), 1024, 8}, (const int*)(act + hk::A_ROWS)); SEAM(19); PP_END(19); }
    if (IN(20)) { PP_BEGIN(20); run_gemm_grouped(lds, (const bf16_t*)(act + hk::A_HB1), (const bf16_t*)(ws + hk::WS_WE_DN), 1024, ctl, 1, pg8::EpiStore{(bf16_t*)(act + hk::A_YR1), 2048, NO_SPLIT, nullptr, 0, 8}); SEAM(20); PP_END(20); }
    if (IN(21)) { PP_BEGIN(21); ph_ln2(p, 1, (const bf16_t*)(act + hk::A_YR1), nullptr, lds); }
#undef IN
#undef SEAM
}

extern "C" void kernel_launch(void* const* d_in, const int* in_sizes, int n_in, void* d_out, int out_size, void* d_ws, size_t ws_size, hipStream_t stream) {
    static int grid = 0;
    if (grid == 0) {
        if (n_in != hk::N_IN || ws_size < hk::WS_NEED) { fprintf(stderr, "kernel_launch: need %d inputs and %zu bytes of workspace; got %d, %zu\n", hk::N_IN, (size_t)hk::WS_NEED, n_in, ws_size); grid = -1; return; }
        int dev = 0, cus = 0, per_cu = 0;
        if (hipGetDevice(&dev) != hipSuccess || hipDeviceGetAttribute(&cus, hipDeviceAttributeMultiprocessorCount, dev) != hipSuccess) { grid = -1; return; }
        if (hipFuncSetAttribute((const void*)hybrid_fwd, hipFuncAttributeMaxDynamicSharedMemorySize, hk::LDS_BYTES) != hipSuccess) { fprintf(stderr, "kernel_launch: hipFuncSetAttribute failed\n"); grid = -1; return; }
        if (hipOccupancyMaxActiveBlocksPerMultiprocessor(&per_cu, (const void*)hybrid_fwd, hk::NTHREADS, hk::LDS_BYTES) != hipSuccess || per_cu < 1) fprintf(stderr, "kernel_launch: occupancy query reports %d\n", per_cu);
        (void)hipGetLastError();
        grid = cus;
    }
    if (grid < 0) return;
    (void)hipMemsetAsync((char*)d_ws + hk::WS_ACT + hk::A_ROWS, 0, (size_t)16 * hk::ROWS_CAP * sizeof(int), stream);
    (void)hipMemsetAsync((char*)d_ws + hk::WS_CTL, 0, 64 * 1024, stream);
    Params prm{};
    for (int i = 0; i < hk::N_IN; ++i) prm.in[i] = (const float*)d_in[i];
    prm.out = (float*)d_out; prm.ws = (unsigned char*)d_ws;
#if ONE_LAUNCH
    prm.ph_lo = 0; prm.ph_hi = N_PHASES;
    hipLaunchKernelGGL(hybrid_fwd, dim3(grid), dim3(hk::NTHREADS), hk::LDS_BYTES, stream, prm);
#else
    for (int k = 0; k < N_PHASES; ++k) { prm.ph_lo = k; prm.ph_hi = k + 1; hipLaunchKernelGGL(hybrid_fwd, dim3(grid), dim3(hk::NTHREADS), hk::LDS_BYTES, stream, prm);
#ifdef PROBE_REP_MASK
        if ((PROBE_REP_MASK >> k) & 1u) hipLaunchKernelGGL(hybrid_fwd, dim3(grid), dim3(hk::NTHREADS), hk::LDS_BYTES, stream, prm);
#endif
    }
#endif
}
```
